# Optimizing an MI355X kernel written in HIP

```python
import math
import jax
import jax.numpy as jnp
from jax import lax
import numpy as np

D_MODEL = 1024
BATCH = 8
SEQ = 4096
DEPTH = 4
DEC_BATCH = 32
DEC_SEQ = 16
PAST_LEN = 2048

CHUNK = 64
Q_BLOCK = 128
HEAD_DIM = 64
D_MIX = D_MODEL
H_RWKV = D_MIX // (4 * HEAD_DIM)
H_FOX = D_MIX // (2 * HEAD_DIM)
H_GDN = D_MIX // (4 * HEAD_DIM)
D_RWKV = H_RWKV * HEAD_DIM
D_FOX = H_FOX * HEAD_DIM
D_GDN = H_GDN * HEAD_DIM
RWKV_DECAY_RANK = 64
RWKV_ICL_RANK = 64
N_SHIFT = 3 * D_RWKV + RWKV_DECAY_RANK + RWKV_ICL_RANK
GDN_CONV = 4
N_CONV = 3 * D_GDN
SPLIT = [N_SHIFT, D_RWKV,
         D_FOX, D_FOX, D_FOX, H_FOX, D_FOX,
         N_CONV, H_GDN, H_GDN, D_GDN]
N_IN = sum(SPLIT)
ALPHA = (2 * DEPTH) ** 0.25
OUT_SCALE = (8 * DEPTH) ** -0.25
LN_EPS = 1e-5
RWKV_GN_EPS = 64e-5
GDN_NORM_EPS = 1e-6
L2_EPS = 1e-6

kernel_name = "hybrid_rwkv7_fox_gdn_stream_step"


def split_cols(t, sizes):
    offs, acc = [], 0
    for s in sizes[:-1]:
        acc += s
        offs.append(acc)
    return jnp.split(t, offs, axis=-1)


def layer_norm(x, g, b):
    xf = x.astype(jnp.float32)
    mu = jnp.mean(xf, -1, keepdims=True)
    var = jnp.mean(jnp.square(xf - mu), -1, keepdims=True)
    return ((xf - mu) * lax.rsqrt(var + LN_EPS) * g.astype(jnp.float32) + b.astype(jnp.float32)).astype(x.dtype)


def l2norm(t):
    return t * lax.rsqrt(jnp.sum(t * t, -1, keepdims=True) + L2_EPS)


def rwkv_mix(p_sh, z, prev_row, s0, lp):
    bsz, t_len, _ = p_sh.shape
    f32 = jnp.float32
    prev = jnp.concatenate([prev_row[:, None, :].astype(p_sh.dtype), p_sh[:, :-1]], axis=1)
    xs = (p_sh + (prev - p_sh) * lp["rwkv_mu"]).astype(f32)
    r, k, v, w_lo, a_lo = split_cols(xs, [D_RWKV, D_RWKV, D_RWKV, RWKV_DECAY_RANK, RWKV_ICL_RANK])
    w_ll = -jax.nn.softplus(-(lp["rwkv_w0"].astype(f32) + jnp.tanh(w_lo) @ lp["rwkv_w2"].astype(f32))) - 0.5
    decay = jnp.exp(-jnp.exp(w_ll))
    a = jax.nn.sigmoid(lp["rwkv_a0"].astype(f32) + a_lo @ lp["rwkv_a2"].astype(f32))
    hd = lambda t: t.reshape(bsz, t_len, H_RWKV, HEAD_DIM)
    r, k, v, decay, a = hd(r), hd(k), hd(v), hd(decay), hd(a)
    kk = k * lp["rwkv_k_k"].astype(f32).reshape(H_RWKV, HEAD_DIM)
    kk = kk / jnp.maximum(jnp.sqrt(jnp.sum(kk * kk, -1, keepdims=True)), 1e-12)
    k = k * (1.0 + (a - 1.0) * lp["rwkv_k_a"].astype(f32).reshape(H_RWKV, HEAD_DIM))

    def step(s, inp):
        r_t, k_t, v_t, w_t, kk_t, a_t = inp
        s_kk = jnp.einsum('bhvk,bhk->bhv', s, kk_t)
        s = (s * w_t[:, :, None, :] - s_kk[..., None] * (kk_t * a_t)[:, :, None, :]
             + v_t[..., None] * k_t[:, :, None, :])
        return s, jnp.einsum('bhvk,bhk->bhv', s, r_t)

    seq = tuple(jnp.moveaxis(t, 1, 0) for t in (r, k, v, decay, kk, a))
    s_fin, o = lax.scan(step, s0.astype(f32), seq)
    o = jnp.moveaxis(o, 0, 1)
    mean = jnp.mean(o, -1, keepdims=True)
    var = jnp.mean(jnp.square(o - mean), -1, keepdims=True)
    o = (((o - mean) * lax.rsqrt(var + RWKV_GN_EPS)).reshape(bsz, t_len, D_RWKV)
         * lp["rwkv_gn_g"].astype(f32) + lp["rwkv_gn_b"].astype(f32))
    bonus = jnp.sum(r * k * lp["rwkv_r_k"].astype(f32), -1, keepdims=True) * v
    o = (o + bonus.reshape(bsz, t_len, D_RWKV)) * jax.nn.silu(z.astype(f32))
    return o.astype(p_sh.dtype), p_sh[:, -1], s_fin


def fox_attend(q, cq, qpos, k, v, ck, kpos):
    f32 = jnp.float32
    s = jnp.einsum('bqhd,bkhd->bhqk', q.astype(f32), k.astype(f32)) * (HEAD_DIM ** -0.5)
    s = s + jnp.transpose(cq, (0, 2, 1))[..., :, None] - jnp.transpose(ck, (0, 2, 1))[..., None, :]
    s = jnp.where(kpos[None, :] <= qpos[:, None], s, -jnp.inf)
    p = jax.nn.softmax(s, axis=-1)
    return jnp.einsum('bhqk,bkhd->bqhd', p, v.astype(f32))


def fox_prompt(q, k, v, logf):
    bsz, t_len, n_h, d = q.shape
    c = jnp.cumsum(logf, axis=1)
    kpos = jnp.arange(t_len)

    def block(i):
        s0 = i * Q_BLOCK
        qb = lax.dynamic_slice_in_dim(q, s0, Q_BLOCK, axis=1)
        cb = lax.dynamic_slice_in_dim(c, s0, Q_BLOCK, axis=1)
        return fox_attend(qb, cb, s0 + jnp.arange(Q_BLOCK), k, v, c, kpos)

    o = lax.map(block, jnp.arange(t_len // Q_BLOCK))
    return jnp.moveaxis(o, 0, 1).reshape(bsz, t_len, n_h, d)


def fox_cached(q, k, v, logf, cache_k, cache_v, cache_logf):
    past, t_len = cache_k.shape[1], q.shape[1]
    k_all = jnp.concatenate([cache_k.astype(k.dtype), k], axis=1)
    v_all = jnp.concatenate([cache_v.astype(v.dtype), v], axis=1)
    c = jnp.cumsum(jnp.concatenate([cache_logf.astype(jnp.float32), logf], axis=1), axis=1)
    return fox_attend(q, c[:, past:], past + jnp.arange(t_len), k_all, v_all, c, jnp.arange(past + t_len))


def gated_delta_chunked(q, k, v, beta, g, s0):
    bsz, t_len, n_h, d = q.shape
    c = min(CHUNK, t_len)
    n = t_len // c

    def chunks(t):
        t = t.reshape((bsz, n, c, n_h) + t.shape[3:])
        return jnp.moveaxis(t, (1, 3), (0, 2))

    q, k, v, beta, g = chunks(q), chunks(k), chunks(v), chunks(beta), chunks(g)
    gc = jnp.cumsum(g, axis=-1)
    incl = jnp.tril(jnp.ones((c, c), bool))
    strict = jnp.tril(jnp.ones((c, c), bool), -1)
    diff = gc[..., :, None] - gc[..., None, :]
    dmat = jnp.where(incl, jnp.exp(jnp.where(incl, diff, 0.0)), 0.0)
    kb = k * beta[..., None]
    m = jnp.where(strict, jnp.einsum('...id,...jd->...ij', kb, k) * dmat, 0.0)
    a_mat = m + jnp.eye(c, dtype=m.dtype)
    rhs = jnp.concatenate([v * beta[..., None], kb * jnp.exp(gc)[..., None]], axis=-1)
    sol = lax.linalg.triangular_solve(a_mat, rhs, left_side=True, lower=True, unit_diagonal=True)
    u, w = sol[..., :d], sol[..., d:]
    qk = jnp.einsum('...id,...jd->...ij', q, k) * dmat
    qg = q * jnp.exp(gc)[..., None]
    kd = k * jnp.exp(gc[..., -1:] - gc)[..., None]
    gl = jnp.exp(gc[..., -1])

    def step(s, xs):
        u_c, w_c, qk_c, qg_c, kd_c, gl_c = xs
        v_new = u_c - jnp.einsum('bhcd,bhde->bhce', w_c, s)
        o = jnp.einsum('bhcd,bhde->bhce', qg_c, s) + jnp.einsum('bhij,bhje->bhie', qk_c, v_new)
        s = s * gl_c[..., None, None] + jnp.einsum('bhcd,bhce->bhde', kd_c, v_new)
        return s, o

    s_fin, o = lax.scan(step, s0, (u, w, qk, qg, kd, gl))
    o = jnp.moveaxis(o, (0, 2), (1, 3)).reshape(bsz, t_len, n_h, d)
    return o, s_fin


def gdn_mix(p_qkv, b_col, a_col, z, conv_prev, s0, lp):
    bsz, t_len, _ = p_qkv.shape
    f32 = jnp.float32
    conv_w = lp["gdn_conv_w"]
    xp = jnp.concatenate([conv_prev.astype(p_qkv.dtype), p_qkv], axis=1)
    y = xp[:, 0:t_len] * conv_w[0]
    for i in range(1, GDN_CONV):
        y = y + xp[:, i:i + t_len] * conv_w[i]
    y = jax.nn.silu(y.astype(f32))
    q, k, v = [t.reshape(bsz, t_len, H_GDN, HEAD_DIM) for t in split_cols(y, [D_GDN, D_GDN, D_GDN])]
    q = l2norm(q) * (HEAD_DIM ** -0.5)
    k = l2norm(k)
    beta = jax.nn.sigmoid(b_col.astype(f32))
    g = -jnp.exp(lp["gdn_a_log"].astype(f32)) * jax.nn.softplus(a_col.astype(f32) + lp["gdn_dt_bias"].astype(f32))
    o, s_fin = gated_delta_chunked(q, k, v, beta, g, s0.astype(f32))
    o = o * lax.rsqrt(jnp.mean(o * o, -1, keepdims=True) + GDN_NORM_EPS) * lp["gdn_norm_g"].astype(f32)
    o = o.reshape(bsz, t_len, D_GDN) * jax.nn.silu(z.astype(f32))
    return o.astype(p_qkv.dtype), xp[:, t_len:], s_fin


def trunk_layer(x, lp, rwkv_prev, rwkv_s0, gdn_conv_prev, gdn_s0, fox_cache):
    bsz, t_len, _ = x.shape
    f32 = jnp.float32
    proj = x @ lp["w_in"]
    a_sh, a_z, b_q, b_k, b_v, b_f, b_z, c_qkv, c_b, c_a, c_z = split_cols(proj, SPLIT)
    o_a, rwkv_last, rwkv_s = rwkv_mix(a_sh, a_z, rwkv_prev, rwkv_s0, lp)
    heads = lambda t: t.reshape(bsz, t_len, H_FOX, HEAD_DIM)
    q, k, v = heads(b_q), heads(b_k), heads(b_v)
    logf = jax.nn.log_sigmoid(b_f.astype(f32) + lp["fox_b_f"].astype(f32))
    if fox_cache is None:
        o_b = fox_prompt(q, k, v, logf)
    else:
        o_b = fox_cached(q, k, v, logf, *fox_cache)
    o_b = (o_b.reshape(bsz, t_len, D_FOX) * jax.nn.silu(b_z.astype(f32))).astype(x.dtype)
    o_c, conv_last, gdn_s = gdn_mix(c_qkv, c_b, c_a, c_z, gdn_conv_prev, gdn_s0, lp)
    h = jnp.concatenate([o_a, o_b, o_c], axis=-1) @ lp["w_out"]
    x_new = layer_norm(ALPHA * x + h, lp["ln_g"], lp["ln_b"])
    return x_new, k, v, logf, rwkv_last, rwkv_s, conv_last, gdn_s


def setup_inputs(seed: int = 0) -> dict:
    key = jax.random.key(seed)
    ks = iter(jax.random.split(key, 40))
    nrm = lambda shape, s=1.0: s * jax.random.normal(next(ks), shape, jnp.float32)
    uni = lambda shape, lo, hi: jax.random.uniform(next(ks), shape, jnp.float32, lo, hi)
    x_prompt = nrm((BATCH, SEQ, D_MODEL))
    x_sample = nrm((DEC_BATCH, DEC_SEQ, D_MODEL))
    cache_fox_k = nrm((DEPTH, DEC_BATCH, PAST_LEN, H_FOX, HEAD_DIM))
    cache_fox_v = nrm((DEPTH, DEC_BATCH, PAST_LEN, H_FOX, HEAD_DIM))
    cache_fox_logf = jax.nn.log_sigmoid(nrm((DEPTH, DEC_BATCH, PAST_LEN, H_FOX)) + 3.0)
    state_rwkv_shift = nrm((DEPTH, DEC_BATCH, N_SHIFT))
    state_rwkv_wkv = nrm((DEPTH, DEC_BATCH, H_RWKV, HEAD_DIM, HEAD_DIM), 0.3)
    state_gdn_conv = nrm((DEPTH, DEC_BATCH, GDN_CONV - 1, N_CONV))
    state_gdn_wkv = nrm((DEPTH, DEC_BATCH, H_GDN, HEAD_DIM, HEAD_DIM), 0.3)
    dt = jnp.exp(uni((DEPTH, H_GDN), math.log(1e-3), math.log(1e-1)))
    return {
        "x_prompt": x_prompt,
        "x_sample": x_sample,
        "cache_fox_k": cache_fox_k,
        "cache_fox_v": cache_fox_v,
        "cache_fox_logf": cache_fox_logf,
        "state_rwkv_shift": state_rwkv_shift,
        "state_rwkv_wkv": state_rwkv_wkv,
        "state_gdn_conv": state_gdn_conv,
        "state_gdn_wkv": state_gdn_wkv,
        "ln_in_g": 1.0 + nrm((D_MODEL,), 0.02),
        "ln_in_b": nrm((D_MODEL,), 0.02),
        "w_in": nrm((DEPTH, D_MODEL, N_IN), D_MODEL ** -0.5),
        "rwkv_mu": uni((DEPTH, N_SHIFT), 0.0, 1.0),
        "rwkv_w0": uni((DEPTH, D_RWKV), -6.0, -1.0),
        "rwkv_w2": nrm((DEPTH, RWKV_DECAY_RANK, D_RWKV), 0.5 * RWKV_DECAY_RANK ** -0.5),
        "rwkv_a0": nrm((DEPTH, D_RWKV), 0.1),
        "rwkv_a2": nrm((DEPTH, RWKV_ICL_RANK, D_RWKV), 0.5 * RWKV_ICL_RANK ** -0.5),
        "rwkv_k_k": 0.85 + nrm((DEPTH, D_RWKV), 0.05),
        "rwkv_k_a": 1.0 + nrm((DEPTH, D_RWKV), 0.05),
        "rwkv_r_k": nrm((DEPTH, H_RWKV, HEAD_DIM), 0.1),
        "rwkv_gn_g": 1.0 + nrm((DEPTH, D_RWKV), 0.02),
        "rwkv_gn_b": nrm((DEPTH, D_RWKV), 0.02),
        "fox_b_f": uni((DEPTH, H_FOX), 1.0, 5.0),
        "gdn_conv_w": nrm((DEPTH, GDN_CONV, N_CONV), GDN_CONV ** -0.5),
        "gdn_a_log": jnp.log(uni((DEPTH, H_GDN), 1.0, 16.0)),
        "gdn_dt_bias": dt + jnp.log(-jnp.expm1(-dt)),
        "gdn_norm_g": 1.0 + nrm((DEPTH, HEAD_DIM), 0.02),
        "w_out": nrm((DEPTH, D_MIX, D_MODEL), OUT_SCALE * D_MIX ** -0.5),
        "ln_post_g": 1.0 + nrm((DEPTH, D_MODEL), 0.02),
        "ln_post_b": nrm((DEPTH, D_MODEL), 0.02),
    }


def reference(x_prompt, x_sample, cache_fox_k, cache_fox_v, cache_fox_logf, state_rwkv_shift, state_rwkv_wkv,
              state_gdn_conv, state_gdn_wkv, ln_in_g, ln_in_b, w_in, rwkv_mu, rwkv_w0, rwkv_w2, rwkv_a0, rwkv_a2,
              rwkv_k_k, rwkv_k_a, rwkv_r_k, rwkv_gn_g, rwkv_gn_b, fox_b_f, gdn_conv_w, gdn_a_log, gdn_dt_bias,
              gdn_norm_g, w_out, ln_post_g, ln_post_b):
    xp = layer_norm(x_prompt, ln_in_g, ln_in_b)
    xs = layer_norm(x_sample, ln_in_g, ln_in_b)
    bp = xp.shape[0]
    fk_p, fv_p, fl_p, sh_p, rw_p, cv_p, gd_p = [], [], [], [], [], [], []
    fk_s, fv_s, fl_s, sh_s, rw_s, cv_s, gd_s = [], [], [], [], [], [], []
    for l in range(DEPTH):
        lp = dict(w_in=w_in[l], rwkv_mu=rwkv_mu[l], rwkv_w0=rwkv_w0[l], rwkv_w2=rwkv_w2[l], rwkv_a0=rwkv_a0[l],
                  rwkv_a2=rwkv_a2[l], rwkv_k_k=rwkv_k_k[l], rwkv_k_a=rwkv_k_a[l], rwkv_r_k=rwkv_r_k[l],
                  rwkv_gn_g=rwkv_gn_g[l], rwkv_gn_b=rwkv_gn_b[l], fox_b_f=fox_b_f[l], gdn_conv_w=gdn_conv_w[l],
                  gdn_a_log=gdn_a_log[l], gdn_dt_bias=gdn_dt_bias[l], gdn_norm_g=gdn_norm_g[l], w_out=w_out[l],
                  ln_g=ln_post_g[l], ln_b=ln_post_b[l])
        xp, k, v, lf, sh, rw, cv, gd = trunk_layer(
            xp, lp,
            jnp.zeros((bp, N_SHIFT), xp.dtype),
            jnp.zeros((bp, H_RWKV, HEAD_DIM, HEAD_DIM), jnp.float32),
            jnp.zeros((bp, GDN_CONV - 1, N_CONV), xp.dtype),
            jnp.zeros((bp, H_GDN, HEAD_DIM, HEAD_DIM), jnp.float32),
            None)
        fk_p.append(k); fv_p.append(v); fl_p.append(lf); sh_p.append(sh); rw_p.append(rw); cv_p.append(cv); gd_p.append(gd)
        xs, k, v, lf, sh, rw, cv, gd = trunk_layer(
            xs, lp, state_rwkv_shift[l], state_rwkv_wkv[l], state_gdn_conv[l], state_gdn_wkv[l],
            (cache_fox_k[l], cache_fox_v[l], cache_fox_logf[l]))
        fk_s.append(k); fv_s.append(v); fl_s.append(lf); sh_s.append(sh); rw_s.append(rw); cv_s.append(cv); gd_s.append(gd)
    return (xp, xs,
            jnp.stack(fk_p), jnp.stack(fv_p), jnp.stack(fl_p), jnp.stack(sh_p), jnp.stack(rw_p),
            jnp.stack(cv_p), jnp.stack(gd_p),
            jnp.stack(fk_s), jnp.stack(fv_s), jnp.stack(fl_s), jnp.stack(sh_s), jnp.stack(rw_s),
            jnp.stack(cv_s), jnp.stack(gd_s))
```

```cpp
#include <hip/hip_runtime.h>
#include <hip/hip_bf16.h>
#include <cstdio>
#include <cstdint>
#include <cmath>

constexpr int DMODEL = 1024, NB = 8, TSEQ = 4096, NLAYER = 4, SBATCH = 32, STOK = 16, PAST = 2048;
constexpr int MP = NB * TSEQ, MS = SBATCH * STOK, MROWS = MP + MS;
constexpr int NIN = 4240, NPJ = 4352;
constexpr int C_ASH = 0, C_AZ = 896, C_Q = 1152, C_K = 1664, C_V = 2176, C_BZ = 2688, C_CQKV = 3200, C_CZ = 3968, C_SM = 4224;
constexpr int NSHIFT = 896, NCONV = 768;
constexpr float LOG2E = 1.4426950408889634f;
constexpr float QSCALE = 0.125f * LOG2E;
constexpr float ALPHA = 1.681792830507429f;
constexpr float LN_EPS = 1e-5f, GN_EPS = 64e-5f, GDN_EPS = 1e-6f, L2_EPS = 1e-6f;

constexpr size_t O_YP = 0, O_YS = O_YP + (size_t)MP * DMODEL;
constexpr size_t O_FKP = O_YS + (size_t)MS * DMODEL, O_FVP = O_FKP + (size_t)NLAYER * MP * 512, O_FLP = O_FVP + (size_t)NLAYER * MP * 512;
constexpr size_t O_SHP = O_FLP + (size_t)NLAYER * MP * 8, O_RWP = O_SHP + (size_t)NLAYER * NB * NSHIFT, O_CVP = O_RWP + (size_t)NLAYER * NB * 4 * 4096;
constexpr size_t O_GDP = O_CVP + (size_t)NLAYER * NB * 3 * NCONV;
constexpr size_t O_FKS = O_GDP + (size_t)NLAYER * NB * 4 * 4096, O_FVS = O_FKS + (size_t)NLAYER * MS * 512, O_FLS = O_FVS + (size_t)NLAYER * MS * 512;
constexpr size_t O_SHS = O_FLS + (size_t)NLAYER * MS * 8, O_RWS = O_SHS + (size_t)NLAYER * SBATCH * NSHIFT, O_CVS = O_RWS + (size_t)NLAYER * SBATCH * 4 * 4096;
constexpr size_t O_GDS = O_CVS + (size_t)NLAYER * SBATCH * 3 * NCONV, O_END = O_GDS + (size_t)NLAYER * SBATCH * 4 * 4096;
static_assert(O_END == 177213440ull, "output size");

constexpr size_t MiB = 1u << 20;
constexpr size_t WS_CTL = 0, CTL_ZERO_BYTES = 1 * MiB;
constexpr size_t WS_WIN = 1 * MiB;
constexpr size_t WS_WOUT = 36 * MiB;
constexpr size_t WS_XB = 44 * MiB;
constexpr size_t WS_PROJ = 112 * MiB;
constexpr size_t WS_SMALL = 392 * MiB;
constexpr size_t WS_OC = 396 * MiB;
constexpr size_t WS_H = 464 * MiB;
constexpr size_t WS_CB = 596 * MiB;
constexpr size_t WS_CBS = 597 * MiB;
constexpr size_t WS_BONUS = 600 * MiB;
constexpr size_t WS_OA = 602 * MiB;
constexpr size_t WS_OG = 636 * MiB;
constexpr size_t WS_RARR = 672 * MiB, ARR_STRIDE = 33 * MiB;
constexpr size_t WS_GARR = 870 * MiB;
constexpr size_t WS_END = 1068 * MiB;
static_assert(WS_WIN + (size_t)NLAYER * NPJ * DMODEL * 2 <= WS_WOUT && WS_XB + (size_t)MROWS * DMODEL * 2 <= WS_PROJ && WS_PROJ + (size_t)MROWS * NPJ * 2 <= WS_SMALL, "ws map 1");
static_assert(WS_OC + (size_t)MROWS * DMODEL * 2 <= WS_H && WS_H + (size_t)MROWS * DMODEL * 4 <= WS_CB && WS_CBS + (size_t)256 * 2064 * 4 <= WS_BONUS && WS_OA + (size_t)MROWS * 256 * 4 <= WS_OG && WS_OG + (size_t)MROWS * 256 * 4 <= WS_RARR, "ws map 2");
static_assert((size_t)MROWS * 256 * 4 <= ARR_STRIDE, "ws map 3");

namespace pg8 {
#define PG8_LAS __attribute__((address_space(3)))
typedef unsigned short bf16_t;
typedef short bf16x8 __attribute__((ext_vector_type(8)));
typedef float f32x4 __attribute__((ext_vector_type(4)));
typedef unsigned u32x4 __attribute__((ext_vector_type(4)));
constexpr int BM = 256, BK = 64, HALF = 128, HTB = HALF * BK * 2  , STAGE_BYTES = 8 * HTB, NXCD = 8, WGM = 8;

__host__ __device__ __forceinline__ int lds_byte(int r, int c) { const int st = (r >> 4) * 2 + (c >> 5), rr = r & 15, cc = c & 31, ob = rr * 64 + cc * 2; return st * 1024 + (ob ^ (((ob >> 9) & 1) << 5)); }
__host__ __device__ __forceinline__ void stage_rc(int b, int& R, int& C) { const int st = b / 1024, sb = b % 1024, swz = sb ^ (((sb >> 9) & 1) << 5); R = (st >> 1) * 16 + swz / 64; C = (st & 1) * 32 + (swz % 64) / 2; }
__host__ __device__ __forceinline__ int perm32(int rho) { const int n = rho >> 4, i = rho & 15; return 8 * (i >> 2) + 4 * n + (i & 3); }

struct Unit { int pm, pn; };
struct Gemm { const bf16_t* A; const bf16_t* Bt; int M, N, K; };

struct StaticOrder {
    int nM, nN, nwg, G, c;
    __host__ __device__ void init(int M, int N, int G_, int c_) { nM = M / BM; nN = N / BM; nwg = nM * nN; G = G_; c = c_; }
    __host__ __device__ bool next(int i, Unit& u) const {
        const long L = (long)i * G + c; if (L >= nwg) return false;
        int wgid = (int)L; { const int q = nwg / NXCD, r = nwg % NXCD, xcd = wgid % NXCD, off = wgid / NXCD; wgid = (xcd < r ? xcd * (q + 1) : r * (q + 1) + (xcd - r) * q) + off; }
        const int nig = WGM * nN, gid = wgid / nig, fm = gid * WGM, gsz = (nM - fm) < WGM ? (nM - fm) : WGM;
        u.pm = fm + ((wgid % nig) % gsz); u.pn = (wgid % nig) / gsz; return true;
    }
    __device__ __forceinline__ void a_ready(const Unit&) const {}
    __device__ __forceinline__ void done(const Unit&) const {}
};

__device__ __forceinline__ unsigned cvt_pk_bf16(float lo, float hi) { unsigned r; asm volatile("v_cvt_pk_bf16_f32 %0, %1, %2" : "=v"(r) : "v"(lo), "v"(hi)); return r; }
struct EpiProj {
    static constexpr bool PERM = true, AFTER_DRAIN = false;
    bf16_t* P; float* small; float* kp; float* vp; float* ks; float* vs;
    __device__ __forceinline__ void operator()(const f32x4 (&acc)[2][2][4][2], const Unit& u, int wr, int wc, int fr, int fq) const {
        const int row0 = u.pm * BM + wr * 64 + fr, col0 = u.pn * BM + wc * 32 + 8 * fq;
        const bool prow = (u.pm * BM) < MP;
#pragma unroll
        for (int ai = 0; ai < 2; ++ai)
#pragma unroll
            for (int m = 0; m < 4; ++m) { const int row = row0 + ai * HALF + m * 16;
#pragma unroll
                for (int bj = 0; bj < 2; ++bj) { const int col = col0 + bj * HALF, cb = 2 * u.pn + bj;
                    f32x4 v0 = acc[ai][bj][m][0], v1 = acc[ai][bj][m][1];
                    if (cb >= 13 && cb < 21) {
                        float* dst;
                        if (cb < 17) dst = (prow ? kp + (size_t)row * 512 : ks + (size_t)(row - MP) * 512) + (col - C_K);
                        else         dst = (prow ? vp + (size_t)row * 512 : vs + (size_t)(row - MP) * 512) + (col - C_V);
                        *(f32x4*)dst = v0; *(f32x4*)(dst + 4) = v1;
                    }
                    if (cb == 33 && col < C_SM + 16) { float* dst = small + (size_t)row * 16 + (col - C_SM); *(f32x4*)dst = v0; *(f32x4*)(dst + 4) = v1; }
                    if (cb >= 9 && cb < 13) { v0 = v0 * QSCALE; v1 = v1 * QSCALE; }
                    u32x4 w; w.x = cvt_pk_bf16(v0[0], v0[1]); w.y = cvt_pk_bf16(v0[2], v0[3]); w.z = cvt_pk_bf16(v1[0], v1[1]); w.w = cvt_pk_bf16(v1[2], v1[3]);
                    *(u32x4*)(P + (size_t)row * NPJ + col) = w; } }
    }
};
struct EpiF32 {
    static constexpr bool PERM = false, AFTER_DRAIN = false;
    float* H; int ldc;
    __device__ __forceinline__ void operator()(const f32x4 (&acc)[2][2][4][2], const Unit& u, int wr, int wc, int fr, int fq) const {
        const int row0 = u.pm * BM + wr * 64 + fr, col0 = u.pn * BM + wc * 32 + 4 * fq;
#pragma unroll
        for (int ai = 0; ai < 2; ++ai)
#pragma unroll
            for (int m = 0; m < 4; ++m) { float* rowp = H + (size_t)(row0 + ai * HALF + m * 16) * ldc + col0;
#pragma unroll
                for (int bj = 0; bj < 2; ++bj)
#pragma unroll
                    for (int n = 0; n < 2; ++n) *(f32x4*)(rowp + bj * HALF + n * 16) = acc[ai][bj][m][n]; }
    }
};

template <class Epi, class Sched, bool ALIGN_EPI = false, bool SP2 = false>
__device__ __forceinline__ void gemm_phase(PG8_LAS unsigned char* lds, const Gemm g, const Sched& S, const Epi& E) {
    int tid_l = threadIdx.x; asm volatile("" : "+v"(tid_l));
    const int tid = tid_l, wid = __builtin_amdgcn_readfirstlane(tid >> 6), lane = tid & 63, wr = wid >> 2, wc = wid & 3, fr = lane & 15, fq = lane >> 4;
    const int K = g.K, nt = K / BK;
    unsigned voffA[2], voffB[2];
#pragma unroll
    for (int i = 0; i < 2; ++i) { int R, C; stage_rc(tid * 16 + i * 8192, R, C); const int Rb = Epi::PERM ? ((R & ~31) + perm32(R & 31)) : R;
        voffA[i] = (unsigned)(R * K + C) * 2u; voffB[i] = (unsigned)(Rb * K + C) * 2u; }
    const size_t kstep = (size_t)(BK * 2);
    const size_t hstep = (size_t)HALF * K * 2;
    const size_t tstep = 2 * hstep;
    const unsigned ldsw = (unsigned)wid * 1024u;
    const int aoff = lds_byte(wr * 64 + fr, fq * 8), boff = lds_byte(wc * 32 + fr, fq * 8);
#define PG8_SA(b, h) (((b) * 2 + (h)) * HTB)
#define PG8_SB(b, h) ((4 + (b) * 2 + (h)) * HTB)
#define PG8_STAGE(bufoff, gbase, voff) do { _Pragma("unroll") for (int _i = 0; _i < 2; ++_i) \
        __builtin_amdgcn_global_load_lds((const unsigned*)((const char*)(gbase) + (voff)[_i]), (PG8_LAS unsigned*)(lds + (bufoff) + ldsw + _i * 8192), 16, 0, 0); } while (0)
#define PG8_LDA(dst, b, h) do { _Pragma("unroll") for (int m = 0; m < 4; ++m) _Pragma("unroll") for (int k = 0; k < 2; ++k) dst[m][k] = *(const PG8_LAS bf16x8*)(lds + PG8_SA(b, h) + aoff + m * 2048 + k * 1024); } while (0)
#define PG8_LDB(dst, b, h) do { _Pragma("unroll") for (int n = 0; n < 2; ++n) _Pragma("unroll") for (int k = 0; k < 2; ++k) dst[n][k] = *(const PG8_LAS bf16x8*)(lds + PG8_SB(b, h) + boff + n * 2048 + k * 1024); } while (0)
#define PG8_MMA(ai, bj, At, Bt) do { __builtin_amdgcn_s_setprio(1); _Pragma("unroll") for (int m = 0; m < 4; ++m) _Pragma("unroll") for (int n = 0; n < 2; ++n) _Pragma("unroll") for (int k = 0; k < 2; ++k) \
        acc[ai][bj][m][n] = __builtin_amdgcn_mfma_f32_16x16x32_bf16(Bt[n][k], At[m][k], acc[ai][bj][m][n], 0, 0, 0); __builtin_amdgcn_s_setprio(0); } while (0)
#define PG8_WAIT_V(n) asm volatile("s_waitcnt vmcnt(" #n ")" ::: "memory")
#define PG8_WAIT_L(n) asm volatile("s_waitcnt lgkmcnt(" #n ")" ::: "memory")
#define PG8_BAR __builtin_amdgcn_s_barrier()
#define PG8_SCHED __builtin_amdgcn_sched_barrier(0)
    Unit cur, nxt; int ui = 0;
    if (!S.next(0, cur)) return;
    f32x4 acc[2][2][4][2];
#pragma unroll
    for (int a = 0; a < 2; ++a)
#pragma unroll
        for (int b = 0; b < 2; ++b)
#pragma unroll
            for (int m = 0; m < 4; ++m)
#pragma unroll
                for (int n = 0; n < 2; ++n) acc[a][b][m][n] = (f32x4){0.f, 0.f, 0.f, 0.f};
    bf16x8 At[4][2], B0[2][2], B1[2][2];
    const char* cA = (const char*)g.A + (size_t)cur.pm * tstep; const char* cB = (const char*)g.Bt + (size_t)cur.pn * tstep;
    S.a_ready(cur);
    if constexpr (SP2) {
        PG8_STAGE(PG8_SB(0, 0), cB, voffB); PG8_STAGE(PG8_SB(0, 1), cB + hstep, voffB); PG8_STAGE(PG8_SA(0, 0), cA, voffA); PG8_STAGE(PG8_SA(0, 1), cA + hstep, voffA);
        if (wr == 1) PG8_BAR;
        PG8_WAIT_V(2); PG8_BAR;
        PG8_STAGE(PG8_SB(1, 0), cB + kstep, voffB); PG8_STAGE(PG8_SA(1, 0), cA + kstep, voffA); PG8_STAGE(PG8_SB(1, 1), cB + hstep + kstep, voffB);
        PG8_WAIT_V(6); PG8_BAR;
    } else {
        PG8_STAGE(PG8_SB(0, 0), cB, voffB); PG8_STAGE(PG8_SA(0, 0), cA, voffA); PG8_STAGE(PG8_SB(0, 1), cB + hstep, voffB); PG8_STAGE(PG8_SA(0, 1), cA + hstep, voffA);
        if (wr == 1) PG8_BAR;
        PG8_WAIT_V(4); PG8_BAR;
        PG8_STAGE(PG8_SB(1, 0), cB + kstep, voffB); PG8_STAGE(PG8_SA(1, 0), cA + kstep, voffA); PG8_STAGE(PG8_SB(1, 1), cB + hstep + kstep, voffB);
        PG8_WAIT_V(6); PG8_BAR;
    }
    for (;;) {
        const bool has_next = S.next(ui + 1, nxt);
        const char* nA = has_next ? (const char*)g.A + (size_t)nxt.pm * tstep : cA; const char* nB = has_next ? (const char*)g.Bt + (size_t)nxt.pn * tstep : cB;
        for (int t = 0; t < nt; t += 2) {
            const bool last = (t == nt - 2);
            const char* a1 = cA + (size_t)(t + 1) * kstep;
            const char* a2 = last ? nA : cA + (size_t)(t + 2) * kstep; const char* b2 = last ? nB : cB + (size_t)(t + 2) * kstep;
            const char* a3 = a2 + kstep; const char* b3 = b2 + kstep;
            if (last && has_next) S.a_ready(nxt);
            if constexpr (SP2) {
            PG8_LDB(B0, 0, 0); PG8_LDB(B1, 0, 1); PG8_SCHED; PG8_LDA(At, 0, 0); PG8_STAGE(PG8_SA(1, 1), a1 + hstep, voffA);
            PG8_WAIT_V(8); PG8_WAIT_L(0); PG8_BAR; PG8_MMA(0, 0, At, B0); PG8_MMA(0, 1, At, B1); PG8_BAR; PG8_SCHED;
            PG8_LDA(At, 0, 1); PG8_STAGE(PG8_SB(0, 0), b2, voffB); PG8_STAGE(PG8_SB(0, 1), b2 + hstep, voffB); PG8_STAGE(PG8_SA(0, 0), a2, voffA);
            PG8_WAIT_V(8); PG8_WAIT_L(0); PG8_BAR; PG8_MMA(1, 0, At, B0); PG8_MMA(1, 1, At, B1); PG8_BAR; PG8_SCHED;
            PG8_LDB(B0, 1, 0); PG8_LDB(B1, 1, 1); PG8_SCHED; PG8_LDA(At, 1, 0); PG8_STAGE(PG8_SA(0, 1), a2 + hstep, voffA);
            PG8_WAIT_V(8); PG8_WAIT_L(0); PG8_BAR; PG8_MMA(0, 0, At, B0); PG8_MMA(0, 1, At, B1); PG8_BAR; PG8_SCHED;
            PG8_LDA(At, 1, 1); PG8_STAGE(PG8_SB(1, 0), b3, voffB); PG8_STAGE(PG8_SB(1, 1), b3 + hstep, voffB); PG8_STAGE(PG8_SA(1, 0), a3, voffA);
            PG8_WAIT_V(8); PG8_WAIT_L(0); PG8_BAR; PG8_MMA(1, 0, At, B0); PG8_MMA(1, 1, At, B1); PG8_BAR; PG8_SCHED;
            } else {
            PG8_LDB(B0, 0, 0); PG8_SCHED; PG8_LDA(At, 0, 0); PG8_STAGE(PG8_SA(1, 1), a1 + hstep, voffA);
            PG8_WAIT_L(8); PG8_BAR; PG8_WAIT_L(0); PG8_MMA(0, 0, At, B0); PG8_BAR; PG8_SCHED;
            PG8_LDB(B1, 0, 1); PG8_STAGE(PG8_SB(0, 0), b2, voffB);
            PG8_BAR; PG8_WAIT_L(0); PG8_MMA(0, 1, At, B1); PG8_BAR;
            PG8_LDA(At, 0, 1); PG8_STAGE(PG8_SA(0, 0), a2, voffA);
            PG8_BAR; PG8_WAIT_L(0); PG8_MMA(1, 0, At, B0); PG8_BAR; PG8_SCHED;
            PG8_STAGE(PG8_SB(0, 1), b2 + hstep, voffB);
            PG8_WAIT_V(6); PG8_BAR; PG8_MMA(1, 1, At, B1); PG8_BAR;
            PG8_LDB(B0, 1, 0); PG8_SCHED; PG8_LDA(At, 1, 0); PG8_STAGE(PG8_SA(0, 1), a2 + hstep, voffA);
            PG8_WAIT_L(8); PG8_BAR; PG8_WAIT_L(0); PG8_MMA(0, 0, At, B0); PG8_BAR; PG8_SCHED;
            PG8_LDB(B1, 1, 1); PG8_STAGE(PG8_SB(1, 0), b3, voffB);
            PG8_BAR; PG8_WAIT_L(0); PG8_MMA(0, 1, At, B1); PG8_BAR;
            PG8_LDA(At, 1, 1); PG8_STAGE(PG8_SA(1, 0), a3, voffA);
            PG8_BAR; PG8_WAIT_L(0); PG8_MMA(1, 0, At, B0); PG8_BAR; PG8_SCHED;
            PG8_STAGE(PG8_SB(1, 1), b3 + hstep, voffB);
            PG8_WAIT_V(6); PG8_BAR; PG8_MMA(1, 1, At, B1); PG8_BAR;
            }
        }
        if constexpr (ALIGN_EPI) { if (wr == 0) PG8_BAR; }
        if constexpr (!Epi::AFTER_DRAIN) { E(acc, cur, wr, wc, fr, fq); S.done(cur); }
        if (!has_next) break;
#pragma unroll
        for (int a = 0; a < 2; ++a)
#pragma unroll
            for (int b = 0; b < 2; ++b)
#pragma unroll
                for (int m = 0; m < 4; ++m)
#pragma unroll
                    for (int n = 0; n < 2; ++n) acc[a][b][m][n] = (f32x4){0.f, 0.f, 0.f, 0.f};
        cur = nxt; cA = nA; cB = nB; ++ui;
        if constexpr (ALIGN_EPI) { if (wr == 1) PG8_BAR; }
    }
    PG8_WAIT_V(0);
    if constexpr (!ALIGN_EPI) { if (wr == 0) PG8_BAR; }
    PG8_BAR;
    if constexpr (Epi::AFTER_DRAIN) { E.fused(acc, cur, wr, wc, fr, fq, lds, wid, lane); S.done(cur); }
#undef PG8_SA
#undef PG8_SB
#undef PG8_STAGE
#undef PG8_LDA
#undef PG8_LDB
#undef PG8_MMA
#undef PG8_WAIT_V
#undef PG8_WAIT_L
#undef PG8_BAR
#undef PG8_SCHED
}
}
#include <hip/hip_bf16.h>
#include <cmath>
namespace attn_body {
using bf16=__hip_bfloat16;
using bf16x8=__attribute__((ext_vector_type(8)))short;
using s16x4=__attribute__((ext_vector_type(4)))short;
using f32x16=__attribute__((ext_vector_type(16)))float;
using u32x4=__attribute__((ext_vector_type(4)))unsigned;
constexpr int BATCH=8,NHEAD=8,SEQ=4096,D=64,DM=4352,OPITCH=1024;
constexpr int NW=8,QBLK=32,QB=QBLK*NW,KVBLK=64,NQB=SEQ/QB;
constexpr int ATTN_PITCH=DM, ATTN_UNIT_ROWS=QB;
__device__ __forceinline__ int crow(int r,int hi){return (r&3)+8*(r>>2)+4*hi;}
#define SBAR() __builtin_amdgcn_sched_barrier(0)
__device__ __forceinline__ void cmask(f32x16&p0,f32x16&p1,int jb,int qrel,int hi){
  const float NEG=-INFINITY; int kb=64*jb+4*hi;
  #pragma unroll
  for(int r=0;r<16;++r){int kv=kb+(r&3)+8*(r>>2); if(kv>qrel)p0[r]=NEG; if(kv+32>qrel)p1[r]=NEG;}
}

constexpr int NSLOT=3, SLOTB=8192;
constexpr int LDS_K=0, LDS_V=NSLOT*SLOTB, LDS_WS=2*NSLOT*SLOTB, LDS_OST=LDS_WS+NW*64*4, LDS_BIAS=LDS_OST+NW*4096, LDS_BYTES=LDS_BIAS+SEQ*4;
constexpr float C2=0.125f*1.4426950408889634f;
__device__ __forceinline__ void glds16(const void*gsrc,unsigned lds_dst){unsigned keep;
  asm volatile("s_mov_b32 %0, m0\n\ts_mov_b32 m0, %2\n\ts_nop 0\n\tglobal_load_lds_dwordx4 %1, off\n\ts_mov_b32 m0, %0":"=&s"(keep):"v"(gsrc),"s"(lds_dst):"memory");}
__device__ __forceinline__ float max3f(float a,float b,float c){float r;asm("v_max3_f32 %0, %1, %2, %3":"=v"(r):"v"(a),"v"(b),"v"(c));return r;}
__device__ __forceinline__ float max2f(float a,float b){float r;asm("v_max_f32_e32 %0, %1, %2":"=v"(r):"v"(a),"v"(b));return r;}
__device__ __forceinline__ float fadd_s(float a,float b){float r;asm("v_add_f32_e32 %0, %1, %2":"=v"(r):"v"(a),"v"(b));return r;}
__device__ __forceinline__ float fsub_s(float a,float b){float r;asm("v_sub_f32_e32 %0, %1, %2":"=v"(r):"v"(a),"v"(b));return r;}
typedef float f32x2_t __attribute__((ext_vector_type(2))); typedef float f32x4_t __attribute__((ext_vector_type(4))); typedef __bf16 bf16x2_t __attribute__((ext_vector_type(2)));
__device__ __forceinline__ unsigned cvtpk_s(float lo,float hi){f32x2_t v={lo,hi};bf16x2_t b=__builtin_convertvector(v,bf16x2_t);return __builtin_bit_cast(unsigned,b);}
#define WAIT_BAR(N) asm volatile("s_waitcnt vmcnt(" #N ") lgkmcnt(0)\n\ts_barrier":::"memory")

__device__ __forceinline__ void qkt(f32x16&p0,f32x16&p1,const char*Kslot,const bf16x8*qr,const f32x16&ci0,const f32x16&ci1,int r32,int hi){
  const char*kb=Kslot+hi*1024+r32*16;
  #pragma unroll
  for(int d0=0;d0<4;++d0){
    const bf16x8 b0=*reinterpret_cast<const bf16x8*>(kb+d0*2048);
    const bf16x8 b1=*reinterpret_cast<const bf16x8*>(kb+d0*2048+512);
    if(d0==0){p0=__builtin_amdgcn_mfma_f32_32x32x16_bf16(b0,qr[0],ci0,0,0,0);p1=__builtin_amdgcn_mfma_f32_32x32x16_bf16(b1,qr[0],ci1,0,0,0);}
    else{p0=__builtin_amdgcn_mfma_f32_32x32x16_bf16(b0,qr[d0],p0,0,0,0);p1=__builtin_amdgcn_mfma_f32_32x32x16_bf16(b1,qr[d0],p1,0,0,0);}}
}
typedef __attribute__((address_space(3))) const char* lds_cptr;
typedef short v4i16_t __attribute__((ext_vector_type(4)));
__device__ __forceinline__ void kload8(bf16x8*kf,lds_cptr kp){
  kf[0]=*(const __attribute__((address_space(3))) bf16x8*)(kp);      kf[1]=*(const __attribute__((address_space(3))) bf16x8*)(kp+512);
  kf[2]=*(const __attribute__((address_space(3))) bf16x8*)(kp+2048); kf[3]=*(const __attribute__((address_space(3))) bf16x8*)(kp+2560);
  kf[4]=*(const __attribute__((address_space(3))) bf16x8*)(kp+4096); kf[5]=*(const __attribute__((address_space(3))) bf16x8*)(kp+4608);
  kf[6]=*(const __attribute__((address_space(3))) bf16x8*)(kp+6144); kf[7]=*(const __attribute__((address_space(3))) bf16x8*)(kp+6656);
}
__device__ __forceinline__ void kload2(bf16x8*kf,lds_cptr kp,int j){ kf[2*j]=*(const __attribute__((address_space(3))) bf16x8*)(kp+j*2048); kf[2*j+1]=*(const __attribute__((address_space(3))) bf16x8*)(kp+j*2048+512); }
__device__ __forceinline__ s16x4 vtr(lds_cptr p){ return __builtin_bit_cast(s16x4,__builtin_amdgcn_ds_read_tr16_b64_v4i16((__attribute__((address_space(3))) v4i16_t*)p)); }
__device__ __forceinline__ float rowmax(const f32x16&p0,const f32x16&p1){
  float a=max3f(p0[0],p0[1],p1[0]),b=max3f(p0[2],p0[3],p1[1]);a=max3f(a,p1[2],p1[3]);
  #pragma unroll
  for(int r=4;r<16;r+=4){a=max3f(a,p0[r],p0[r+1]);b=max3f(b,p0[r+2],p0[r+3]);a=max3f(a,p1[r],p1[r+1]);b=max3f(b,p1[r+2],p1[r+3]);}
  const float m=max2f(a,b);
  auto rr=__builtin_amdgcn_permlane32_swap(__float_as_uint(m),__float_as_uint(m),false,false);
  return max2f(__uint_as_float(rr[0]),__uint_as_float(rr[1]));
}
__device__ __forceinline__ void pv(f32x16*o,int vb,bf16x8 pa0,bf16x8 pa1,bf16x8 pa2,bf16x8 pa3){
  #pragma unroll
  for(int d0=0;d0<2;++d0){s16x4 lo[4],hi[4];
    #pragma unroll
    for(int ks=0;ks<4;++ks){
      asm volatile("ds_read_b64_tr_b16 %0,%1 offset:%c2":"=&v"(lo[ks]):"v"(vb),"i"(d0*4096+ks*1024):"memory");
      asm volatile("ds_read_b64_tr_b16 %0,%1 offset:%c2":"=&v"(hi[ks]):"v"(vb),"i"(d0*4096+ks*1024+512):"memory");}
    asm volatile("s_waitcnt lgkmcnt(0)":::"memory");SBAR();
    #define PK(k) (bf16x8){lo[k][0],lo[k][1],lo[k][2],lo[k][3],hi[k][0],hi[k][1],hi[k][2],hi[k][3]}
    o[d0]=__builtin_amdgcn_mfma_f32_32x32x16_bf16(pa0,PK(0),o[d0],0,0,0);
    o[d0]=__builtin_amdgcn_mfma_f32_32x32x16_bf16(pa1,PK(1),o[d0],0,0,0);
    o[d0]=__builtin_amdgcn_mfma_f32_32x32x16_bf16(pa2,PK(2),o[d0],0,0,0);
    o[d0]=__builtin_amdgcn_mfma_f32_32x32x16_bf16(pa3,PK(3),o[d0],0,0,0);
    #undef PK
  }
}

#ifndef ATTN_STORE16
#define ATTN_STORE16(p,v) (*(u32x4*)(p)=(v))
#endif
template<int THRL> __device__ __forceinline__ void attn_unit(int b,int h,int qb,const bf16*Q,const bf16*__restrict__ K,const bf16*__restrict__ V,const bf16*__restrict__ Z,const float*__restrict__ CBG,bf16*O,char*shm){
  int tid_l=threadIdx.x; asm volatile("":"+v"(tid_l));
  const int tid=tid_l,lane=tid&63,r32=lane&31,hi=lane>>5; const int wid=__builtin_amdgcn_readfirstlane(tid>>6);
  const long rowbase=(long)b*SEQ; const int q0=qb*QB;
  const bf16*Qw=Q+(rowbase+q0+wid*QBLK)*DM+h*D;
  const bf16*Kh=K+rowbase*DM+h*D,*Vh=V+rowbase*DM+h*D;
  const unsigned lds0=(unsigned)(uintptr_t)shm;
  float*wsf=(float*)(shm+LDS_WS)+wid*64;
  const bf16*ksrc=Kh+(long)lane*DM+wid*8;
  const bf16*vsrc=Vh+(long)(16*(wid&3)+(lane>>2))*DM+(wid>>2)*32+(lane&3)*8;
  const unsigned kdst=lds0+LDS_K+wid*1024, vdst=lds0+LDS_V+wid*1024;
  #define DMA_K(t,slot) glds16(ksrc+(long)(t)*KVBLK*DM,(unsigned)__builtin_amdgcn_readfirstlane(kdst+(slot)))
  #define DMA_V(t,slot) glds16(vsrc+(long)(t)*KVBLK*DM,(unsigned)__builtin_amdgcn_readfirstlane(vdst+(slot)))
  const int vb0=(int)(lds0+LDS_V)+((lane>>4)&1)*32+(lane&3)*8+(4*hi+((lane&15)>>2))*64;
  const char*Kbase=shm+LDS_K; bf16x8 kf[8];
  const lds_cptr shm3=(lds_cptr)shm; const lds_cptr kp0=shm3+LDS_K+hi*1024+r32*16; const lds_cptr vp0=shm3+LDS_V+((lane>>4)&1)*32+(lane&3)*8+(4*hi+((lane&15)>>2))*64;
  const int NT=(q0+QB)/KVBLK;
  const __attribute__((address_space(3))) float* biasL=(const __attribute__((address_space(3))) float*)(shm3+LDS_BIAS);
  { const float cref=CBG[q0]; __attribute__((address_space(3))) float* bw=(__attribute__((address_space(3))) float*)(shm3+LDS_BIAS);
    _Pragma("clang loop vectorize(disable) unroll(disable)") for(int i=tid;i<NT*KVBLK;i+=NW*64) bw[i]=cref-CBG[i]; }
  DMA_K(0,0);DMA_V(0,0);DMA_K(1,SLOTB);
  bf16x8 qr[4];
  #pragma unroll
  for(int d0=0;d0<4;++d0)qr[d0]=*reinterpret_cast<const bf16x8*>(&Qw[(long)r32*DM+d0*16+hi*8]);
  float mhat=0.f,l_reg=0.f;f32x16 o[2];o[0]=f32x16{};o[1]=f32x16{};
  const int qrel=wid*QBLK+r32;
  #define CMASK(P0,P1,t) do{int jb_=(t)-(NT-4); if(jb_>=0)cmask(P0,P1,jb_,qrel,hi);}while(0)
  #define CINIT(CI0,CI1,t) do{ const float nm_=-mhat; const __attribute__((address_space(3))) float* bp_=biasL+(t)*KVBLK+4*hi; \
    _Pragma("unroll") for(int j_=0;j_<4;++j_){ const f32x4_t a_=*(const __attribute__((address_space(3))) f32x4_t*)(bp_+8*j_), b_=*(const __attribute__((address_space(3))) f32x4_t*)(bp_+32+8*j_); \
      CI0[4*j_]=nm_+a_[0];CI0[4*j_+1]=nm_+a_[1];CI0[4*j_+2]=nm_+a_[2];CI0[4*j_+3]=nm_+a_[3]; CI1[4*j_]=nm_+b_[0];CI1[4*j_+1]=nm_+b_[1];CI1[4*j_+2]=nm_+b_[2];CI1[4*j_+3]=nm_+b_[3]; } }while(0)
  bool resc=false;
  #define START(P0,P1) do{ const float rm=rowmax(P0,P1); resc=false; \
    { const float dl=rm; mhat=fadd_s(mhat,dl); \
      _Pragma("unroll") for(int r=0;r<16;++r){P0[r]=fsub_s(P0[r],dl);P1[r]=fsub_s(P1[r],dl);} } \
    _Pragma("unroll") for(int r=0;r<16;++r)P0[r]=__builtin_amdgcn_exp2f(P0[r]); }while(0)
  #define RESC() do{ if(resc){ asm volatile("s_waitcnt lgkmcnt(0)":::"memory"); \
      _Pragma("unroll") for(int d_=0;d_<2;++d_) _Pragma("unroll") for(int r=0;r<16;++r)o[d_][r]*=wsf[crow(r,hi)]; } }while(0)
  f32x16 pA0,pA1,pB0,pB1;
  int sl_prev=0,sl_cur=0,sl_next=SLOTB;
  #define ROT() do{sl_prev=sl_cur;sl_cur=sl_next;sl_next=(sl_next==(NSLOT-1)*SLOTB)?0:sl_next+SLOTB;}while(0)
  DMA_K(2,2*SLOTB);
  WAIT_BAR(3);
  { f32x16 ci0,ci1; CINIT(ci0,ci1,0); qkt(pA0,pA1,Kbase,qr,ci0,ci1,r32,hi); } asm volatile("s_nop 15\n\ts_nop 7":"+v"(pA0),"+v"(pA1));CMASK(pA0,pA1,0);
  START(pA0,pA1);
  _Pragma("unroll") for(int r=0;r<16;++r)pA1[r]=__builtin_amdgcn_exp2f(pA1[r]);
  WAIT_BAR(0);
  DMA_K(3,0);DMA_V(1,SLOTB);
  ROT();
  kload8(kf,kp0+sl_cur);
  WAIT_BAR(2);
  s16x4 vlo[8],vhi[8]; u32x4 pw0,pw1,pw2,pw3;
  #define PKW(P,B) cvtpk_s(P[B],P[B+1])
  #define PAF(k) __builtin_bit_cast(bf16x8,pw##k)
  #define VFR(i) (bf16x8){vlo[i][0],vlo[i][1],vlo[i][2],vlo[i][3],vhi[i][0],vhi[i][1],vhi[i][2],vhi[i][3]}
  #define PIN(x) asm volatile("":"+v"(x))
  #define MX3(a,b,c) __builtin_fmaxf(__builtin_fmaxf((a),(b)),(c))
  #define GAPA(MF,A0,A1,A2,A3,W0,W1,PW) do{ MF; sacc+=A0; sacc+=A1; sacc+=A2; sacc+=A3; PIN(sacc); W0; W1; PIN(PW); SBAR(); }while(0)
  #define EX(v) __builtin_amdgcn_exp2f(v)
  #define GAPB(MF,X,B) do{ MF; X[B]=EX(X[B]); X[B+1]=EX(X[B+1]); X[B+2]=EX(X[B+2]); X[B+3]=EX(X[B+3]); PIN(X); SBAR(); }while(0)
  #define VRD(i) do{ vlo[i]=vtr(vp_+(((i)>>2)*4096+((i)&3)*1024)); vhi[i]=vtr(vp_+(((i)>>2)*4096+((i)&3)*1024+512)); }while(0)
  #define KRD(G,j) do{ if(G){ kload2(kf,kp0+sl_next,j); SBAR(); } }while(0)
  #define STEP(C0,C1,P0,P1,t,GK,GV,GL) do{ SBAR(); \
    CINIT(C0,C1,t); SBAR(); \
    const lds_cptr vp_=vp0+sl_prev; \
    VRD(0); SBAR(); float sacc=(P0[0]+P0[1]); \
    GAPA(C0=__builtin_amdgcn_mfma_f32_32x32x16_bf16(kf[0],qr[0],C0,0,0,0), P0[2],P0[3],P0[4],P0[5],     pw0[0]=PKW(P0,0), pw0[1]=PKW(P0,2), pw0); \
    VRD(4); SBAR(); GAPA(C1=__builtin_amdgcn_mfma_f32_32x32x16_bf16(kf[1],qr[0],C1,0,0,0), P0[6],P0[7],P0[8],P0[9],     pw0[2]=PKW(P0,4), pw0[3]=PKW(P0,6), pw0); \
    VRD(1); SBAR(); GAPA(C0=__builtin_amdgcn_mfma_f32_32x32x16_bf16(kf[2],qr[1],C0,0,0,0),   P0[10],P0[11],P0[12],P0[13], pw1[0]=PKW(P0,8), pw1[1]=PKW(P0,10), pw1); \
    VRD(5); SBAR(); GAPA(C1=__builtin_amdgcn_mfma_f32_32x32x16_bf16(kf[3],qr[1],C1,0,0,0),   P0[14],P0[15],P1[0],P1[1],   pw1[2]=PKW(P0,12),pw1[3]=PKW(P0,14), pw1); \
    VRD(2); SBAR(); GAPA(C0=__builtin_amdgcn_mfma_f32_32x32x16_bf16(kf[4],qr[2],C0,0,0,0),   P1[2],P1[3],P1[4],P1[5],     pw2[0]=PKW(P1,0), pw2[1]=PKW(P1,2), pw2); \
    VRD(6); SBAR(); GAPA(C1=__builtin_amdgcn_mfma_f32_32x32x16_bf16(kf[5],qr[2],C1,0,0,0),   P1[6],P1[7],P1[8],P1[9],     pw2[2]=PKW(P1,4), pw2[3]=PKW(P1,6), pw2); \
    VRD(3); SBAR(); GAPA(C0=__builtin_amdgcn_mfma_f32_32x32x16_bf16(kf[6],qr[3],C0,0,0,0),   P1[10],P1[11],P1[12],P1[13], pw3[0]=PKW(P1,8), pw3[1]=PKW(P1,10), pw3); \
    VRD(7); SBAR(); GAPA(C1=__builtin_amdgcn_mfma_f32_32x32x16_bf16(kf[7],qr[3],C1,0,0,0),   P1[14],P1[15],0.f,0.f,       pw3[2]=PKW(P1,12),pw3[3]=PKW(P1,14), pw3); \
    l_reg+=sacc; \
    if(GK){DMA_K((t)+3,sl_cur);} if(GV){DMA_V((t)+1,sl_next);} \
    CMASK(C0,C1,t); \
    { float a=MX3(C0[0],C0[1],C1[0]),b=MX3(C0[2],C0[3],C1[1]); a=MX3(a,C1[2],C1[3]); \
      _Pragma("unroll") for(int r=4;r<16;r+=4){a=MX3(a,C0[r],C0[r+1]);b=MX3(b,C0[r+2],C0[r+3]);a=MX3(a,C1[r],C1[r+1]);b=MX3(b,C1[r+2],C1[r+3]);} \
      float rm=__builtin_fmaxf(a,b); { auto rr=__builtin_amdgcn_permlane32_swap(__float_as_uint(rm),__float_as_uint(rm),false,false); rm=__builtin_fmaxf(__uint_as_float(rr[0]),__uint_as_float(rr[1])); } \
      resc=false; \
      if(__builtin_expect(__any(rm>(float)THRL),0)){ const float dl=__builtin_fmaxf(rm,0.f); mhat+=dl; \
        _Pragma("unroll") for(int r=0;r<16;++r){C0[r]-=dl;C1[r]-=dl;} \
        const float f=__builtin_amdgcn_exp2f(-dl); l_reg*=f; if(hi==0)wsf[r32]=f; resc=true; } } \
    SBAR(); \
    GAPB(o[0]=__builtin_amdgcn_mfma_f32_32x32x16_bf16(PAF(0),VFR(0),o[0],0,0,0), C0,0); \
    GAPB(o[1]=__builtin_amdgcn_mfma_f32_32x32x16_bf16(PAF(0),VFR(4),o[1],0,0,0), C0,4); \
    KRD(GL,0); GAPB(o[0]=__builtin_amdgcn_mfma_f32_32x32x16_bf16(PAF(1),VFR(1),o[0],0,0,0), C0,8); \
    KRD(GL,1); GAPB(o[1]=__builtin_amdgcn_mfma_f32_32x32x16_bf16(PAF(1),VFR(5),o[1],0,0,0), C0,12); \
    KRD(GL,2); GAPB(o[0]=__builtin_amdgcn_mfma_f32_32x32x16_bf16(PAF(2),VFR(2),o[0],0,0,0), C1,0); \
    KRD(GL,3); GAPB(o[1]=__builtin_amdgcn_mfma_f32_32x32x16_bf16(PAF(2),VFR(6),o[1],0,0,0), C1,4); \
    GAPB(o[0]=__builtin_amdgcn_mfma_f32_32x32x16_bf16(PAF(3),VFR(3),o[0],0,0,0), C1,8); \
    GAPB(o[1]=__builtin_amdgcn_mfma_f32_32x32x16_bf16(PAF(3),VFR(7),o[1],0,0,0), C1,12); \
    }while(0)
  int t=1;
  #undef CMASK
  #define CMASK(P0,P1,t) do{}while(0)
  for(;t+5<NT;t+=2){
    STEP(pB0,pB1,pA0,pA1,t,true,true,true);     WAIT_BAR(2); RESC(); ROT();
    STEP(pA0,pA1,pB0,pB1,t+1,true,true,true);   WAIT_BAR(2); RESC(); ROT();
  }
  #undef CMASK
  #define CMASK(P0,P1,t) do{int jb_=(t)-(NT-4); if(jb_>=0)cmask(P0,P1,jb_,qrel,hi);}while(0)
  #define ENDW(tt) do{ if((tt)+3<NT){WAIT_BAR(2);} else if((tt)+2<NT){WAIT_BAR(1);} else {WAIT_BAR(0);} }while(0)
  for(;t+1<NT;t+=2){
    STEP(pB0,pB1,pA0,pA1,t,(t+3<NT),(t+1<NT),(t+1<NT));       ENDW(t);   RESC(); ROT();
    STEP(pA0,pA1,pB0,pB1,t+1,(t+4<NT),(t+2<NT),(t+2<NT));     ENDW(t+1); RESC(); ROT();
  }
  STEP(pB0,pB1,pA0,pA1,NT-1,false,false,false); RESC();
  { float sacc=pB0[0]+pB0[1]; _Pragma("unroll") for(int r=2;r<16;++r)sacc+=pB0[r]; _Pragma("unroll") for(int r=0;r<16;++r)sacc+=pB1[r]; l_reg+=sacc;
    pw0=(u32x4){PKW(pB0,0),PKW(pB0,2),PKW(pB0,4),PKW(pB0,6)};pw1=(u32x4){PKW(pB0,8),PKW(pB0,10),PKW(pB0,12),PKW(pB0,14)};pw2=(u32x4){PKW(pB1,0),PKW(pB1,2),PKW(pB1,4),PKW(pB1,6)};pw3=(u32x4){PKW(pB1,8),PKW(pB1,10),PKW(pB1,12),PKW(pB1,14)};
    SBAR(); pv(o,vb0+sl_cur,PAF(0),PAF(1),PAF(2),PAF(3)); }
  #undef PKW
  #undef PAF
  #undef VFR
  #undef PIN
  #undef MX3
  #undef GAPA
  #undef GAPB
  #undef EX
  #undef VRD
  #undef KRD
  #undef STEP
  #undef ENDW
  {auto rr=__builtin_amdgcn_permlane32_swap(__float_as_uint(l_reg),__float_as_uint(l_reg),false,false);l_reg=__uint_as_float(rr[0])+__uint_as_float(rr[1]);}
  if(hi==0)wsf[32+r32]=l_reg;asm volatile("s_waitcnt lgkmcnt(0)":::"memory");
  float rli[16];
  #pragma unroll
  for(int r=0;r<16;++r)rli[r]=__builtin_amdgcn_rcpf(wsf[32+crow(r,hi)]);
  bf16*Ow=O+(rowbase+q0+wid*QBLK)*OPITCH+h*D;
  const bf16*Zw=Z+(rowbase+q0+wid*QBLK)*DM+h*D;
  { bf16*stg=(bf16*)(shm+LDS_OST)+wid*2048;
    #pragma unroll
    for(int r=0;r<16;++r){const int orow=crow(r,hi);
      #pragma unroll
      for(int d0=0;d0<2;++d0){ const float z=__bfloat162float(Zw[(long)orow*DM+d0*32+r32]); const float sg=z/(1.f+__expf(-z)); stg[orow*64+d0*32+r32]=__float2bfloat16(o[d0][r]*rli[r]*sg);} }
    asm volatile("s_waitcnt lgkmcnt(0)":::"memory");
    #pragma unroll
    for(int i=0;i<4;++i){const int row=i*8+(lane>>3),ch=lane&7; const u32x4 v=*(const u32x4*)(stg+row*64+ch*8); ATTN_STORE16(Ow+(long)row*OPITCH+ch*8,v);} }
  asm volatile("s_waitcnt lgkmcnt(0)\n\ts_barrier":::"memory");
  #undef DMA_K
  #undef DMA_V
  #undef CMASK
  #undef START
  #undef CINIT
  #undef RESC
  #undef ROT
}
constexpr int ATTN_LDS_BYTES=LDS_BYTES;
struct AttnTensors { const bf16* Q; const bf16* K; const bf16* V; const bf16* Z; const float* CB; bf16* O; };
struct AttnUnit { int bh; int qb; };
struct StaticOrder {
  int vcu;
  __device__ __forceinline__ explicit StaticOrder(int grid,int block):vcu((grid%8==0)?((block%8)*(grid/8)+block/8):block){}
  __device__ __forceinline__ bool next(int i,AttnUnit&u)const{ const int L=vcu*4+i; if(i>=4||L>=BATCH*NHEAD*NQB)return false; const int s=vcu&3; u.bh=vcu>>2; u.qb=(i==0)?15-s:(i==1)?11-s:(i==2)?4+s:s; return true; }
  __device__ __forceinline__ void a_ready(const AttnUnit&)const{}
  __device__ __forceinline__ void done(const AttnUnit&)const{}
};
template<class Sched,int THRL=8> __device__ __forceinline__ void attn_phase(char*lds,const AttnTensors&T,const Sched&S){
  AttnUnit u;
  for(int i=0;S.next(i,u);++i){ S.a_ready(u); attn_unit<THRL>(u.bh/NHEAD,u.bh%NHEAD,u.qb,T.Q,T.K,T.V,T.Z,T.CB+(long)u.bh*SEQ,T.O,lds); S.done(u); }
}
#undef SBAR
#undef WAIT_BAR
}
#define GAS __attribute__((address_space(1)))
#define LAS __attribute__((address_space(3)))
typedef unsigned short bf16;
typedef unsigned v4u __attribute__((ext_vector_type(4)));
typedef float f32x4 __attribute__((ext_vector_type(4)));
typedef short bf16x8 __attribute__((ext_vector_type(8)));
typedef GAS unsigned gu32;
typedef GAS unsigned long long gu64;
#define RLX_AGENT __ATOMIC_RELAXED, __HIP_MEMORY_SCOPE_AGENT
#define LDS_WAIT() asm volatile("s_waitcnt lgkmcnt(0)" ::: "memory")
#define VM_WAIT() asm volatile("s_waitcnt vmcnt(0)" ::: "memory")
__device__ __forceinline__ unsigned long long rt() { return __builtin_amdgcn_s_memrealtime(); }
__device__ __forceinline__ unsigned f2bf(float f) { unsigned u = __builtin_bit_cast(unsigned, f); return (u + 0x7fffu + ((u >> 16) & 1u)) >> 16; }
__device__ __forceinline__ unsigned pk2(float lo, float hi) { return f2bf(lo) | (f2bf(hi) << 16); }

#define XB_TMO      128
#define XB_XCNT(j)  (256  + 64 * (j))
#define XB_XSUB(j)  (1280 + 64 * (j))
#define XB_XGEN(j)  (2304 + 64 * (j))
#define XB_TOP      3328
#define XB_TOPGEN   3392
#define XCD_BAR_WORDS 3456
#define XB_SPIN_CAP (1u << 18)

__device__ __forceinline__ unsigned xb_ld(unsigned* p)              { return __hip_atomic_load(p, __ATOMIC_RELAXED, __HIP_MEMORY_SCOPE_AGENT); }
__device__ __forceinline__ unsigned xb_add(unsigned* p, unsigned v) { return __hip_atomic_fetch_add(p, v, __ATOMIC_RELAXED, __HIP_MEMORY_SCOPE_AGENT); }
__device__ __forceinline__ unsigned xb_xcc_id() { return (unsigned)__builtin_amdgcn_s_getreg((3 << 11) | 20) & 0xFu; }
#define XB_SPIN(cond, bar) do { unsigned _sp = 0; while (cond) { __builtin_amdgcn_s_sleep(1); \
    if ((++_sp & 255u) == 0u) { if (xb_ld(&(bar)[XB_TMO])) break; if (_sp > XB_SPIN_CAP) { atomicAdd(&(bar)[XB_TMO], 1u); break; } } } } while (0)

struct XcdBarrier {
    unsigned* bar; unsigned x;
    volatile LAS unsigned* st;
};

__device__ __forceinline__ XcdBarrier xcd_barrier_post(unsigned* bar, volatile LAS unsigned* st) {
    XcdBarrier b; b.bar = bar; b.x = xb_xcc_id(); b.st = st;
    if (threadIdx.x == 0) (void)xb_add(&bar[XB_XCNT(b.x)], 1u);
    return b;
}
__device__ __forceinline__ void xcd_barrier_complete(unsigned* bar, unsigned x, unsigned& nloc, unsigned& nx) {
    const unsigned G = gridDim.x * gridDim.y * gridDim.z;
    unsigned sum, cnt, mine, sp = 0u;
    for (;;) {
        sum = 0u; cnt = 0u; mine = 0u;
#pragma unroll
        for (unsigned j = 0; j < 16; ++j) { const unsigned c = xb_ld(&bar[XB_XCNT(j)]); sum += c; cnt += (c > 0u) ? 1u : 0u; mine = (j == x) ? c : mine; }
        if (sum == G) break;
        __builtin_amdgcn_s_sleep(1);
        if ((++sp & 255u) == 0u) { if (xb_ld(&bar[XB_TMO])) break; if (sp > XB_SPIN_CAP) { atomicAdd(&bar[XB_TMO], 1u); break; } }
    }
    nloc = mine > 0u ? mine : 1u; nx = cnt > 0u ? cnt : 1u;
}

__device__ __forceinline__ void xcd_barrier(const XcdBarrier& b) {
    asm volatile("s_waitcnt vmcnt(0)" ::: "memory");
    __syncthreads();
    if (threadIdx.x == 0) {
        unsigned* bar = b.bar;
        __builtin_amdgcn_s_waitcnt(0);
        unsigned nloc = b.st[0], nx = b.st[1];
        if (nloc == 0u) { xcd_barrier_complete(bar, b.x, nloc, nx); b.st[0] = nloc; b.st[1] = nx; }
        const unsigned old = xb_add(&bar[XB_XSUB(b.x)], 1u);
        const unsigned gen = old / nloc;
        if (old + 1u == (gen + 1u) * nloc) {
            __builtin_amdgcn_fence(__ATOMIC_RELEASE, "agent");
            asm volatile("s_waitcnt vmcnt(0)" ::: "memory");
            const unsigned og = xb_add(&bar[XB_TOP], 1u);
            const unsigned tg = og / nx;
            if (og + 1u == (tg + 1u) * nx) xb_add(&bar[XB_TOPGEN], 1u);
            else XB_SPIN(xb_ld(&bar[XB_TOPGEN]) == tg, bar);
            __builtin_amdgcn_fence(__ATOMIC_ACQUIRE, "agent");
            xb_add(&bar[XB_XGEN(b.x)], 1u);
            asm volatile("s_waitcnt vmcnt(0)" ::: "memory");
        } else {
            XB_SPIN(xb_ld(&bar[XB_XGEN(b.x)]) == gen, bar);
            __builtin_amdgcn_fence(__ATOMIC_ACQUIRE, "agent");
            asm volatile("s_waitcnt vmcnt(0)" ::: "memory");
        }
    }
    __syncthreads();
}
constexpr int NWAVES = 8, NTHREADS = 512;
constexpr int PH_SCRATCH = 147456;
constexpr int MISC_OFF = PH_SCRATCH;
constexpr int LDS_BYTES = PH_SCRATCH + 512;
typedef float f32x2 __attribute__((ext_vector_type(2)));

struct Args { const float* in[30]; float* out; unsigned char* ws; int do_pro, fused, l_lo, l_hi, ph_lo, ph_hi; };

__device__ __forceinline__ float bf2f(bf16 v) { return __uint_as_float((unsigned)v << 16); }
__device__ __forceinline__ float sigmoid_f(float x) { return 1.f / (1.f + __expf(-x)); }
__device__ __forceinline__ float silu_f(float x) { return x / (1.f + __expf(-x)); }
__device__ __forceinline__ float softplus_f(float x) { return fmaxf(x, 0.f) + log1pf(__expf(-fabsf(x))); }
__device__ __forceinline__ float logsigmoid_f(float x) { return fminf(x, 0.f) - log1pf(__expf(-fabsf(x))); }
__device__ __forceinline__ float wave_sum(float v) {
#pragma unroll
    for (int o = 1; o < 64; o <<= 1) v += __shfl_xor(v, o);
    return v;
}
template <int CTRL> __device__ __forceinline__ float dpp_f(float v) { return __int_as_float(__builtin_amdgcn_update_dpp(0, __float_as_int(v), CTRL, 0xF, 0xF, true)); }
__device__ __forceinline__ float row16_sum(float v) { v += dpp_f<0xB1>(v); v += dpp_f<0x4E>(v); v += dpp_f<0x141>(v); v += dpp_f<0x140>(v); return v; }

__device__ __forceinline__ int win_src_col(int n) {
    if (n < 2688) return n;
    if (n < 3968) return n + 8;
    if (n < 4224) return n + 16;
    if (n < 4232) return 2688 + (n - 4224);
    if (n < 4236) return 3976 + (n - 4232);
    if (n < 4240) return 3980 + (n - 4236);
    return -1;
}
__device__ __forceinline__ void transpose_item(const float* W, int Nsrc, bf16* WT, LAS float* scr, int kb, int nb, int lane, bool is_win) {
    const int k0 = 64 * kb, n0 = 32 * nb;
    const int n = n0 + (lane & 31); const int sc = is_win ? win_src_col(n) : n;
#pragma unroll 8
    for (int i = 0; i < 32; ++i) { const int kk = 2 * i + (lane >> 5); scr[kk * 33 + (lane & 31)] = (sc >= 0) ? W[(size_t)(k0 + kk) * Nsrc + sc] : 0.f; }
    LDS_WAIT(); asm volatile("" ::: "memory");
    const int c = lane & 7;
#pragma unroll
    for (int j = 0; j < 4; ++j) { const int nn = (lane >> 3) + 8 * j; const LAS float* s = scr + (8 * c) * 33 + nn;
        v4u o; o.x = pk2(s[0 * 33], s[1 * 33]); o.y = pk2(s[2 * 33], s[3 * 33]); o.z = pk2(s[4 * 33], s[5 * 33]); o.w = pk2(s[6 * 33], s[7 * 33]);
        *(v4u*)(WT + (size_t)(n0 + nn) * 1024 + k0 + 8 * c) = o; }
    LDS_WAIT(); asm volatile("" ::: "memory");
}
__device__ __forceinline__ void ln_row(const float* xin, float alpha, const float* hin, const float* g, const float* b, float* xf, bf16* xb, int lane) {
    f32x4 v[4]; float s = 0.f;
#pragma unroll
    for (int j = 0; j < 4; ++j) { v[j] = ((const f32x4*)xin)[lane + 64 * j]; if (hin) v[j] = v[j] * alpha + ((const f32x4*)hin)[lane + 64 * j]; s += (v[j].x + v[j].y) + (v[j].z + v[j].w); }
    const float mean = wave_sum(s) * (1.f / 1024.f); float s2 = 0.f;
#pragma unroll
    for (int j = 0; j < 4; ++j) { v[j] = v[j] - mean; s2 += (v[j].x * v[j].x + v[j].y * v[j].y) + (v[j].z * v[j].z + v[j].w * v[j].w); }
    const float rstd = 1.f / sqrtf(wave_sum(s2) * (1.f / 1024.f) + LN_EPS);
#pragma unroll
    for (int j = 0; j < 4; ++j) { const f32x4 gg = ((const f32x4*)g)[lane + 64 * j], bb = ((const f32x4*)b)[lane + 64 * j]; const f32x4 o = v[j] * rstd * gg + bb;
        ((f32x4*)xf)[lane + 64 * j] = o;
        ((unsigned long long*)xb)[lane + 64 * j] = (unsigned long long)pk2(o.x, o.y) | ((unsigned long long)pk2(o.z, o.w) << 32); }
}
__device__ __forceinline__ void phase_prologue(const Args& a, LAS unsigned char* ldsb, int vcu, int G, int tid) {
    const int lane = tid & 63, wave = tid >> 6;
    LAS float* scr = (LAS float*)(ldsb + wave * 16384);
    const int gw = vcu * NWAVES + wave, NGW = G * NWAVES;
    bf16* WinT = (bf16*)(a.ws + WS_WIN); bf16* WoutT = (bf16*)(a.ws + WS_WOUT);
    constexpr int NB_IN = NPJ / 32, I_IN = 16 * NB_IN, I_OUT = 16 * 32, I_L = I_IN + I_OUT;
    for (int it = gw; it < NLAYER * I_L; it += NGW) {
        const int l = it / I_L; int r = it - l * I_L;
        if (r < I_IN) transpose_item(a.in[11] + (size_t)l * 1024 * NIN, NIN, WinT + (size_t)l * NPJ * 1024, scr, r / NB_IN, r % NB_IN, lane, true);
        else { r -= I_IN; transpose_item(a.in[27] + (size_t)l * 1024 * 1024, 1024, WoutT + (size_t)l * 1024 * 1024, scr, r / 32, r % 32, lane, false); }
    }
    bf16* XB = (bf16*)(a.ws + WS_XB);
    for (int m = gw; m < MROWS; m += NGW) {
        const float* xin = (m < MP) ? a.in[0] + (size_t)m * 1024 : a.in[1] + (size_t)(m - MP) * 1024;
        ln_row(xin, 1.f, nullptr, a.in[9], a.in[10], a.out + (size_t)m * 1024, XB + (size_t)m * 1024, lane);
    }
}

struct Arr6 { float* p[6]; };
__device__ __forceinline__ Arr6 arr6(unsigned char* ws, size_t base) { Arr6 r;
#pragma unroll
    for (int i = 0; i < 6; ++i) r.p[i] = (float*)(ws + base + (size_t)i * ARR_STRIDE); return r; }

__device__ __forceinline__ void rwkv_prep_tile(const Args& a, int l, int tile, LAS float* XS, int tid) {
    const bf16* P = (const bf16*)(a.ws + WS_PROJ);
    const int m0 = tile * 8; const bool samp = m0 >= MP;
    const int t0 = samp ? ((m0 - MP) & 15) : (m0 & 4095); const int bidx = samp ? ((m0 - MP) >> 4) : (m0 >> 12);
    const float* mu = a.in[12] + l * NSHIFT; const float* shst = a.in[5] + ((size_t)l * SBATCH + (samp ? bidx : 0)) * NSHIFT;
    for (int idx = tid; idx < 8 * NSHIFT; idx += NTHREADS) {
        const int tok = idx / NSHIFT, c = idx - tok * NSHIFT;
        const float p = bf2f(P[(size_t)(m0 + tok) * NPJ + c]);
        float prev;
        if (t0 + tok > 0) prev = bf2f(P[(size_t)(m0 + tok - 1) * NPJ + c]); else prev = samp ? shst[c] : 0.f;
        float xs = p + (prev - p) * mu[c];
        if (c >= 768 && c < 832) xs = tanhf(xs);
        XS[tok * NSHIFT + c] = xs;
    }
    __syncthreads();
    const int g = tid >> 8, c = tid & 255, lane = tid & 63, h = c >> 6;
    float accw[4], acca[4];
    { const float w0v = a.in[13][l * 256 + c], a0v = a.in[15][l * 256 + c];
#pragma unroll
      for (int k = 0; k < 4; ++k) { accw[k] = w0v; acca[k] = a0v; } }
    const float* w2 = a.in[14] + (size_t)l * 64 * 256 + c; const float* a2 = a.in[16] + (size_t)l * 64 * 256 + c;
    const LAS float* xg = XS + (g * 4) * NSHIFT;
#pragma unroll 4
    for (int j = 0; j < 64; ++j) { const float wv = w2[j * 256], av = a2[j * 256];
#pragma unroll
        for (int k = 0; k < 4; ++k) { accw[k] += xg[k * NSHIFT + 768 + j] * wv; acca[k] += xg[k * NSHIFT + 832 + j] * av; } }
    const float kkc = a.in[17][l * 256 + c], kac = a.in[18][l * 256 + c], rkc = a.in[19][l * 256 + c];
    Arr6 R = arr6(a.ws, WS_RARR); float* BON = (float*)(a.ws + WS_BONUS);
#pragma unroll
    for (int k = 0; k < 4; ++k) { const int m = m0 + g * 4 + k; const size_t o = (size_t)m * 256 + c;
        const float r = xg[k * NSHIFT + c], kx = xg[k * NSHIFT + 256 + c], v = xg[k * NSHIFT + 512 + c];
        const float wll = -softplus_f(-accw[k]) - 0.5f; const float dec = __expf(-__expf(wll));
        const float aa = sigmoid_f(acca[k]);
        const float kkr = kx * kkc; const float ss = wave_sum(kkr * kkr); const float kkn = kkr / fmaxf(sqrtf(ss), 1e-12f);
        const float kmod = kx * (1.f + (aa - 1.f) * kac);
        const float bon = wave_sum(r * kmod * rkc);
        R.p[0][o] = dec; R.p[1][o] = kkn; R.p[2][o] = -kkn * aa; R.p[3][o] = kmod; R.p[4][o] = r; R.p[5][o] = v;
        if (lane == 0) BON[m * 4 + h] = bon; }
    __syncthreads();
}
__device__ __forceinline__ void gdn_prep_tile(const Args& a, int l, int tile, int tid) {
    const bf16* P = (const bf16*)(a.ws + WS_PROJ); const float* SM = (const float*)(a.ws + WS_SMALL);
    const int m0 = tile * 8; const bool samp = m0 >= MP;
    const int t0 = samp ? ((m0 - MP) & 15) : (m0 & 4095); const int bidx = samp ? ((m0 - MP) >> 4) : (m0 >> 12);
    const int g = tid >> 8, c = tid & 255, lane = tid & 63, h = c >> 6;
    const float* cw = a.in[23] + (size_t)l * 4 * NCONV; const float* cst = a.in[7] + ((size_t)l * SBATCH + (samp ? bidx : 0)) * 3 * NCONV;
    float xr[7][3], cwv[4][3];
#pragma unroll
    for (int i = 0; i < 7; ++i) { const int tt = t0 + g * 4 - 3 + i;
#pragma unroll
        for (int x = 0; x < 3; ++x) { const int col = x * 256 + c;
            if (tt >= 0) xr[i][x] = bf2f(P[(size_t)(m0 - t0 + tt) * NPJ + C_CQKV + col]); else xr[i][x] = samp ? cst[(3 + tt) * NCONV + col] : 0.f; } }
#pragma unroll
    for (int i = 0; i < 4; ++i)
#pragma unroll
        for (int x = 0; x < 3; ++x) cwv[i][x] = cw[i * NCONV + x * 256 + c];
    const float alog = a.in[24][l * 4 + h], dtb = a.in[25][l * 4 + h];
    Arr6 Gm = arr6(a.ws, WS_GARR);
#pragma unroll
    for (int k = 0; k < 4; ++k) { const int m = m0 + g * 4 + k; const size_t o = (size_t)m * 256 + c;
        float y[3];
#pragma unroll
        for (int x = 0; x < 3; ++x) { float s = 0.f;
#pragma unroll
            for (int i = 0; i < 4; ++i) s += cwv[i][x] * xr[k + i][x];
            y[x] = silu_f(s); }
        const float qs = wave_sum(y[0] * y[0]), ks = wave_sum(y[1] * y[1]);
        const float qn = y[0] * (1.f / sqrtf(qs + L2_EPS)) * 0.125f, kn = y[1] * (1.f / sqrtf(ks + L2_EPS));
        const float beta = sigmoid_f(SM[(size_t)m * 16 + 8 + h]);
        const float gg = -__expf(alog) * softplus_f(SM[(size_t)m * 16 + 12 + h] + dtb); const float eg = __expf(gg);
        Gm.p[0][o] = eg; Gm.p[1][o] = kn; Gm.p[2][o] = -eg * beta * kn; Gm.p[3][o] = beta * kn; Gm.p[4][o] = qn; Gm.p[5][o] = y[2]; }
}
__device__ __forceinline__ void fox_cum_prompt(const Args& a, int l, int b, LAS float* SEG, int tid) {
    const float* SM = (const float*)(a.ws + WS_SMALL); const int h = tid & 7, seg = tid >> 3; const float bfv = a.in[22][l * 8 + h];
    float* lfo = a.out + O_FLP + ((size_t)(l * NB + b) * TSEQ) * 8;
    float sum = 0.f;
    for (int i = 0; i < 64; ++i) { const int t = seg * 64 + i; const float lf = logsigmoid_f(SM[((size_t)b * TSEQ + t) * 16 + h] + bfv); lfo[t * 8 + h] = lf; sum += lf; }
    SEG[seg * 8 + h] = sum; __syncthreads();
    float c = 0.f; for (int s = 0; s < seg; ++s) c += SEG[s * 8 + h];
    float* CB = (float*)(a.ws + WS_CB) + (size_t)(b * 8 + h) * TSEQ;
    for (int i = 0; i < 64; ++i) { const int t = seg * 64 + i; const float lf = logsigmoid_f(SM[((size_t)b * TSEQ + t) * 16 + h] + bfv); c += lf; CB[t] = c * LOG2E; }
    __syncthreads();
}
__device__ __forceinline__ void fox_cum_sample(const Args& a, int l, int b, LAS float* SEG, int tid) {
    const float* SM = (const float*)(a.ws + WS_SMALL); const int h = tid & 7, seg = tid >> 3; const float bfv = a.in[22][l * 8 + h];
    const float* clf = a.in[4] + ((size_t)(l * SBATCH + b) * PAST) * 8;
    float sum = 0.f;
    for (int i = 0; i < 32; ++i) sum += clf[(seg * 32 + i) * 8 + h];
    SEG[seg * 8 + h] = sum; __syncthreads();
    float post = 0.f; for (int s = seg + 1; s < 64; ++s) post += SEG[s * 8 + h];
    float* CBS = (float*)(a.ws + WS_CBS) + (size_t)(b * 8 + h) * 2064;
    for (int i = 31; i >= 0; --i) { const int j = seg * 32 + i; CBS[j] = post * LOG2E; post += clf[j * 8 + h]; }
    if (seg == 0) { float run = 0.f; float* lfo = a.out + O_FLS + ((size_t)(l * SBATCH + b) * STOK) * 8;
        for (int i = 0; i < STOK; ++i) { const float lf = logsigmoid_f(SM[((size_t)MP + b * STOK + i) * 16 + h] + bfv); lfo[i * 8 + h] = lf; run += lf; CBS[PAST + i] = -run * LOG2E; } }
    __syncthreads();
}
__device__ __forceinline__ void phase_prep(const Args& a, int l, LAS unsigned char* ldsb, int vcu, int G, int tid) {
    LAS float* XS = (LAS float*)ldsb;
    for (int tile = vcu; tile < MROWS / 8; tile += G) { rwkv_prep_tile(a, l, tile, XS, tid); gdn_prep_tile(a, l, tile, tid); }
    LAS float* SEG = (LAS float*)(ldsb + 32768);
    for (int u = vcu; u < NB + SBATCH; u += G) { if (u < NB) fox_cum_prompt(a, l, u, SEG, tid); else fox_cum_sample(a, l, u - NB, SEG, tid); }
    const bf16* P = (const bf16*)(a.ws + WS_PROJ);
    for (int idx = vcu * NTHREADS + tid; idx < (NB + SBATCH) * 3200; idx += G * NTHREADS) {
        const int seq = idx / 3200, r = idx - seq * 3200; const bool pr = seq < NB; const int b = pr ? seq : seq - NB;
        const size_t last = pr ? (size_t)b * TSEQ + (TSEQ - 1) : (size_t)MP + b * STOK + (STOK - 1);
        if (r < NSHIFT) { const float v = bf2f(P[last * NPJ + r]); a.out[(pr ? O_SHP + (size_t)(l * NB + b) * NSHIFT : O_SHS + (size_t)(l * SBATCH + b) * NSHIFT) + r] = v; }
        else { const int r2 = r - NSHIFT, i = r2 / NCONV, c = r2 - i * NCONV; const float v = bf2f(P[(last - 2 + i) * NPJ + C_CQKV + c]);
            a.out[(pr ? O_CVP + (size_t)(l * NB + b) * 3 * NCONV : O_CVS + (size_t)(l * SBATCH + b) * 3 * NCONV) + i * NCONV + c] = v; }
    }
}
constexpr int SC_TS = 32, SC_BUF = SC_TS * 5 * 64 * 4, SC_VS_OFF = 2 * SC_BUF, SC_VS = SC_TS * 32 * 4, SC_OS_OFF = SC_VS_OFF + 2 * SC_VS, SC_END = SC_OS_OFF + 2 * SC_VS;
static_assert(SC_END <= PH_SCRATCH, "scan LDS");
__device__ __forceinline__ void scan_unit(LAS unsigned char* ldsb, const Arr6& X, float* O, int rowbase, int nsteps, int h, int half,
                                          const float* s_init, float* s_out, bool transposed, int tid) {
    const int lane = tid & 63, wave = tid >> 6, j = lane & 15, rg = lane >> 4, row = 32 * half + 4 * wave + rg;
    f32x4 s = (f32x4){0.f, 0.f, 0.f, 0.f};
    if (s_init) { if (!transposed) s = *(const f32x4*)(s_init + row * 64 + 4 * j);
                  else { s.x = s_init[(4 * j + 0) * 64 + row]; s.y = s_init[(4 * j + 1) * 64 + row]; s.z = s_init[(4 * j + 2) * 64 + row]; s.w = s_init[(4 * j + 3) * 64 + row]; } }
    const int lt = tid >> 4, lq = tid & 15;
    const int colw = h * 64 + lq * 4, colv = h * 64 + 32 * half + lq * 2;
    const int nchunks = (nsteps + SC_TS - 1) / SC_TS;
    f32x4 ld[5]; f32x2 lv;
#define SC_GLOAD(c_) do { const int t_ = (c_) * SC_TS + lt; if (t_ < nsteps) { const size_t ro_ = (size_t)(rowbase + t_) * 256; \
        _Pragma("unroll") for (int q_ = 0; q_ < 5; ++q_) ld[q_] = *(const f32x4*)(X.p[q_] + ro_ + colw); lv = *(const f32x2*)(X.p[5] + ro_ + colv); } \
        else { _Pragma("unroll") for (int q_ = 0; q_ < 5; ++q_) ld[q_] = (f32x4){0.f, 0.f, 0.f, 0.f}; lv = (f32x2){0.f, 0.f}; } } while (0)
#define SC_LSTORE(b_) do { LAS float* B_ = (LAS float*)(ldsb + (b_) * SC_BUF); \
        _Pragma("unroll") for (int q_ = 0; q_ < 5; ++q_) *(LAS f32x4*)(B_ + (lt * 5 + q_) * 64 + lq * 4) = ld[q_]; \
        *(LAS f32x2*)((LAS float*)(ldsb + SC_VS_OFF + (b_) * SC_VS) + lt * 32 + lq * 2) = lv; } while (0)
    SC_GLOAD(0); SC_LSTORE(0); __syncthreads();
    for (int c = 0; c < nchunks; ++c) {
        const int b = c & 1;
        if (c + 1 < nchunks) SC_GLOAD(c + 1);
        const int steps = (nsteps - c * SC_TS) < SC_TS ? (nsteps - c * SC_TS) : SC_TS;
        const LAS float* Bf = (const LAS float*)(ldsb + b * SC_BUF) + 4 * j;
        const LAS float* VSb = (const LAS float*)(ldsb + SC_VS_OFF + b * SC_VS) + 4 * wave + rg;
        LAS float* OSb = (LAS float*)(ldsb + SC_OS_OFF + b * SC_VS);
#pragma unroll 4
        for (int tt = 0; tt < steps; ++tt) {
            const f32x4 W4 = *(const LAS f32x4*)(Bf + (tt * 5 + 0) * 64), A4 = *(const LAS f32x4*)(Bf + (tt * 5 + 1) * 64), B4 = *(const LAS f32x4*)(Bf + (tt * 5 + 2) * 64),
                        K4 = *(const LAS f32x4*)(Bf + (tt * 5 + 3) * 64), R4 = *(const LAS f32x4*)(Bf + (tt * 5 + 4) * 64);
            const float v = VSb[tt * 32];
            float d = (s.x * A4.x + s.y * A4.y) + (s.z * A4.z + s.w * A4.w); d = row16_sum(d);
            s = s * W4 + d * B4 + v * K4;
            float o = (s.x * R4.x + s.y * R4.y) + (s.z * R4.z + s.w * R4.w); o = row16_sum(o);
            if (j == 0) OSb[tt * 32 + 4 * wave + rg] = o;
        }
        if (c + 1 < nchunks) SC_LSTORE(b ^ 1);
        __syncthreads();
        { const int t_ = c * SC_TS + lt; if (t_ < nsteps) *(f32x2*)(O + (size_t)(rowbase + t_) * 256 + colv) = *(const LAS f32x2*)(OSb + lt * 32 + lq * 2); }
    }
#undef SC_GLOAD
#undef SC_LSTORE
    if (!transposed) *(f32x4*)(s_out + row * 64 + 4 * j) = s;
    else { s_out[(4 * j + 0) * 64 + row] = s.x; s_out[(4 * j + 1) * 64 + row] = s.y; s_out[(4 * j + 2) * 64 + row] = s.z; s_out[(4 * j + 3) * 64 + row] = s.w; }
    __syncthreads();
}
__device__ __forceinline__ void scan_prompt_unit(const Args& a, int l, int u, LAS unsigned char* ldsb, int tid) {
    const int mixer = u >> 6, bh = (u & 63) >> 1, half = u & 1, b = bh >> 2, h = bh & 3;
    const Arr6 X = arr6(a.ws, mixer ? WS_GARR : WS_RARR); float* O = (float*)(a.ws + (mixer ? WS_OG : WS_OA));
    float* so = a.out + (mixer ? O_GDP : O_RWP) + ((size_t)(l * NB + b) * 4 + h) * 4096;
    scan_unit(ldsb, X, O, b * TSEQ, TSEQ, h, half, nullptr, so, mixer != 0, tid);
}
__device__ __forceinline__ void scan_sample_unit(const Args& a, int l, int u, LAS unsigned char* ldsb, int tid) {
    const int mixer = u >> 8, bh = (u & 255) >> 1, half = u & 1, b = bh >> 2, h = bh & 3;
    const Arr6 X = arr6(a.ws, mixer ? WS_GARR : WS_RARR); float* O = (float*)(a.ws + (mixer ? WS_OG : WS_OA));
    const size_t so_ = ((size_t)(l * SBATCH + b) * 4 + h) * 4096;
    scan_unit(ldsb, X, O, MP + b * STOK, STOK, h, half, a.in[mixer ? 8 : 6] + so_, a.out + (mixer ? O_GDS : O_RWS) + so_, mixer != 0, tid);
}

__device__ __forceinline__ void fox_sample_unit(const Args& a, int l, int bh, LAS unsigned char* ldsb, int tid) {
    const int b = bh >> 3, h = bh & 7, lane = tid & 63, wave = tid >> 6, j = lane & 15, rg = lane >> 4;
    const bf16* P = (const bf16*)(a.ws + WS_PROJ); const int m0 = MP + b * STOK;
    float qv[16][4];
#pragma unroll
    for (int q = 0; q < 16; ++q) { const unsigned long long w = *(const unsigned long long*)(P + (size_t)(m0 + q) * NPJ + C_Q + h * 64 + 4 * j);
        qv[q][0] = __uint_as_float((unsigned)(w & 0xffffu) << 16); qv[q][1] = __uint_as_float((unsigned)(w >> 16 & 0xffffu) << 16);
        qv[q][2] = __uint_as_float((unsigned)(w >> 32 & 0xffffu) << 16); qv[q][3] = __uint_as_float((unsigned)(w >> 48 & 0xffffu) << 16); }
    float mx[16], ls[16], o[16][4];
#pragma unroll
    for (int q = 0; q < 16; ++q) { mx[q] = -1e30f; ls[q] = 0.f; o[q][0] = 0.f; o[q][1] = 0.f; o[q][2] = 0.f; o[q][3] = 0.f; }
    const float* Kc = a.in[2] + ((size_t)(l * SBATCH + b) * PAST * 8 + h) * 64 + 4 * j; const float* Vc = a.in[3] + ((size_t)(l * SBATCH + b) * PAST * 8 + h) * 64 + 4 * j;
    const float* Kn = a.out + O_FKS + ((size_t)(l * SBATCH + b) * STOK * 8 + h) * 64 + 4 * j; const float* Vn = a.out + O_FVS + ((size_t)(l * SBATCH + b) * STOK * 8 + h) * 64 + 4 * j;
    const float* bias = (const float*)(a.ws + WS_CBS) + (size_t)bh * 2064;
    constexpr int NKEY = PAST + STOK, NIT = (NKEY + 31) / 32;
    f32x4 k4, v4; float bs; int kc;
#define FS_LOAD(it_) do { const int key_ = (it_) * 32 + wave * 4 + rg; kc = key_ < NKEY ? key_ : NKEY - 1; \
        const float* kp_ = kc < PAST ? Kc + (size_t)kc * 512 : Kn + (size_t)(kc - PAST) * 512; const float* vp_ = kc < PAST ? Vc + (size_t)kc * 512 : Vn + (size_t)(kc - PAST) * 512; \
        k4 = *(const f32x4*)kp_; v4 = *(const f32x4*)vp_; bs = bias[kc]; if (key_ >= NKEY) kc = 1 << 20; } while (0)
    FS_LOAD(0);
    for (int it = 0; it < NIT; ++it) {
        const f32x4 kk = k4, vv = v4; const float bb = bs; const int kcur = kc;
        if (it + 1 < NIT) FS_LOAD(it + 1);
#pragma unroll
        for (int q = 0; q < 16; ++q) {
            float s = (qv[q][0] * kk.x + qv[q][1] * kk.y) + (qv[q][2] * kk.z + qv[q][3] * kk.w); s = row16_sum(s) + bb;
            if (kcur - PAST > q) s = -INFINITY;
            const float mn = fmaxf(mx[q], s); const float p = __builtin_amdgcn_exp2f(s - mn), cr = __builtin_amdgcn_exp2f(mx[q] - mn);
            ls[q] = ls[q] * cr + p; o[q][0] = o[q][0] * cr + p * vv.x; o[q][1] = o[q][1] * cr + p * vv.y; o[q][2] = o[q][2] * cr + p * vv.z; o[q][3] = o[q][3] * cr + p * vv.w; mx[q] = mn;
        }
    }
#undef FS_LOAD
    LAS float* PM = (LAS float*)ldsb; LAS float* PL = PM + 128; LAS float* PO = PM + 256;
#pragma unroll
    for (int q = 0; q < 16; ++q) {
        float mt = fmaxf(mx[q], __shfl_xor(mx[q], 16)); mt = fmaxf(mt, __shfl_xor(mt, 32));
        const float sc = __builtin_amdgcn_exp2f(mx[q] - mt);
        float lq = ls[q] * sc; lq += __shfl_xor(lq, 16); lq += __shfl_xor(lq, 32);
        float ov[4];
#pragma unroll
        for (int i = 0; i < 4; ++i) { ov[i] = o[q][i] * sc; ov[i] += __shfl_xor(ov[i], 16); ov[i] += __shfl_xor(ov[i], 32); }
        if (rg == 0) { if (j == 0) { PM[wave * 16 + q] = mt; PL[wave * 16 + q] = lq; } *(LAS f32x4*)(PO + (wave * 16 + q) * 64 + 4 * j) = (f32x4){ov[0], ov[1], ov[2], ov[3]}; }
    }
    __syncthreads();
    { const int q = tid >> 5, d = (tid & 31) * 2;
      float M_ = PM[q];
#pragma unroll
      for (int w = 1; w < 8; ++w) M_ = fmaxf(M_, PM[w * 16 + q]);
      float L_ = 0.f, o0 = 0.f, o1 = 0.f;
#pragma unroll
      for (int w = 0; w < 8; ++w) { const float e = __builtin_amdgcn_exp2f(PM[w * 16 + q] - M_); L_ += PL[w * 16 + q] * e; o0 += PO[(w * 16 + q) * 64 + d] * e; o1 += PO[(w * 16 + q) * 64 + d + 1] * e; }
      const unsigned zz = *(const unsigned*)(P + (size_t)(m0 + q) * NPJ + C_BZ + h * 64 + d);
      const float z0 = __uint_as_float(zz << 16), z1 = __uint_as_float(zz & 0xffff0000u);
      const float r = 1.f / L_;
      bf16* OC = (bf16*)(a.ws + WS_OC);
      *(unsigned*)(OC + (size_t)(m0 + q) * 1024 + 256 + h * 64 + d) = pk2(o0 * r * silu_f(z0), o1 * r * silu_f(z1)); }
    __syncthreads();
}

__device__ __forceinline__ void phase_post(const Args& a, int l, int vcu, int G, int tid) {
    const int lane = tid & 63, wave = tid >> 6; const int gw = vcu * NWAVES + wave, NGW = G * NWAVES;
    const bf16* P = (const bf16*)(a.ws + WS_PROJ); bf16* OC = (bf16*)(a.ws + WS_OC);
    const float* OA = (const float*)(a.ws + WS_OA); const float* OG = (const float*)(a.ws + WS_OG); const float* BON = (const float*)(a.ws + WS_BONUS);
    const float* RV = (const float*)(a.ws + WS_RARR + 5 * ARR_STRIDE);
    float gng[4], gnb[4];
#pragma unroll
    for (int hh = 0; hh < 4; ++hh) { gng[hh] = a.in[20][l * 256 + hh * 64 + lane]; gnb[hh] = a.in[21][l * 256 + hh * 64 + lane]; }
    const float ng = a.in[26][l * 64 + lane];
    for (int m = gw; m < MROWS; m += NGW) {
#pragma unroll
        for (int hh = 0; hh < 4; ++hh) { const int c = hh * 64 + lane;
            const float o = OA[(size_t)m * 256 + c]; const float mean = wave_sum(o) * (1.f / 64.f); const float d = o - mean; const float var = wave_sum(d * d) * (1.f / 64.f);
            float y = d * (1.f / sqrtf(var + GN_EPS)) * gng[hh] + gnb[hh];
            y += BON[(size_t)m * 4 + hh] * RV[(size_t)m * 256 + c];
            y *= silu_f(bf2f(P[(size_t)m * NPJ + C_AZ + c]));
            OC[(size_t)m * 1024 + c] = (bf16)f2bf(y); }
#pragma unroll
        for (int hh = 0; hh < 4; ++hh) { const int c = hh * 64 + lane;
            const float o = OG[(size_t)m * 256 + c]; const float ms = wave_sum(o * o) * (1.f / 64.f);
            float y = o * (1.f / sqrtf(ms + GDN_EPS)) * ng;
            y *= silu_f(bf2f(P[(size_t)m * NPJ + C_CZ + c]));
            OC[(size_t)m * 1024 + 768 + c] = (bf16)f2bf(y); }
    }
}
__device__ __forceinline__ void phase_ln(const Args& a, int l, int vcu, int G, int tid) {
    const int lane = tid & 63, wave = tid >> 6; const int gw = vcu * NWAVES + wave, NGW = G * NWAVES;
    const float* H = (const float*)(a.ws + WS_H); bf16* XB = (bf16*)(a.ws + WS_XB);
    for (int m = gw; m < MROWS; m += NGW) ln_row(a.out + (size_t)m * 1024, ALPHA, H + (size_t)m * 1024, a.in[28] + l * 1024, a.in[29] + l * 1024, a.out + (size_t)m * 1024, XB + (size_t)m * 1024, lane);
}
#ifndef MK_FUSED
#define MK_FUSED 1
#endif
constexpr int CW_BAR = 4096;
constexpr int NPHASE = 6;

__global__ void __launch_bounds__(NTHREADS, 2) trunk_fwd(Args a) {
    extern __shared__ __attribute__((aligned(16))) unsigned char lds[];
    LAS unsigned char* ldsb = (LAS unsigned char*)lds;
    const int tid0 = threadIdx.x; const int tid = tid0;
    constexpr int G = 256; const int bx = blockIdx.x; const int vcu = (bx % 8) * (G / 8) + bx / 8;
    volatile LAS unsigned* MISC = (volatile LAS unsigned*)(ldsb + MISC_OFF);
    for (int u = tid; u < 128; u += NTHREADS) ((LAS unsigned*)(ldsb + MISC_OFF))[u] = 0u;
    __syncthreads();
    unsigned* ctl = (unsigned*)(a.ws + WS_CTL);
    XcdBarrier bar; bar.bar = ctl + CW_BAR; bar.x = 0; bar.st = nullptr;
    if (a.fused) bar = xcd_barrier_post(ctl + CW_BAR, MISC + 8);
#define SEAM() do { if (fused) xcd_barrier(bar); } while (0)
#ifndef PHMASK
#define PHMASK 0xFFFF
#endif
#define IN(k) (((PHMASK >> (k)) & 1) && ph_lo <= (k) && (k) < ph_hi)

    if (((PHMASK >> 8) & 1) && a.do_pro) { const int fused = a.fused; phase_prologue(a, ldsb, vcu, G, tid); SEAM(); }

    for (int l = a.l_lo; l < a.l_hi; ++l) {
        int ph_lo = a.ph_lo, ph_hi = a.ph_hi, fused = a.fused; asm volatile("" : "+s"(ph_lo), "+s"(ph_hi), "+s"(fused));
#define LAUNDER() int tid = tid0; asm volatile("" : "+v"(tid)); Args al = a; int bxl = bx; asm volatile("" : "+s"(al.ws), "+s"(al.out), "+s"(bxl)); const int vcul = (bxl % 8) * (G / 8) + bxl / 8; (void)vcul
        if (IN(0)) { LAUNDER(); (void)tid;
            pg8::Gemm g{(const bf16*)(al.ws + WS_XB), (const bf16*)(al.ws + WS_WIN) + (size_t)l * NPJ * 1024, MROWS, NPJ, DMODEL}; pg8::StaticOrder S; S.init(MROWS, NPJ, G, bxl);
            pg8::EpiProj E{(bf16*)(al.ws + WS_PROJ), (float*)(al.ws + WS_SMALL), al.out + O_FKP + (size_t)l * MP * 512, al.out + O_FVP + (size_t)l * MP * 512, al.out + O_FKS + (size_t)l * MS * 512, al.out + O_FVS + (size_t)l * MS * 512};
            pg8::gemm_phase<pg8::EpiProj, pg8::StaticOrder, true, true>(ldsb, g, S, E);
            SEAM();
        }
        if (IN(1)) { LAUNDER(); phase_prep(al, l, ldsb, vcul, G, tid); SEAM(); }
        if (IN(2)) {
#ifndef P2MASK
#define P2MASK 7
#endif
            if (!(P2MASK & 1)) {} else if (bx < 128) { LAUNDER(); scan_prompt_unit(al, l, bxl, ldsb, tid); }
            else { for (int i = 0; i < 4; ++i) { LAUNDER(); scan_sample_unit(al, l, (bxl - 128) * 4 + i, ldsb, tid); } }
            if (P2MASK & 2) { LAUNDER(); (void)tid; const bf16* PJ = (const bf16*)(al.ws + WS_PROJ);
              const attn_body::AttnTensors AT{(const attn_body::bf16*)(PJ + C_Q), (const attn_body::bf16*)(PJ + C_K), (const attn_body::bf16*)(PJ + C_V), (const attn_body::bf16*)(PJ + C_BZ),
                                             (const float*)(al.ws + WS_CB), (attn_body::bf16*)((bf16*)(al.ws + WS_OC) + 256)};
              const attn_body::StaticOrder S(G, bxl);
              attn_body::attn_phase<attn_body::StaticOrder>((char*)lds, AT, S); }
            if (P2MASK & 4) for (int u = bx; u < SBATCH * 8; u += G) { LAUNDER(); fox_sample_unit(al, l, u, ldsb, tid); }
            SEAM();
        }
        if (IN(3)) { LAUNDER(); phase_post(al, l, vcul, G, tid); SEAM(); }
        if (IN(4)) { LAUNDER(); (void)tid;
            pg8::Gemm g{(const bf16*)(al.ws + WS_OC), (const bf16*)(al.ws + WS_WOUT) + (size_t)l * 1024 * 1024, MROWS, DMODEL, DMODEL}; pg8::StaticOrder S; S.init(MROWS, DMODEL, G, bxl);
            pg8::EpiF32 E{(float*)(al.ws + WS_H), DMODEL};
            pg8::gemm_phase<pg8::EpiF32, pg8::StaticOrder, true, true>(ldsb, g, S, E);
            SEAM();
        }
        if (IN(5)) { LAUNDER(); phase_ln(al, l, vcul, G, tid); if (l + 1 < a.l_hi || !IN(5)) SEAM(); }
    }
#undef SEAM
#undef IN
}

extern "C" void kernel_launch(void* const* d_in, const int* in_sizes, int n_in, void* d_out, int out_size, void* d_ws, size_t ws_size, hipStream_t stream) {
    static int grid = 0;
    if (grid == 0) {
        if (n_in != 30 || (size_t)out_size != O_END || ws_size < WS_END) { fprintf(stderr, "kernel_launch: unexpected sizes: n_in %d out %d ws %zu (need %zu); nothing launched\n", n_in, out_size, ws_size, (size_t)WS_END); grid = -1; return; }
        int dev = 0, cus = 0, per_cu = 0;
        if (hipGetDevice(&dev) != hipSuccess || hipDeviceGetAttribute(&cus, hipDeviceAttributeMultiprocessorCount, dev) != hipSuccess) { fprintf(stderr, "kernel_launch: device query failed\n"); grid = -1; return; }
        if (hipFuncSetAttribute((const void*)trunk_fwd, hipFuncAttributeMaxDynamicSharedMemorySize, LDS_BYTES) != hipSuccess) { fprintf(stderr, "kernel_launch: hipFuncSetAttribute failed\n"); grid = -1; return; }
        if (hipOccupancyMaxActiveBlocksPerMultiprocessor(&per_cu, (const void*)trunk_fwd, NTHREADS, LDS_BYTES) != hipSuccess || per_cu < 1) fprintf(stderr, "kernel_launch: note: occupancy query reports %d workgroups per CU\n", per_cu);
        (void)hipGetLastError();
        if (cus < 256) { fprintf(stderr, "kernel_launch: %d CUs; this kernel needs 256 resident workgroups\n", cus); grid = -1; return; }
        grid = 256;
    }
    if (grid < 0) return;
    (void)in_sizes;
    if (hipMemsetAsync((char*)d_ws + WS_CTL, 0, CTL_ZERO_BYTES, stream) != hipSuccess) { fprintf(stderr, "kernel_launch: memset failed\n"); return; }
    Args a{};
    for (int i = 0; i < 30; ++i) a.in[i] = (const float*)d_in[i];
    a.out = (float*)d_out; a.ws = (unsigned char*)d_ws;
#if MK_FUSED
    a.do_pro = 1; a.fused = 1; a.l_lo = 0; a.l_hi = NLAYER; a.ph_lo = 0; a.ph_hi = NPHASE;
    hipLaunchKernelGGL(trunk_fwd, dim3(grid), dim3(NTHREADS), LDS_BYTES, stream, a);
#else
    a.fused = 0; a.do_pro = 1; a.l_lo = 0; a.l_hi = 0; a.ph_lo = 0; a.ph_hi = 0;
    hipLaunchKernelGGL(trunk_fwd, dim3(grid), dim3(NTHREADS), LDS_BYTES, stream, a);
    a.do_pro = 0;
    for (int l = 0; l < NLAYER; ++l) for (int ph = 0; ph < NPHASE; ++ph) { a.l_lo = l; a.l_hi = l + 1; a.ph_lo = ph; a.ph_hi = ph + 1;
        hipLaunchKernelGGL(trunk_fwd, dim3(grid), dim3(NTHREADS), LDS_BYTES, stream, a); }
#endif
    const hipError_t le = hipPeekAtLastError();
    if (le != hipSuccess) fprintf(stderr, "kernel_launch: launch failed: %s\n", hipGetErrorName(le));
}
```

```cpp
#include <hip/hip_runtime.h>
#include <hip/hip_bf16.h>
#include <cstdio>
#include <cstdint>
#include <cmath>

constexpr int DMODEL = 1024, NB = 8, TSEQ = 4096, NLAYER = 4, SBATCH = 32, STOK = 16, PAST = 2048;
constexpr int MP = NB * TSEQ, MS = SBATCH * STOK, MROWS = MP + MS;
constexpr int NIN = 4240, NPJ = 4352;
constexpr int C_ASH = 0, C_AZ = 896, C_Q = 1152, C_K = 1664, C_V = 2176, C_BZ = 2688, C_CQKV = 3200, C_CZ = 3968, C_SM = 4224;
constexpr int NSHIFT = 896, NCONV = 768;
constexpr float LOG2E = 1.4426950408889634f;
constexpr float QSCALE = 0.125f * LOG2E;
constexpr float ALPHA = 1.681792830507429f;
constexpr float LN_EPS = 1e-5f, GN_EPS = 64e-5f, GDN_EPS = 1e-6f, L2_EPS = 1e-6f;

constexpr size_t O_YP = 0, O_YS = O_YP + (size_t)MP * DMODEL;
constexpr size_t O_FKP = O_YS + (size_t)MS * DMODEL, O_FVP = O_FKP + (size_t)NLAYER * MP * 512, O_FLP = O_FVP + (size_t)NLAYER * MP * 512;
constexpr size_t O_SHP = O_FLP + (size_t)NLAYER * MP * 8, O_RWP = O_SHP + (size_t)NLAYER * NB * NSHIFT, O_CVP = O_RWP + (size_t)NLAYER * NB * 4 * 4096;
constexpr size_t O_GDP = O_CVP + (size_t)NLAYER * NB * 3 * NCONV;
constexpr size_t O_FKS = O_GDP + (size_t)NLAYER * NB * 4 * 4096, O_FVS = O_FKS + (size_t)NLAYER * MS * 512, O_FLS = O_FVS + (size_t)NLAYER * MS * 512;
constexpr size_t O_SHS = O_FLS + (size_t)NLAYER * MS * 8, O_RWS = O_SHS + (size_t)NLAYER * SBATCH * NSHIFT, O_CVS = O_RWS + (size_t)NLAYER * SBATCH * 4 * 4096;
constexpr size_t O_GDS = O_CVS + (size_t)NLAYER * SBATCH * 3 * NCONV, O_END = O_GDS + (size_t)NLAYER * SBATCH * 4 * 4096;
static_assert(O_END == 177213440ull, "output size");

constexpr size_t MiB = 1u << 20;
constexpr size_t WS_CTL = 0, CTL_ZERO_BYTES = 1 * MiB;
constexpr size_t WS_WIN = 1 * MiB;
constexpr size_t WS_WOUT = 36 * MiB;
constexpr size_t WS_XB = 44 * MiB;
constexpr size_t WS_PROJ = 112 * MiB;
constexpr size_t WS_SMALL = 392 * MiB;
constexpr size_t WS_OC = 396 * MiB;
constexpr size_t WS_H = 464 * MiB;
constexpr size_t WS_CB = 596 * MiB;
constexpr size_t WS_CBS = 597 * MiB;
constexpr size_t WS_BONUS = 600 * MiB;
constexpr size_t WS_OA = 602 * MiB;
constexpr size_t WS_OG = 636 * MiB;
constexpr size_t WS_RARR = 672 * MiB, ARR_STRIDE = 33 * MiB;
constexpr size_t WS_GARR = 870 * MiB;
constexpr size_t WS_END = 1068 * MiB;
static_assert(WS_WIN + (size_t)NLAYER * NPJ * DMODEL * 2 <= WS_WOUT && WS_XB + (size_t)MROWS * DMODEL * 2 <= WS_PROJ && WS_PROJ + (size_t)MROWS * NPJ * 2 <= WS_SMALL, "ws map 1");
static_assert(WS_OC + (size_t)MROWS * DMODEL * 2 <= WS_H && WS_H + (size_t)MROWS * DMODEL * 4 <= WS_CB && WS_CBS + (size_t)256 * 2064 * 4 <= WS_BONUS && WS_OA + (size_t)MROWS * 256 * 4 <= WS_OG && WS_OG + (size_t)MROWS * 256 * 4 <= WS_RARR, "ws map 2");
static_assert((size_t)MROWS * 256 * 4 <= ARR_STRIDE, "ws map 3");

namespace pg8 {
#define PG8_LAS __attribute__((address_space(3)))
#define PG8_GAS __attribute__((address_space(1)))
typedef unsigned short bf16_t;
typedef short bf16x8 __attribute__((ext_vector_type(8)));
typedef float f32x4 __attribute__((ext_vector_type(4)));
typedef unsigned u32x4 __attribute__((ext_vector_type(4)));
constexpr int BM = 256, BK = 64, HALF = 128, HTB = HALF * BK * 2  , STAGE_BYTES = 8 * HTB, NXCD = 8, WGM = 8;

__host__ __device__ __forceinline__ int lds_byte(int r, int c) { const int st = (r >> 4) * 2 + (c >> 5), rr = r & 15, cc = c & 31, ob = rr * 64 + cc * 2; return st * 1024 + (ob ^ (((ob >> 9) & 1) << 5)); }
__host__ __device__ __forceinline__ void stage_rc(int b, int& R, int& C) { const int st = b / 1024, sb = b % 1024, swz = sb ^ (((sb >> 9) & 1) << 5); R = (st >> 1) * 16 + swz / 64; C = (st & 1) * 32 + (swz % 64) / 2; }
__host__ __device__ __forceinline__ int perm32(int rho) { const int n = rho >> 4, i = rho & 15; return 8 * (i >> 2) + 4 * n + (i & 3); }

struct Unit { int pm, pn; };
struct Gemm { const bf16_t* A; const bf16_t* Bt; int M, N, K; };

struct StaticOrder {
    int nM, nN, nwg, G, c;
    __host__ __device__ void init(int M, int N, int G_, int c_) { nM = M / BM; nN = N / BM; nwg = nM * nN; G = G_; c = c_; }
    __host__ __device__ bool next(int i, Unit& u) const {
        const long L = (long)i * G + c; if (L >= nwg) return false;
        int wgid = (int)L; { const int q = nwg / NXCD, r = nwg % NXCD, xcd = wgid % NXCD, off = wgid / NXCD; wgid = (xcd < r ? xcd * (q + 1) : r * (q + 1) + (xcd - r) * q) + off; }
        const int nig = WGM * nN, gid = wgid / nig, fm = gid * WGM, gsz = (nM - fm) < WGM ? (nM - fm) : WGM;
        u.pm = fm + ((wgid % nig) % gsz); u.pn = (wgid % nig) / gsz; return true;
    }
    __device__ __forceinline__ void a_ready(const Unit&) const {}
    __device__ __forceinline__ void done(const Unit&) const {}
};

__device__ __forceinline__ unsigned cvt_pk_bf16(float lo, float hi) { unsigned r; asm volatile("v_cvt_pk_bf16_f32 %0, %1, %2" : "=v"(r) : "v"(lo), "v"(hi)); return r; }
struct EpiProj {
    static constexpr bool PERM = true, AFTER_DRAIN = false;
    bf16_t* P; bf16_t* KV; float* small; float* kp; float* vp; float* ks; float* vs;
    __device__ __forceinline__ void operator()(const f32x4 (&acc)[2][2][4][2], const Unit& u, int wr, int wc, int fr, int fq) const {
        const int row0 = u.pm * BM + wr * 64 + fr, col0 = u.pn * BM + wc * 32 + 8 * fq;
        const bool prow = (u.pm * BM) < MP;
#pragma unroll
        for (int ai = 0; ai < 2; ++ai)
#pragma unroll
            for (int m = 0; m < 4; ++m) { const int row = row0 + ai * HALF + m * 16;
#pragma unroll
                for (int bj = 0; bj < 2; ++bj) { const int col = col0 + bj * HALF, cb = 2 * u.pn + bj;
                    f32x4 v0 = acc[ai][bj][m][0], v1 = acc[ai][bj][m][1];
                    if (cb >= 13 && cb < 21) {
                        float* dst;
                        if (cb < 17) dst = (prow ? kp + (size_t)row * 512 : ks + (size_t)(row - MP) * 512) + (col - C_K);
                        else         dst = (prow ? vp + (size_t)row * 512 : vs + (size_t)(row - MP) * 512) + (col - C_V);
                        __builtin_nontemporal_store(v0, (PG8_GAS f32x4*)dst); __builtin_nontemporal_store(v1, (PG8_GAS f32x4*)(dst + 4));
                    }
                    if (cb == 33 && col < C_SM + 16) { float* dst = small + (size_t)row * 16 + (col - C_SM); *(PG8_GAS f32x4*)dst = v0; *(PG8_GAS f32x4*)(dst + 4) = v1; }
                    if (cb >= 9 && cb < 13) { v0 = v0 * QSCALE; v1 = v1 * QSCALE; }
                    u32x4 w; w.x = cvt_pk_bf16(v0[0], v0[1]); w.y = cvt_pk_bf16(v0[2], v0[3]); w.z = cvt_pk_bf16(v1[0], v1[1]); w.w = cvt_pk_bf16(v1[2], v1[3]);
                    if (cb >= 13 && cb < 21) { const int ck = col - C_K, hk = (ck >> 6) & 7, dk = ck & 63;
                        bf16_t* tb = KV + ((size_t)(row >> 6) * 8 + hk) * 8192 + (ck < 512 ? (dk >> 3) * 512 + (row & 63) * 8 : 4096 + (dk >> 5) * 2048 + (row & 63) * 32 + (dk & 31));
                        *(PG8_GAS u32x4*)tb = w; }
                    else *(PG8_GAS u32x4*)(P + (size_t)row * NPJ + col) = w; } }
    }
};
struct EpiH {
    static constexpr bool PERM = true, AFTER_DRAIN = false;
    bf16_t* H; int ldc;
    __device__ __forceinline__ void operator()(const f32x4 (&acc)[2][2][4][2], const Unit& u, int wr, int wc, int fr, int fq) const {
        const int row0 = u.pm * BM + wr * 64 + fr, col0 = u.pn * BM + wc * 32 + 8 * fq;
#pragma unroll
        for (int ai = 0; ai < 2; ++ai)
#pragma unroll
            for (int m = 0; m < 4; ++m) { bf16_t* rowp = H + (size_t)(row0 + ai * HALF + m * 16) * ldc + col0;
#pragma unroll
                for (int bj = 0; bj < 2; ++bj) { const f32x4 v0 = acc[ai][bj][m][0], v1 = acc[ai][bj][m][1];
                    u32x4 w; w.x = cvt_pk_bf16(v0[0], v0[1]); w.y = cvt_pk_bf16(v0[2], v0[3]); w.z = cvt_pk_bf16(v1[0], v1[1]); w.w = cvt_pk_bf16(v1[2], v1[3]);
                    *(PG8_GAS u32x4*)(rowp + bj * HALF) = w; } }
    }
};

template <class Epi, class Sched, bool ALIGN_EPI = false, bool SP2 = false>
__device__ __forceinline__ void gemm_phase(PG8_LAS unsigned char* lds, const Gemm g, const Sched& S, const Epi& E) {
    int tid_l = threadIdx.x; asm volatile("" : "+v"(tid_l));
    const int tid = tid_l, wid = __builtin_amdgcn_readfirstlane(tid >> 6), lane = tid & 63, wr = wid >> 2, wc = wid & 3, fr = lane & 15, fq = lane >> 4;
    const int K = g.K, nt = K / BK;
    unsigned voffA[2], voffB[2];
#pragma unroll
    for (int i = 0; i < 2; ++i) { int R, C; stage_rc(tid * 16 + i * 8192, R, C); const int Rb = Epi::PERM ? ((R & ~31) + perm32(R & 31)) : R;
        voffA[i] = (unsigned)(R * K + C) * 2u; voffB[i] = (unsigned)(Rb * K + C) * 2u; }
    const size_t kstep = (size_t)(BK * 2);
    const size_t hstep = (size_t)HALF * K * 2;
    const size_t tstep = 2 * hstep;
    const unsigned ldsw = (unsigned)wid * 1024u;
    const int aoff = lds_byte(wr * 64 + fr, fq * 8), boff = lds_byte(wc * 32 + fr, fq * 8);
#define PG8_SA(b, h) (((b) * 2 + (h)) * HTB)
#define PG8_SB(b, h) ((4 + (b) * 2 + (h)) * HTB)
#define PG8_STAGE(bufoff, gbase, voff) do { _Pragma("unroll") for (int _i = 0; _i < 2; ++_i) \
        __builtin_amdgcn_global_load_lds((const unsigned*)((const char*)(gbase) + (voff)[_i]), (PG8_LAS unsigned*)(lds + (bufoff) + ldsw + _i * 8192), 16, 0, 0); } while (0)
#define PG8_LDA(dst, b, h) do { _Pragma("unroll") for (int m = 0; m < 4; ++m) _Pragma("unroll") for (int k = 0; k < 2; ++k) dst[m][k] = *(const PG8_LAS bf16x8*)(lds + PG8_SA(b, h) + aoff + m * 2048 + k * 1024); } while (0)
#define PG8_LDB(dst, b, h) do { _Pragma("unroll") for (int n = 0; n < 2; ++n) _Pragma("unroll") for (int k = 0; k < 2; ++k) dst[n][k] = *(const PG8_LAS bf16x8*)(lds + PG8_SB(b, h) + boff + n * 2048 + k * 1024); } while (0)
#define PG8_MMA(ai, bj, At, Bt) do { __builtin_amdgcn_s_setprio(1); _Pragma("unroll") for (int m = 0; m < 4; ++m) _Pragma("unroll") for (int n = 0; n < 2; ++n) _Pragma("unroll") for (int k = 0; k < 2; ++k) \
        acc[ai][bj][m][n] = __builtin_amdgcn_mfma_f32_16x16x32_bf16(Bt[n][k], At[m][k], acc[ai][bj][m][n], 0, 0, 0); __builtin_amdgcn_s_setprio(0); } while (0)
#define PG8_WAIT_V(n) asm volatile("s_waitcnt vmcnt(" #n ")" ::: "memory")
#define PG8_WAIT_L(n) asm volatile("s_waitcnt lgkmcnt(" #n ")" ::: "memory")
#define PG8_BAR __builtin_amdgcn_s_barrier()
#define PG8_SCHED __builtin_amdgcn_sched_barrier(0)
    Unit cur, nxt; int ui = 0;
    if (!S.next(0, cur)) return;
    f32x4 acc[2][2][4][2];
#pragma unroll
    for (int a = 0; a < 2; ++a)
#pragma unroll
        for (int b = 0; b < 2; ++b)
#pragma unroll
            for (int m = 0; m < 4; ++m)
#pragma unroll
                for (int n = 0; n < 2; ++n) acc[a][b][m][n] = (f32x4){0.f, 0.f, 0.f, 0.f};
    bf16x8 At[4][2], B0[2][2], B1[2][2];
    const char* cA = (const char*)g.A + (size_t)cur.pm * tstep; const char* cB = (const char*)g.Bt + (size_t)cur.pn * tstep;
    S.a_ready(cur);
    if constexpr (SP2) {
        PG8_STAGE(PG8_SB(0, 0), cB, voffB); PG8_STAGE(PG8_SB(0, 1), cB + hstep, voffB); PG8_STAGE(PG8_SA(0, 0), cA, voffA); PG8_STAGE(PG8_SA(0, 1), cA + hstep, voffA);
        if (wr == 1) PG8_BAR;
        PG8_WAIT_V(2); PG8_BAR;
        PG8_STAGE(PG8_SB(1, 0), cB + kstep, voffB); PG8_STAGE(PG8_SA(1, 0), cA + kstep, voffA); PG8_STAGE(PG8_SB(1, 1), cB + hstep + kstep, voffB);
        PG8_WAIT_V(6); PG8_BAR;
    } else {
        PG8_STAGE(PG8_SB(0, 0), cB, voffB); PG8_STAGE(PG8_SA(0, 0), cA, voffA); PG8_STAGE(PG8_SB(0, 1), cB + hstep, voffB); PG8_STAGE(PG8_SA(0, 1), cA + hstep, voffA);
        if (wr == 1) PG8_BAR;
        PG8_WAIT_V(4); PG8_BAR;
        PG8_STAGE(PG8_SB(1, 0), cB + kstep, voffB); PG8_STAGE(PG8_SA(1, 0), cA + kstep, voffA); PG8_STAGE(PG8_SB(1, 1), cB + hstep + kstep, voffB);
        PG8_WAIT_V(6); PG8_BAR;
    }
    for (;;) {
        const bool has_next = S.next(ui + 1, nxt);
        const char* nA = has_next ? (const char*)g.A + (size_t)nxt.pm * tstep : cA; const char* nB = has_next ? (const char*)g.Bt + (size_t)nxt.pn * tstep : cB;
        for (int t = 0; t < nt; t += 2) {
            const bool last = (t == nt - 2);
            const char* a1 = cA + (size_t)(t + 1) * kstep;
            const char* a2 = last ? nA : cA + (size_t)(t + 2) * kstep; const char* b2 = last ? nB : cB + (size_t)(t + 2) * kstep;
            const char* a3 = a2 + kstep; const char* b3 = b2 + kstep;
            if (last && has_next) S.a_ready(nxt);
            if constexpr (SP2) {
            PG8_LDB(B0, 0, 0); PG8_LDB(B1, 0, 1); PG8_SCHED; PG8_LDA(At, 0, 0); PG8_STAGE(PG8_SA(1, 1), a1 + hstep, voffA);
            PG8_WAIT_V(8); PG8_WAIT_L(0); PG8_BAR; PG8_MMA(0, 0, At, B0); PG8_MMA(0, 1, At, B1); PG8_BAR; PG8_SCHED;
            PG8_LDA(At, 0, 1); PG8_STAGE(PG8_SB(0, 0), b2, voffB); PG8_STAGE(PG8_SB(0, 1), b2 + hstep, voffB); PG8_STAGE(PG8_SA(0, 0), a2, voffA);
            PG8_WAIT_V(8); PG8_WAIT_L(0); PG8_BAR; PG8_MMA(1, 0, At, B0); PG8_MMA(1, 1, At, B1); PG8_BAR; PG8_SCHED;
            PG8_LDB(B0, 1, 0); PG8_LDB(B1, 1, 1); PG8_SCHED; PG8_LDA(At, 1, 0); PG8_STAGE(PG8_SA(0, 1), a2 + hstep, voffA);
            PG8_WAIT_V(8); PG8_WAIT_L(0); PG8_BAR; PG8_MMA(0, 0, At, B0); PG8_MMA(0, 1, At, B1); PG8_BAR; PG8_SCHED;
            PG8_LDA(At, 1, 1); PG8_STAGE(PG8_SB(1, 0), b3, voffB); PG8_STAGE(PG8_SB(1, 1), b3 + hstep, voffB); PG8_STAGE(PG8_SA(1, 0), a3, voffA);
            PG8_WAIT_V(8); PG8_WAIT_L(0); PG8_BAR; PG8_MMA(1, 0, At, B0); PG8_MMA(1, 1, At, B1); PG8_BAR; PG8_SCHED;
            } else {
            PG8_LDB(B0, 0, 0); PG8_SCHED; PG8_LDA(At, 0, 0); PG8_STAGE(PG8_SA(1, 1), a1 + hstep, voffA);
            PG8_WAIT_L(8); PG8_BAR; PG8_WAIT_L(0); PG8_MMA(0, 0, At, B0); PG8_BAR; PG8_SCHED;
            PG8_LDB(B1, 0, 1); PG8_STAGE(PG8_SB(0, 0), b2, voffB);
            PG8_BAR; PG8_WAIT_L(0); PG8_MMA(0, 1, At, B1); PG8_BAR;
            PG8_LDA(At, 0, 1); PG8_STAGE(PG8_SA(0, 0), a2, voffA);
            PG8_BAR; PG8_WAIT_L(0); PG8_MMA(1, 0, At, B0); PG8_BAR; PG8_SCHED;
            PG8_STAGE(PG8_SB(0, 1), b2 + hstep, voffB);
            PG8_WAIT_V(6); PG8_BAR; PG8_MMA(1, 1, At, B1); PG8_BAR;
            PG8_LDB(B0, 1, 0); PG8_SCHED; PG8_LDA(At, 1, 0); PG8_STAGE(PG8_SA(0, 1), a2 + hstep, voffA);
            PG8_WAIT_L(8); PG8_BAR; PG8_WAIT_L(0); PG8_MMA(0, 0, At, B0); PG8_BAR; PG8_SCHED;
            PG8_LDB(B1, 1, 1); PG8_STAGE(PG8_SB(1, 0), b3, voffB);
            PG8_BAR; PG8_WAIT_L(0); PG8_MMA(0, 1, At, B1); PG8_BAR;
            PG8_LDA(At, 1, 1); PG8_STAGE(PG8_SA(1, 0), a3, voffA);
            PG8_BAR; PG8_WAIT_L(0); PG8_MMA(1, 0, At, B0); PG8_BAR; PG8_SCHED;
            PG8_STAGE(PG8_SB(1, 1), b3 + hstep, voffB);
            PG8_WAIT_V(6); PG8_BAR; PG8_MMA(1, 1, At, B1); PG8_BAR;
            }
        }
        if constexpr (ALIGN_EPI) { if (wr == 0) PG8_BAR; }
        if constexpr (!Epi::AFTER_DRAIN) { E(acc, cur, wr, wc, fr, fq); S.done(cur); }
        if (!has_next) break;
#pragma unroll
        for (int a = 0; a < 2; ++a)
#pragma unroll
            for (int b = 0; b < 2; ++b)
#pragma unroll
                for (int m = 0; m < 4; ++m)
#pragma unroll
                    for (int n = 0; n < 2; ++n) acc[a][b][m][n] = (f32x4){0.f, 0.f, 0.f, 0.f};
        cur = nxt; cA = nA; cB = nB; ++ui;
        if constexpr (ALIGN_EPI) { if (wr == 1) PG8_BAR; }
    }
    PG8_WAIT_V(0);
    if constexpr (!ALIGN_EPI) { if (wr == 0) PG8_BAR; }
    PG8_BAR;
    if constexpr (Epi::AFTER_DRAIN) { E.fused(acc, cur, wr, wc, fr, fq, lds, wid, lane); S.done(cur); }
#undef PG8_SA
#undef PG8_SB
#undef PG8_STAGE
#undef PG8_LDA
#undef PG8_LDB
#undef PG8_MMA
#undef PG8_WAIT_V
#undef PG8_WAIT_L
#undef PG8_BAR
#undef PG8_SCHED
}
}
#include <hip/hip_bf16.h>
#include <cmath>
namespace attn_body {
using bf16=__hip_bfloat16;
using bf16x8=__attribute__((ext_vector_type(8)))short;
using s16x4=__attribute__((ext_vector_type(4)))short;
using f32x16=__attribute__((ext_vector_type(16)))float;
using u32x4=__attribute__((ext_vector_type(4)))unsigned;
constexpr int BATCH=8,NHEAD=8,SEQ=4096,D=64,DM=4352,KDM=1024,OPITCH=1024;
constexpr int NW=8,QBLK=32,QB=QBLK*NW,KVBLK=64,NQB=SEQ/QB;
constexpr int ATTN_PITCH=DM, ATTN_UNIT_ROWS=QB;
__device__ __forceinline__ int crow(int r,int hi){return (r&3)+8*(r>>2)+4*hi;}
#define SBAR() __builtin_amdgcn_sched_barrier(0)
__device__ __forceinline__ void cmask(f32x16&p0,f32x16&p1,int jb,int qrel,int hi){
  const float NEG=-INFINITY; int kb=64*jb+4*hi;
  #pragma unroll
  for(int r=0;r<16;++r){int kv=kb+(r&3)+8*(r>>2); if(kv>qrel)p0[r]=NEG; if(kv+32>qrel)p1[r]=NEG;}
}

constexpr int NSLOT=3, SLOTB=8192;
constexpr int LDS_K=0, LDS_V=NSLOT*SLOTB, LDS_WS=2*NSLOT*SLOTB, LDS_OST=LDS_WS+NW*64*4, LDS_BIAS=LDS_OST+NW*4096, LDS_BYTES=LDS_BIAS+SEQ*8+512;
constexpr int ATTN_DUMP=163072+256;
constexpr float C2=0.125f*1.4426950408889634f;
__device__ __forceinline__ void glds16(const void*gsrc,unsigned lds_dst){unsigned keep;
  asm volatile("s_mov_b32 %0, m0\n\ts_mov_b32 m0, %2\n\ts_nop 0\n\tglobal_load_lds_dwordx4 %1, off\n\ts_mov_b32 m0, %0":"=&s"(keep):"v"(gsrc),"s"(lds_dst):"memory");}
__device__ __forceinline__ float max3f(float a,float b,float c){float r;asm("v_max3_f32 %0, %1, %2, %3":"=v"(r):"v"(a),"v"(b),"v"(c));return r;}
__device__ __forceinline__ float max2f(float a,float b){float r;asm("v_max_f32_e32 %0, %1, %2":"=v"(r):"v"(a),"v"(b));return r;}
__device__ __forceinline__ float fadd_s(float a,float b){float r;asm("v_add_f32_e32 %0, %1, %2":"=v"(r):"v"(a),"v"(b));return r;}
__device__ __forceinline__ float fsub_s(float a,float b){float r;asm("v_sub_f32_e32 %0, %1, %2":"=v"(r):"v"(a),"v"(b));return r;}
typedef float f32x2_t __attribute__((ext_vector_type(2))); typedef float f32x4_t __attribute__((ext_vector_type(4))); typedef __bf16 bf16x2_t __attribute__((ext_vector_type(2)));
__device__ __forceinline__ unsigned cvtpk_s(float lo,float hi){f32x2_t v={lo,hi};bf16x2_t b=__builtin_convertvector(v,bf16x2_t);return __builtin_bit_cast(unsigned,b);}
#define WAIT_BAR(N) asm volatile("s_waitcnt vmcnt(" #N ") lgkmcnt(0)\n\ts_barrier":::"memory")
typedef unsigned u32x2_t __attribute__((ext_vector_type(2)));
__device__ __forceinline__ u32x2_t split3(float x){ const unsigned h1=cvtpk_s(x,0.f)&0xffffu; const float r1=x-__uint_as_float(h1<<16); const unsigned h2=cvtpk_s(r1,0.f)&0xffffu; const float r2=r1-__uint_as_float(h2<<16);
  const unsigned h3=cvtpk_s(r2,0.f)&0xffffu; return (u32x2_t){h1|(h2<<16),h3}; }

__device__ __forceinline__ void qkt(f32x16&p0,f32x16&p1,const char*Kslot,const bf16x8*qr,const f32x16&ci0,const f32x16&ci1,int r32,int hi){
  const char*kb=Kslot+hi*1024+r32*16;
  #pragma unroll
  for(int d0=0;d0<4;++d0){
    const bf16x8 b0=*reinterpret_cast<const bf16x8*>(kb+d0*2048);
    const bf16x8 b1=*reinterpret_cast<const bf16x8*>(kb+d0*2048+512);
    if(d0==0){p0=__builtin_amdgcn_mfma_f32_32x32x16_bf16(b0,qr[0],ci0,0,0,0);p1=__builtin_amdgcn_mfma_f32_32x32x16_bf16(b1,qr[0],ci1,0,0,0);}
    else{p0=__builtin_amdgcn_mfma_f32_32x32x16_bf16(b0,qr[d0],p0,0,0,0);p1=__builtin_amdgcn_mfma_f32_32x32x16_bf16(b1,qr[d0],p1,0,0,0);}}
}
typedef __attribute__((address_space(3))) const char* lds_cptr;
typedef short v4i16_t __attribute__((ext_vector_type(4)));
__device__ __forceinline__ void kload8(bf16x8*kf,lds_cptr kp){
  kf[0]=*(const __attribute__((address_space(3))) bf16x8*)(kp);      kf[1]=*(const __attribute__((address_space(3))) bf16x8*)(kp+512);
  kf[2]=*(const __attribute__((address_space(3))) bf16x8*)(kp+2048); kf[3]=*(const __attribute__((address_space(3))) bf16x8*)(kp+2560);
  kf[4]=*(const __attribute__((address_space(3))) bf16x8*)(kp+4096); kf[5]=*(const __attribute__((address_space(3))) bf16x8*)(kp+4608);
  kf[6]=*(const __attribute__((address_space(3))) bf16x8*)(kp+6144); kf[7]=*(const __attribute__((address_space(3))) bf16x8*)(kp+6656);
}
__device__ __forceinline__ void kload2(bf16x8*kf,lds_cptr kp,int j){ kf[2*j]=*(const __attribute__((address_space(3))) bf16x8*)(kp+j*2048); kf[2*j+1]=*(const __attribute__((address_space(3))) bf16x8*)(kp+j*2048+512); }
__device__ __forceinline__ s16x4 vtr(lds_cptr p){ return __builtin_bit_cast(s16x4,__builtin_amdgcn_ds_read_tr16_b64_v4i16((__attribute__((address_space(3))) v4i16_t*)p)); }
__device__ __forceinline__ float rowmax(const f32x16&p0,const f32x16&p1){
  float a=max3f(p0[0],p0[1],p1[0]),b=max3f(p0[2],p0[3],p1[1]);a=max3f(a,p1[2],p1[3]);
  #pragma unroll
  for(int r=4;r<16;r+=4){a=max3f(a,p0[r],p0[r+1]);b=max3f(b,p0[r+2],p0[r+3]);a=max3f(a,p1[r],p1[r+1]);b=max3f(b,p1[r+2],p1[r+3]);}
  const float m=max2f(a,b);
  auto rr=__builtin_amdgcn_permlane32_swap(__float_as_uint(m),__float_as_uint(m),false,false);
  return max2f(__uint_as_float(rr[0]),__uint_as_float(rr[1]));
}
__device__ __forceinline__ void pv(f32x16*o,int vb,bf16x8 pa0,bf16x8 pa1,bf16x8 pa2,bf16x8 pa3){
  #pragma unroll
  for(int d0=0;d0<2;++d0){s16x4 lo[4],hi[4];
    #pragma unroll
    for(int ks=0;ks<4;++ks){
      asm volatile("ds_read_b64_tr_b16 %0,%1 offset:%c2":"=&v"(lo[ks]):"v"(vb),"i"(d0*4096+ks*1024):"memory");
      asm volatile("ds_read_b64_tr_b16 %0,%1 offset:%c2":"=&v"(hi[ks]):"v"(vb),"i"(d0*4096+ks*1024+512):"memory");}
    asm volatile("s_waitcnt lgkmcnt(0)":::"memory");SBAR();
    #define PK(k) (bf16x8){lo[k][0],lo[k][1],lo[k][2],lo[k][3],hi[k][0],hi[k][1],hi[k][2],hi[k][3]}
    o[d0]=__builtin_amdgcn_mfma_f32_32x32x16_bf16(pa0,PK(0),o[d0],0,0,0);
    o[d0]=__builtin_amdgcn_mfma_f32_32x32x16_bf16(pa1,PK(1),o[d0],0,0,0);
    o[d0]=__builtin_amdgcn_mfma_f32_32x32x16_bf16(pa2,PK(2),o[d0],0,0,0);
    o[d0]=__builtin_amdgcn_mfma_f32_32x32x16_bf16(pa3,PK(3),o[d0],0,0,0);
    #undef PK
  }
}

#ifndef ATTN_STORE16
#define ATTN_STORE16(p,v) (*(u32x4*)(p)=(v))
#endif
template<int THRL> __device__ __forceinline__ void attn_unit(int b,int h,int qb,const bf16*Q,const bf16*__restrict__ K,const bf16*__restrict__ V,const bf16*__restrict__ Z,const float*__restrict__ CBG,bf16*O,char*shm){
  int tid_l=threadIdx.x; asm volatile("":"+v"(tid_l));
  const int tid=tid_l,lane=tid&63,r32=lane&31,hi=lane>>5; const int wid=__builtin_amdgcn_readfirstlane(tid>>6);
  const long rowbase=(long)b*SEQ; const int q0=qb*QB;
  const bf16*Qw=Q+(rowbase+q0+wid*QBLK)*DM+h*D;
  const bf16*Kh=K+((rowbase>>6)*NHEAD+h)*8192;
  (void)V;
  const unsigned lds0=(unsigned)(uintptr_t)shm;
  float*wsf=(float*)(shm+LDS_WS)+wid*64;
  const bf16*ksrc=Kh+wid*512+lane*8;
  const bf16*vsrc=Kh+4096+(wid>>2)*2048+(16*(wid&3))*32+lane*8;
  const unsigned kdst=lds0+LDS_K+wid*1024, vdst=lds0+LDS_V+wid*1024;
  #define DMA_K(t,slot) glds16(ksrc+(long)(t)*(NHEAD*8192),(unsigned)__builtin_amdgcn_readfirstlane(kdst+(slot)))
  #define DMA_V(t,slot) glds16(vsrc+(long)(t)*(NHEAD*8192),(unsigned)__builtin_amdgcn_readfirstlane(vdst+(slot)))
  const int vb0=(int)(lds0+LDS_V)+((lane>>4)&1)*32+(lane&3)*8+(4*hi+((lane&15)>>2))*64;
  const char*Kbase=shm+LDS_K; bf16x8 kf[8];
  const lds_cptr shm3=(lds_cptr)shm; const lds_cptr kp0=shm3+LDS_K+hi*1024+r32*16; const lds_cptr vp0=shm3+LDS_V+((lane>>4)&1)*32+(lane&3)*8+(4*hi+((lane&15)>>2))*64;
  const int NT=(q0+QB)/KVBLK;
  if(wid<4){ unsigned keep_; const bf16* zp_=Z+(rowbase+q0+tid)*DM+h*D;
    asm volatile("s_mov_b32 %0, m0\n\ts_mov_b32 m0, %2\n\ts_nop 0\n\tglobal_load_lds_dword %1, off\n\ts_mov_b32 m0, %0":"=&s"(keep_):"v"(zp_),"s"(lds0+(unsigned)ATTN_DUMP):"memory"); }
  DMA_K(0,0);DMA_V(0,0);DMA_K(1,SLOTB);
  float bias_own;
  { __attribute__((address_space(3))) u32x2_t* bw=(__attribute__((address_space(3))) u32x2_t*)(shm3+LDS_BIAS);
    const __attribute__((address_space(1))) float* cg=(const __attribute__((address_space(1))) float*)CBG; float cb_[8];
    _Pragma("unroll") for(int k_=0;k_<8;++k_){ const int i_=tid+k_*NW*64; cb_[k_]=(i_<NT*KVBLK)?cg[i_]:0.f; }
    const float cref=cg[q0]; const float cown=cg[q0+wid*QBLK+(lane&31)];
    _Pragma("unroll") for(int k_=0;k_<8;++k_){ const int i_=tid+k_*NW*64; if(i_<NT*KVBLK) bw[i_]=split3(cref-cb_[k_]); }
    if(tid<64) bw[SEQ+tid]=(u32x2_t){0x3F803F80u,0x00003F80u};
    bias_own=cref-cown; }
  bf16x8 qr[4];
  #pragma unroll
  for(int d0=0;d0<4;++d0)qr[d0]=*reinterpret_cast<const bf16x8*>(&Qw[(long)r32*DM+d0*16+hi*8]);
  bf16x8 kq[4];
  #pragma unroll
  for(int d0=0;d0<4;++d0){ const int qr_=q0+wid*QBLK+r32; kq[d0]=*reinterpret_cast<const bf16x8*>(&Kh[(long)(qr_>>6)*(NHEAD*8192)+(2*d0+hi)*512+(qr_&63)*8]); }
  float mhat=0.f,l_reg=0.f;f32x16 o[2];o[0]=f32x16{};o[1]=f32x16{};
  const int qrel=wid*QBLK+r32;
  #define CMASK(P0,P1,t) do{int jb_=(t)-(NT-4); if(jb_>=0)cmask(P0,P1,jb_,qrel,hi);}while(0)
  const __attribute__((address_space(3))) char* kbp=(const __attribute__((address_space(3))) char*)(shm3+LDS_BIAS)+(hi?SEQ*8:0)+r32*8; const int kbstride=hi?0:KVBLK*8;
  u32x2_t kba,kbb; bf16x8 qm;
  #define KBLOAD() do{ kba=*(const __attribute__((address_space(3))) u32x2_t*)(kbp); kbb=*(const __attribute__((address_space(3))) u32x2_t*)(kbp+256); }while(0)
  #define KBF(v) __builtin_bit_cast(bf16x8,(u32x4){(v)[0],(v)[1],0u,0u})
  #define QMSET() do{ const u32x2_t v_=hi?split3(-mhat):(u32x2_t){0x3F803F80u,0x00003F80u}; qm=__builtin_bit_cast(bf16x8,(u32x4){v_[0],v_[1],0u,0u}); }while(0)
  #define CZERO (f32x16){0.f,0.f,0.f,0.f,0.f,0.f,0.f,0.f,0.f,0.f,0.f,0.f,0.f,0.f,0.f,0.f}
  bool resc=false;
  #define START(P0,P1) do{ const float rm=rowmax(P0,P1); resc=false; \
    { const float dl=__builtin_fmaxf(rm,sdiag); mhat=fadd_s(mhat,dl); QMSET(); \
      _Pragma("unroll") for(int r=0;r<16;++r){P0[r]=fsub_s(P0[r],dl);P1[r]=fsub_s(P1[r],dl);} } \
    _Pragma("unroll") for(int r=0;r<16;++r)P0[r]=__builtin_amdgcn_exp2f(P0[r]); }while(0)
  #define RESC() do{ if(resc){ asm volatile("s_waitcnt lgkmcnt(0)":::"memory"); \
      _Pragma("unroll") for(int d_=0;d_<2;++d_) _Pragma("unroll") for(int r=0;r<16;++r)o[d_][r]*=wsf[crow(r,hi)]; } }while(0)
  f32x16 pA0,pA1,pB0,pB1;
  int sl_prev=0,sl_cur=0,sl_next=SLOTB;
  #define ROT() do{sl_prev=sl_cur;sl_cur=sl_next;sl_next=(sl_next==(NSLOT-1)*SLOTB)?0:sl_next+SLOTB;}while(0)
  DMA_K(2,2*SLOTB);
  WAIT_BAR(3);
  float sdiag;
  { float acc_=0.f;
    #pragma unroll
    for(int d0=0;d0<4;++d0){
      #pragma unroll
      for(int e=0;e<8;++e)acc_+=__uint_as_float((unsigned)(unsigned short)qr[d0][e]<<16)*__uint_as_float((unsigned)(unsigned short)kq[d0][e]<<16);}
    auto rr_=__builtin_amdgcn_permlane32_swap(__float_as_uint(acc_),__float_as_uint(acc_),false,false);
    sdiag=__uint_as_float(rr_[0])+__uint_as_float(rr_[1])+bias_own; }
  { QMSET(); KBLOAD(); f32x16 ci0=__builtin_amdgcn_mfma_f32_32x32x16_bf16(KBF(kba),qm,CZERO,0,0,0),ci1=__builtin_amdgcn_mfma_f32_32x32x16_bf16(KBF(kbb),qm,CZERO,0,0,0); qkt(pA0,pA1,Kbase,qr,ci0,ci1,r32,hi); } asm volatile("s_nop 15\n\ts_nop 7":"+v"(pA0),"+v"(pA1));CMASK(pA0,pA1,0);
  START(pA0,pA1);
  _Pragma("unroll") for(int r=0;r<16;++r)pA1[r]=__builtin_amdgcn_exp2f(pA1[r]);
  WAIT_BAR(0);
  DMA_K(3,0);DMA_V(1,SLOTB);
  ROT();
  kload8(kf,kp0+sl_cur);
  WAIT_BAR(2);
  s16x4 vlo[8],vhi[8]; u32x4 pw0,pw1,pw2,pw3;
  #define PKW(P,B) cvtpk_s(P[B],P[B+1])
  #define PAF(k) __builtin_bit_cast(bf16x8,pw##k)
  #define VFR(i) (bf16x8){vlo[i][0],vlo[i][1],vlo[i][2],vlo[i][3],vhi[i][0],vhi[i][1],vhi[i][2],vhi[i][3]}
  #define PIN(x) asm volatile("":"+v"(x))
  #define MX3(a,b,c) __builtin_fmaxf(__builtin_fmaxf((a),(b)),(c))
  #define GAPA(MF,A0,A1,A2,A3,W0,W1,PW) do{ MF; sacc+=A0; sacc+=A1; sacc+=A2; sacc+=A3; PIN(sacc); W0; W1; PIN(PW); SBAR(); }while(0)
  #define EX(v) __builtin_amdgcn_exp2f(v)
  #define GAPB(MF,X,B) do{ MF; X[B]=EX(X[B]); X[B+1]=EX(X[B+1]); X[B+2]=EX(X[B+2]); X[B+3]=EX(X[B+3]); PIN(X); SBAR(); }while(0)
  #define VRD(i) do{ vlo[i]=vtr(vp_+(((i)>>2)*4096+((i)&3)*1024)); vhi[i]=vtr(vp_+(((i)>>2)*4096+((i)&3)*1024+512)); }while(0)
  #define KRD(G,j) do{ if(G){ kload2(kf,kp0+sl_next,j); SBAR(); } }while(0)
  #define STEP(C0,C1,P0,P1,t,GK,GV,GL) do{ SBAR(); \
    const lds_cptr vp_=vp0+sl_prev; \
    C0=__builtin_amdgcn_mfma_f32_32x32x16_bf16(KBF(kba),qm,CZERO,0,0,0); C1=__builtin_amdgcn_mfma_f32_32x32x16_bf16(KBF(kbb),qm,CZERO,0,0,0); SBAR(); \
    VRD(0); SBAR(); float sacc=(P0[0]+P0[1]); \
    GAPA(C0=__builtin_amdgcn_mfma_f32_32x32x16_bf16(kf[0],qr[0],C0,0,0,0), P0[2],P0[3],P0[4],P0[5],     pw0[0]=PKW(P0,0), pw0[1]=PKW(P0,2), pw0); \
    VRD(4); SBAR(); GAPA(C1=__builtin_amdgcn_mfma_f32_32x32x16_bf16(kf[1],qr[0],C1,0,0,0), P0[6],P0[7],P0[8],P0[9],     pw0[2]=PKW(P0,4), pw0[3]=PKW(P0,6), pw0); \
    VRD(1); SBAR(); GAPA(C0=__builtin_amdgcn_mfma_f32_32x32x16_bf16(kf[2],qr[1],C0,0,0,0),   P0[10],P0[11],P0[12],P0[13], pw1[0]=PKW(P0,8), pw1[1]=PKW(P0,10), pw1); \
    VRD(5); SBAR(); GAPA(C1=__builtin_amdgcn_mfma_f32_32x32x16_bf16(kf[3],qr[1],C1,0,0,0),   P0[14],P0[15],P1[0],P1[1],   pw1[2]=PKW(P0,12),pw1[3]=PKW(P0,14), pw1); \
    VRD(2); SBAR(); GAPA(C0=__builtin_amdgcn_mfma_f32_32x32x16_bf16(kf[4],qr[2],C0,0,0,0),   P1[2],P1[3],P1[4],P1[5],     pw2[0]=PKW(P1,0), pw2[1]=PKW(P1,2), pw2); \
    VRD(6); SBAR(); GAPA(C1=__builtin_amdgcn_mfma_f32_32x32x16_bf16(kf[5],qr[2],C1,0,0,0),   P1[6],P1[7],P1[8],P1[9],     pw2[2]=PKW(P1,4), pw2[3]=PKW(P1,6), pw2); \
    VRD(3); SBAR(); GAPA(C0=__builtin_amdgcn_mfma_f32_32x32x16_bf16(kf[6],qr[3],C0,0,0,0),   P1[10],P1[11],P1[12],P1[13], pw3[0]=PKW(P1,8), pw3[1]=PKW(P1,10), pw3); \
    VRD(7); SBAR(); GAPA(C1=__builtin_amdgcn_mfma_f32_32x32x16_bf16(kf[7],qr[3],C1,0,0,0),   P1[14],P1[15],0.f,0.f,       pw3[2]=PKW(P1,12),pw3[3]=PKW(P1,14), pw3); \
    l_reg+=sacc; \
    if(GK){DMA_K((t)+3,sl_cur);} if(GV){DMA_V((t)+1,sl_next);} \
    CMASK(C0,C1,t); \
    { float a=MX3(C0[0],C0[1],C1[0]),b=MX3(C0[2],C0[3],C1[1]); a=MX3(a,C1[2],C1[3]); \
      _Pragma("unroll") for(int r=4;r<16;r+=4){a=MX3(a,C0[r],C0[r+1]);b=MX3(b,C0[r+2],C0[r+3]);a=MX3(a,C1[r],C1[r+1]);b=MX3(b,C1[r+2],C1[r+3]);} \
      float rm=__builtin_fmaxf(a,b); { auto rr=__builtin_amdgcn_permlane32_swap(__float_as_uint(rm),__float_as_uint(rm),false,false); rm=__builtin_fmaxf(__uint_as_float(rr[0]),__uint_as_float(rr[1])); } \
      resc=false; \
      if(__builtin_expect(__any(rm>(float)THRL),0)){ const float dl=__builtin_fmaxf(rm,0.f); mhat+=dl; QMSET(); \
        _Pragma("unroll") for(int r=0;r<16;++r){C0[r]-=dl;C1[r]-=dl;} \
        const float f=__builtin_amdgcn_exp2f(-dl); l_reg*=f; if(hi==0)wsf[r32]=f; resc=true; } } \
    SBAR(); \
    GAPB(o[0]=__builtin_amdgcn_mfma_f32_32x32x16_bf16(PAF(0),VFR(0),o[0],0,0,0), C0,0); \
    GAPB(o[1]=__builtin_amdgcn_mfma_f32_32x32x16_bf16(PAF(0),VFR(4),o[1],0,0,0), C0,4); \
    KRD(GL,0); GAPB(o[0]=__builtin_amdgcn_mfma_f32_32x32x16_bf16(PAF(1),VFR(1),o[0],0,0,0), C0,8); \
    KRD(GL,1); GAPB(o[1]=__builtin_amdgcn_mfma_f32_32x32x16_bf16(PAF(1),VFR(5),o[1],0,0,0), C0,12); \
    KRD(GL,2); GAPB(o[0]=__builtin_amdgcn_mfma_f32_32x32x16_bf16(PAF(2),VFR(2),o[0],0,0,0), C1,0); \
    KRD(GL,3); GAPB(o[1]=__builtin_amdgcn_mfma_f32_32x32x16_bf16(PAF(2),VFR(6),o[1],0,0,0), C1,4); \
    GAPB(o[0]=__builtin_amdgcn_mfma_f32_32x32x16_bf16(PAF(3),VFR(3),o[0],0,0,0), C1,8); \
    GAPB(o[1]=__builtin_amdgcn_mfma_f32_32x32x16_bf16(PAF(3),VFR(7),o[1],0,0,0), C1,12); \
    kbp+=kbstride; KBLOAD();   \
    }while(0)
  kbp+=kbstride; KBLOAD();
  int t=1;
  #undef CMASK
  #define CMASK(P0,P1,t) do{}while(0)
  for(;t+5<NT;t+=2){
    STEP(pB0,pB1,pA0,pA1,t,true,true,true);     WAIT_BAR(2); RESC(); ROT();
    STEP(pA0,pA1,pB0,pB1,t+1,true,true,true);   WAIT_BAR(2); RESC(); ROT();
  }
  #undef CMASK
  #define CMASK(P0,P1,t) do{int jb_=(t)-(NT-4); if(jb_>=0)cmask(P0,P1,jb_,qrel,hi);}while(0)
  #define ENDW(tt) do{ if((tt)+3<NT){WAIT_BAR(2);} else if((tt)+2<NT){WAIT_BAR(1);} else {WAIT_BAR(0);} }while(0)
  for(;t+1<NT;t+=2){
    STEP(pB0,pB1,pA0,pA1,t,(t+3<NT),(t+1<NT),(t+1<NT));       ENDW(t);   RESC(); ROT();
    STEP(pA0,pA1,pB0,pB1,t+1,(t+4<NT),(t+2<NT),(t+2<NT));     ENDW(t+1); RESC(); ROT();
  }
  STEP(pB0,pB1,pA0,pA1,NT-1,false,false,false); RESC();
  { float sacc=pB0[0]+pB0[1]; _Pragma("unroll") for(int r=2;r<16;++r)sacc+=pB0[r]; _Pragma("unroll") for(int r=0;r<16;++r)sacc+=pB1[r]; l_reg+=sacc;
    pw0=(u32x4){PKW(pB0,0),PKW(pB0,2),PKW(pB0,4),PKW(pB0,6)};pw1=(u32x4){PKW(pB0,8),PKW(pB0,10),PKW(pB0,12),PKW(pB0,14)};pw2=(u32x4){PKW(pB1,0),PKW(pB1,2),PKW(pB1,4),PKW(pB1,6)};pw3=(u32x4){PKW(pB1,8),PKW(pB1,10),PKW(pB1,12),PKW(pB1,14)};
    SBAR(); pv(o,vb0+sl_cur,PAF(0),PAF(1),PAF(2),PAF(3)); }
  #undef PKW
  #undef PAF
  #undef VFR
  #undef PIN
  #undef MX3
  #undef GAPA
  #undef GAPB
  #undef EX
  #undef VRD
  #undef KRD
  #undef STEP
  #undef ENDW
  {auto rr=__builtin_amdgcn_permlane32_swap(__float_as_uint(l_reg),__float_as_uint(l_reg),false,false);l_reg=__uint_as_float(rr[0])+__uint_as_float(rr[1]);}
  if(hi==0)wsf[32+r32]=l_reg;asm volatile("s_waitcnt lgkmcnt(0)":::"memory");
  float rli[16];
  #pragma unroll
  for(int r=0;r<16;++r)rli[r]=__builtin_amdgcn_rcpf(wsf[32+crow(r,hi)]);
  bf16*Ow=O+(rowbase+q0+wid*QBLK)*OPITCH+h*D;
  const bf16*Zw=Z+(rowbase+q0+wid*QBLK)*DM+h*D;
  { bf16*stg=(bf16*)(shm+LDS_OST)+wid*2048;
    const __attribute__((address_space(1))) unsigned short* Zg=(const __attribute__((address_space(1))) unsigned short*)Zw; unsigned zr[32];
    #pragma unroll
    for(int r=0;r<16;++r){const int orow=crow(r,hi);
      #pragma unroll
      for(int d0=0;d0<2;++d0) zr[2*r+d0]=Zg[(long)orow*DM+d0*32+r32]; }
    #pragma unroll
    for(int r=0;r<16;++r){const int orow=crow(r,hi);
      #pragma unroll
      for(int d0=0;d0<2;++d0){ const float z=__uint_as_float(zr[2*r+d0]<<16); const float sg=z*__builtin_amdgcn_rcpf(1.f+__expf(-z)); stg[orow*64+d0*32+r32]=__float2bfloat16(o[d0][r]*rli[r]*sg);} }
    asm volatile("s_waitcnt lgkmcnt(0)":::"memory");
    #pragma unroll
    for(int i=0;i<4;++i){const int row=i*8+(lane>>3),ch=lane&7; const u32x4 v=*(const u32x4*)(stg+row*64+ch*8); ATTN_STORE16(Ow+(long)row*OPITCH+ch*8,v);} }
  asm volatile("s_waitcnt lgkmcnt(0)\n\ts_barrier":::"memory");
  #undef DMA_K
  #undef DMA_V
  #undef CMASK
  #undef START
  #undef KBLOAD
  #undef KBF
  #undef QMSET
  #undef CZERO
  #undef RESC
  #undef ROT
}
constexpr int ATTN_LDS_BYTES=LDS_BYTES;
struct AttnTensors { const bf16* Q; const bf16* K; const bf16* V; const bf16* Z; const float* CB; bf16* O; };
struct AttnUnit { int bh; int qb; };
struct StaticOrder {
  int vcu;
  __device__ __forceinline__ explicit StaticOrder(int grid,int block):vcu((grid%8==0)?((block%8)*(grid/8)+block/8):block){}
  __device__ __forceinline__ bool next(int i,AttnUnit&u)const{ const int L=vcu*4+i; if(i>=4||L>=BATCH*NHEAD*NQB)return false; const int s=vcu&3; u.bh=vcu>>2; u.qb=(i==0)?15-s:(i==1)?11-s:(i==2)?4+s:s; return true; }
  __device__ __forceinline__ void a_ready(const AttnUnit&)const{}
  __device__ __forceinline__ void done(const AttnUnit&)const{}
};
template<class Sched,int THRL=8> __device__ __forceinline__ void attn_phase(char*lds,const AttnTensors&T,const Sched&S){
  AttnUnit u;
  for(int i=0;S.next(i,u);++i){ S.a_ready(u); attn_unit<THRL>(u.bh/NHEAD,u.bh%NHEAD,u.qb,T.Q,T.K,T.V,T.Z,T.CB+(long)u.bh*SEQ,T.O,lds); S.done(u); }
}
template<int THRL=8> __device__ __forceinline__ void attn_phase_queue(char*lds,const AttnTensors&T,unsigned*ctr,volatile __attribute__((address_space(3))) unsigned*qw){
  const int tid=threadIdx.x; unsigned nxt=0u;
  if(tid==0)nxt=__hip_atomic_fetch_add(ctr,1u,__ATOMIC_RELAXED,__HIP_MEMORY_SCOPE_AGENT);
  for(;;){
    if(tid==0)*qw=nxt;
    asm volatile("s_waitcnt lgkmcnt(0)\n\ts_barrier":::"memory");
    const unsigned n=(unsigned)__builtin_amdgcn_readfirstlane((int)*qw);
    asm volatile("s_waitcnt lgkmcnt(0)\n\ts_barrier":::"memory");
    if(n>=(unsigned)(BATCH*NHEAD*NQB))break;
    if(tid==0)nxt=__hip_atomic_fetch_add(ctr,1u,__ATOMIC_RELAXED,__HIP_MEMORY_SCOPE_AGENT);
    const int bh=(int)(n&63u),qb=15-(int)(n>>6);
    attn_unit<THRL>(bh/NHEAD,bh%NHEAD,qb,T.Q,T.K,T.V,T.Z,T.CB+(long)bh*SEQ,T.O,lds);
  }
}
#undef SBAR
#undef WAIT_BAR
}
#define GAS __attribute__((address_space(1)))
#define LAS __attribute__((address_space(3)))
typedef unsigned short bf16;
typedef unsigned v4u __attribute__((ext_vector_type(4)));
typedef float f32x4 __attribute__((ext_vector_type(4)));
typedef short bf16x8 __attribute__((ext_vector_type(8)));
typedef GAS unsigned gu32;
typedef GAS unsigned long long gu64;
#define RLX_AGENT __ATOMIC_RELAXED, __HIP_MEMORY_SCOPE_AGENT
#define LDS_WAIT() asm volatile("s_waitcnt lgkmcnt(0)" ::: "memory")
#define VM_WAIT() asm volatile("s_waitcnt vmcnt(0)" ::: "memory")
__device__ __forceinline__ unsigned long long rt() { return __builtin_amdgcn_s_memrealtime(); }
typedef float f32x2_hw __attribute__((ext_vector_type(2))); typedef __bf16 bf16x2_hw __attribute__((ext_vector_type(2)));
__device__ __forceinline__ unsigned pk2(float lo, float hi) { f32x2_hw v = {lo, hi}; bf16x2_hw b = __builtin_convertvector(v, bf16x2_hw); return __builtin_bit_cast(unsigned, b); }
__device__ __forceinline__ unsigned f2bf(float f) { return pk2(f, 0.f) & 0xffffu; }

#define XB_TMO      128
#define XB_XCNT(j)  (256  + 64 * (j))
#define XB_XSUB(j)  (1280 + 64 * (j))
#define XB_XGEN(j)  (2304 + 64 * (j))
#define XB_TOP      3328
#define XB_TOPGEN   3392
#define XCD_BAR_WORDS 3456
#define XB_SPIN_CAP (1u << 18)

__device__ __forceinline__ unsigned xb_ld(unsigned* p)              { return __hip_atomic_load(p, __ATOMIC_RELAXED, __HIP_MEMORY_SCOPE_AGENT); }
__device__ __forceinline__ unsigned xb_add(unsigned* p, unsigned v) { return __hip_atomic_fetch_add(p, v, __ATOMIC_RELAXED, __HIP_MEMORY_SCOPE_AGENT); }
__device__ __forceinline__ unsigned xb_xcc_id() { return (unsigned)__builtin_amdgcn_s_getreg((3 << 11) | 20) & 0xFu; }
#define XB_SPIN(cond, bar) do { unsigned _sp = 0; while (cond) { __builtin_amdgcn_s_sleep(1); \
    if ((++_sp & 255u) == 0u) { if (xb_ld(&(bar)[XB_TMO])) break; if (_sp > XB_SPIN_CAP) { atomicAdd(&(bar)[XB_TMO], 1u); break; } } } } while (0)

struct XcdBarrier {
    unsigned* bar; unsigned x;
    volatile LAS unsigned* st;
};

__device__ __forceinline__ XcdBarrier xcd_barrier_post(unsigned* bar, volatile LAS unsigned* st) {
    XcdBarrier b; b.bar = bar; b.x = xb_xcc_id(); b.st = st;
    if (threadIdx.x == 0) (void)xb_add(&bar[XB_XCNT(b.x)], 1u);
    return b;
}
__device__ __forceinline__ void xcd_barrier_complete(unsigned* bar, unsigned x, unsigned& nloc, unsigned& nx) {
    const unsigned G = gridDim.x * gridDim.y * gridDim.z;
    unsigned sum, cnt, mine, sp = 0u;
    for (;;) {
        sum = 0u; cnt = 0u; mine = 0u;
#pragma unroll
        for (unsigned j = 0; j < 16; ++j) { const unsigned c = xb_ld(&bar[XB_XCNT(j)]); sum += c; cnt += (c > 0u) ? 1u : 0u; mine = (j == x) ? c : mine; }
        if (sum == G) break;
        __builtin_amdgcn_s_sleep(1);
        if ((++sp & 255u) == 0u) { if (xb_ld(&bar[XB_TMO])) break; if (sp > XB_SPIN_CAP) { atomicAdd(&bar[XB_TMO], 1u); break; } }
    }
    nloc = mine > 0u ? mine : 1u; nx = cnt > 0u ? cnt : 1u;
}

__device__ __forceinline__ void xcd_barrier(const XcdBarrier& b) {
    asm volatile("s_waitcnt vmcnt(0)" ::: "memory");
    __syncthreads();
    if (threadIdx.x == 0) {
        unsigned* bar = b.bar;
        __builtin_amdgcn_s_waitcnt(0);
        unsigned nloc = b.st[0], nx = b.st[1];
        if (nloc == 0u) { xcd_barrier_complete(bar, b.x, nloc, nx); b.st[0] = nloc; b.st[1] = nx; }
        const unsigned old = xb_add(&bar[XB_XSUB(b.x)], 1u);
        const unsigned gen = old / nloc;
        if (old + 1u == (gen + 1u) * nloc) {
            __builtin_amdgcn_fence(__ATOMIC_RELEASE, "agent");
            asm volatile("s_waitcnt vmcnt(0)" ::: "memory");
            const unsigned og = xb_add(&bar[XB_TOP], 1u);
            const unsigned tg = og / nx;
            if (og + 1u == (tg + 1u) * nx) xb_add(&bar[XB_TOPGEN], 1u);
            else XB_SPIN(xb_ld(&bar[XB_TOPGEN]) == tg, bar);
            __builtin_amdgcn_fence(__ATOMIC_ACQUIRE, "agent");
            xb_add(&bar[XB_XGEN(b.x)], 1u);
            asm volatile("s_waitcnt vmcnt(0)" ::: "memory");
        } else {
            XB_SPIN(xb_ld(&bar[XB_XGEN(b.x)]) == gen, bar);
            __builtin_amdgcn_fence(__ATOMIC_ACQUIRE, "agent");
            asm volatile("s_waitcnt vmcnt(0)" ::: "memory");
        }
    }
    __syncthreads();
}
constexpr int NWAVES = 8, NTHREADS = 512;
constexpr int PH_SCRATCH = 163072;
constexpr int MISC_OFF = PH_SCRATCH;
constexpr int LDS_BYTES = PH_SCRATCH + 512;
typedef float f32x2 __attribute__((ext_vector_type(2)));

struct Args { const float* in[30]; float* out; unsigned char* ws; int do_pro, fused, l_lo, l_hi, ph_lo, ph_hi; };

__device__ __forceinline__ float bf2f(bf16 v) { return __uint_as_float((unsigned)v << 16); }
__device__ __forceinline__ float sigmoid_f(float x) { return __builtin_amdgcn_rcpf(1.f + __expf(-x)); }
__device__ __forceinline__ float silu_f(float x) { return x * __builtin_amdgcn_rcpf(1.f + __expf(-x)); }
__device__ __forceinline__ float log1p_fast(float u) { const float w = 1.f + u; const float d = w - 1.f; return (d == 0.f) ? u : __logf(w) * u * __builtin_amdgcn_rcpf(d); }
__device__ __forceinline__ float softplus_f(float x) { return fmaxf(x, 0.f) + log1p_fast(__expf(-fabsf(x))); }
__device__ __forceinline__ float rcp_fast(float x) { return __builtin_amdgcn_rcpf(x); }
__device__ __forceinline__ float rsq_fast(float x) { return __builtin_amdgcn_rsqf(x); }
__device__ __forceinline__ float sigmoid_fast(float x) { return __builtin_amdgcn_rcpf(1.f + __expf(-x)); }
__device__ __forceinline__ float silu_fast(float x) { return x * __builtin_amdgcn_rcpf(1.f + __expf(-x)); }
__device__ __forceinline__ float softplus_fast(float x) { return fmaxf(x, 0.f) + __logf(1.f + __expf(-fabsf(x))); }
__device__ __forceinline__ float tanh_fast(float x) { const float e = __expf(-2.f * fabsf(x)); const float t = (1.f - e) * __builtin_amdgcn_rcpf(1.f + e); return x < 0.f ? -t : t; }
__device__ __forceinline__ float logsigmoid_f(float x) { return fminf(x, 0.f) - log1p_fast(__expf(-fabsf(x))); }
template <int CTRL> __device__ __forceinline__ float dpp_f(float v) { return __int_as_float(__builtin_amdgcn_update_dpp(0, __float_as_int(v), CTRL, 0xF, 0xF, true)); }
__device__ __forceinline__ float wave_sum_dpp(float v) { v += dpp_f<0xB1>(v); v += dpp_f<0x4E>(v); v += dpp_f<0x141>(v); v += dpp_f<0x140>(v);
    v += __int_as_float(__builtin_amdgcn_update_dpp(0, __float_as_int(v), 0x142, 0xA, 0xF, false)); v += __int_as_float(__builtin_amdgcn_update_dpp(0, __float_as_int(v), 0x143, 0xC, 0xF, false));
    return __int_as_float(__builtin_amdgcn_readlane(__float_as_int(v), 63)); }
__device__ __forceinline__ float wave_sum(float v) { return wave_sum_dpp(v); }
__device__ __forceinline__ float row16_sum(float v) { v += dpp_f<0xB1>(v); v += dpp_f<0x4E>(v); v += dpp_f<0x141>(v); v += dpp_f<0x140>(v); return v; }

typedef float f32x16 __attribute__((ext_vector_type(16)));
typedef __bf16 bf16x2_t __attribute__((ext_vector_type(2)));
#define MFMA32(a_, b_, c_) __builtin_amdgcn_mfma_f32_32x32x16_bf16((a_), (b_), (c_), 0, 0, 0)
constexpr size_t WS_PK = 1068 * MiB, PK_STRIDE = 32 * MiB;
constexpr size_t WS_PKWC = 1292 * MiB;
constexpr size_t WS_W2T = 1293 * MiB, WS_A2T = WS_W2T + 256 * 1024;
constexpr size_t WS_KV = 1294 * MiB;
constexpr size_t WS_END2 = 1360 * MiB;
constexpr int LDM = 72;
constexpr int CL_MSZ = 64 * LDM * 2, CL_AAB = 9 * CL_MSZ, CL_YAK = CL_AAB + 64 * 68 * 4, CL_AT32 = CL_YAK + 64 * 68 * 4, CL_LW = CL_AT32 + 64 * 68 * 4, CL_AIB = CL_LW + 64 * 64 * 4, CL_VEC = CL_AIB + 64 * 64 * 2, CL_TMP = CL_VEC + 5 * 256, CL_END = CL_TMP + 8 * 256;
static_assert(CL_END <= PH_SCRATCH, "chunk LDS");
__device__ __forceinline__ int crow16(int reg, int hh) { return (reg & 3) + 8 * (reg >> 2) + 4 * hh; }
__device__ __forceinline__ unsigned cvtpk(float lo, float hi) { f32x2 v = {lo, hi}; bf16x2_t b = __builtin_convertvector(v, bf16x2_t); return __builtin_bit_cast(unsigned, b); }
__device__ __forceinline__ bf16x8 pack8v(float e0, float e1, float e2, float e3, float e4, float e5, float e6, float e7) { v4u p; p.x = cvtpk(e0, e1); p.y = cvtpk(e2, e3); p.z = cvtpk(e4, e5); p.w = cvtpk(e6, e7); return __builtin_bit_cast(bf16x8, p); }
#define PACK8(x_, s_) pack8v((x_)[8 * (s_)], (x_)[8 * (s_) + 1], (x_)[8 * (s_) + 2], (x_)[8 * (s_) + 3], (x_)[8 * (s_) + 4], (x_)[8 * (s_) + 5], (x_)[8 * (s_) + 6], (x_)[8 * (s_) + 7])
__device__ __forceinline__ void unpack8(f32x16& x, int s, v4u p) {
    x[8 * s + 0] = __uint_as_float(p.x << 16); x[8 * s + 1] = __uint_as_float(p.x & 0xffff0000u); x[8 * s + 2] = __uint_as_float(p.y << 16); x[8 * s + 3] = __uint_as_float(p.y & 0xffff0000u);
    x[8 * s + 4] = __uint_as_float(p.z << 16); x[8 * s + 5] = __uint_as_float(p.z & 0xffff0000u); x[8 * s + 6] = __uint_as_float(p.w << 16); x[8 * s + 7] = __uint_as_float(p.w & 0xffff0000u);
}
typedef LAS unsigned short lbf16;
__device__ __forceinline__ bf16x8 frag_nat(const lbf16* M, int row, int k0) { return *(const LAS bf16x8*)(M + row * LDM + k0); }
__device__ __forceinline__ bf16x8 frag_perm(const lbf16* M, int row, int s, int hh) {
    typedef unsigned u32x2 __attribute__((ext_vector_type(2)));
    const u32x2 lo = *(const LAS u32x2*)(M + row * LDM + 16 * s + 4 * hh), hi = *(const LAS u32x2*)(M + row * LDM + 16 * s + 8 + 4 * hh);
    v4u p; p.x = lo.x; p.y = lo.y; p.z = hi.x; p.w = hi.y; return __builtin_bit_cast(bf16x8, p);
}
__device__ __forceinline__ lbf16* cl_mat(LAS unsigned char* L, int i) { return (lbf16*)(L + i * CL_MSZ); }

#define CL_BAR() asm volatile("s_waitcnt lgkmcnt(0)\n\ts_barrier" ::: "memory")
struct RwkvConst { float mur, muk, muv, muw, mua, kkc, kac, rkc, bias; bf16x8 bfr[4]; };
struct RwkvRaw { unsigned r[5], k[5], v[5], w[5], a[5]; };
__device__ __forceinline__ float rawf(const unsigned* p, int i) { return (i & 1) ? __uint_as_float(p[i >> 1] & 0xffff0000u) : __uint_as_float(p[i >> 1] << 16); }
__device__ __forceinline__ void rwkv_const_load(RwkvConst& K, const Args& a, int l, int h, int tid) {
    const int lane = tid & 63, wave = __builtin_amdgcn_readfirstlane(tid >> 6);
    const GAS float* mu = (const GAS float*)a.in[12] + l * NSHIFT;
    K.mur = mu[h * 64 + lane]; K.muk = mu[256 + h * 64 + lane]; K.muv = mu[512 + h * 64 + lane]; K.muw = mu[768 + lane]; K.mua = mu[832 + lane];
    K.kkc = a.in[17][l * 256 + h * 64 + lane]; K.kac = a.in[18][l * 256 + h * 64 + lane]; K.rkc = a.in[19][l * 256 + h * 64 + lane];
    const int mat = wave >> 2, kb = wave & 1, r = lane & 31, hh = lane >> 5;
    const GAS bf16* Bg = (const GAS bf16*)(a.ws + (mat ? WS_A2T : WS_W2T)) + ((size_t)l * 256 + h * 64 + 32 * kb + r) * 64 + 8 * hh;
#pragma unroll
    for (int ks = 0; ks < 4; ++ks) K.bfr[ks] = *(const GAS bf16x8*)(Bg + 16 * ks);
    K.bias = a.in[mat ? 15 : 13][l * 256 + h * 64 + 32 * kb + r];
}
__device__ __forceinline__ void rwkv_raw_load_vw(RwkvRaw& R, const Args& a, int b, int c, int h, int wave, int lane) {
    const GAS bf16* p0 = (const GAS bf16*)(a.ws + WS_PROJ) + (size_t)(b * TSEQ + c * 64 + wave * 8 - 1) * NPJ;
    const bool first = (c == 0 && wave == 0);
    unsigned T[9][5];
#pragma unroll
    for (int i = 0; i < 9; ++i) { const GAS bf16* pp = p0 + (size_t)((i == 0 && first) ? 1 : i) * NPJ;
        T[i][0] = pp[h * 64 + lane]; T[i][1] = pp[256 + h * 64 + lane]; T[i][2] = pp[512 + h * 64 + lane]; T[i][3] = pp[768 + lane]; T[i][4] = pp[832 + lane]; }
#pragma unroll
    for (int s_ = 0; s_ < 5; ++s_) if (first) T[0][s_] = 0u;
#pragma unroll
    for (int p = 0; p < 5; ++p) { const int i = 2 * p;
        R.r[p] = T[i][0] | (i + 1 < 9 ? T[i + 1 < 9 ? i + 1 : 8][0] << 16 : 0u); R.k[p] = T[i][1] | (i + 1 < 9 ? T[i + 1 < 9 ? i + 1 : 8][1] << 16 : 0u); R.v[p] = T[i][2] | (i + 1 < 9 ? T[i + 1 < 9 ? i + 1 : 8][2] << 16 : 0u);
        R.w[p] = T[i][3] | (i + 1 < 9 ? T[i + 1 < 9 ? i + 1 : 8][3] << 16 : 0u); R.a[p] = T[i][4] | (i + 1 < 9 ? T[i + 1 < 9 ? i + 1 : 8][4] << 16 : 0u); }
}
struct GdnConst { float cwv[4][3]; float nea, dtb; };
struct GdnRaw { unsigned x[3][6]; float sba; };
__device__ __forceinline__ void gdn_const_load(GdnConst& K, const Args& a, int l, int h, int tid) {
    const int lane = tid & 63;
    const GAS float* cw = (const GAS float*)a.in[23] + (size_t)l * 4 * NCONV + h * 64 + lane;
#pragma unroll
    for (int d = 0; d < 4; ++d)
#pragma unroll
        for (int x = 0; x < 3; ++x) K.cwv[d][x] = cw[d * NCONV + x * 256];
    K.nea = -__expf(a.in[24][l * 4 + h]); K.dtb = a.in[25][l * 4 + h];
}
__device__ __forceinline__ void gdn_raw_load_vw(GdnRaw& R, const Args& a, int b, int c, int h, int wave, int lane) {
    const int t0 = wave * 8;
    const GAS bf16* P = (const GAS bf16*)(a.ws + WS_PROJ); const GAS float* SM = (const GAS float*)(a.ws + WS_SMALL);
    unsigned T[12][3];
#pragma unroll
    for (int i = 0; i < 11; ++i) { const int tt = c * 64 + t0 - 3 + i; const int tc = tt < 0 ? 0 : tt;
#pragma unroll
        for (int x = 0; x < 3; ++x) T[i][x] = P[(size_t)(b * TSEQ + tc) * NPJ + C_CQKV + x * 256 + h * 64 + lane]; }
    { const size_t m = (size_t)b * TSEQ + c * 64 + t0 + (lane & 7); R.sba = SM[m * 16 + 8 + 4 * ((lane >> 3) & 1) + h]; }
#pragma unroll
    for (int i = 0; i < 3; ++i) { const bool neg = (c * 64 + t0 - 3 + i) < 0;
#pragma unroll
        for (int x = 0; x < 3; ++x) if (neg) T[i][x] = 0u; }
#pragma unroll
    for (int x = 0; x < 3; ++x) { T[11][x] = 0u;
#pragma unroll
        for (int p = 0; p < 6; ++p) R.x[x][p] = T[2 * p][x] | (T[2 * p + 1][x] << 16); }
}
__device__ __forceinline__ void touch_dma(const GAS void* p, LAS unsigned char* L) {
    const unsigned dst = (unsigned)(size_t)(L + MISC_OFF + 256); unsigned keep;
    asm volatile("s_mov_b32 %0, m0\n\ts_mov_b32 m0, %2\n\ts_nop 0\n\tglobal_load_lds_dword %1, off\n\ts_mov_b32 m0, %0" : "=&s"(keep) : "v"(p), "s"(dst) : "memory");
}
__device__ __forceinline__ void rwkv_touch(const Args& a, int b, int c, int h, LAS unsigned char* L, int wave, int lane) {
    int idx = (wave - 2) * 64 + lane; idx = idx < 325 ? idx : 324;
    const int row = idx / 5, seg = idx - row * 5; const int col = seg < 3 ? seg * 256 + h * 64 : 768 + (seg - 3) * 64;
    touch_dma((const GAS bf16*)(a.ws + WS_PROJ) + ((ptrdiff_t)(b * TSEQ + c * 64 - 1 + row) * NPJ + col), L);
}
__device__ __forceinline__ void gdn_touch(const Args& a, int b, int c, int h, LAS unsigned char* L, int wave, int lane) {
    int idx = (wave - 2) * 64 + lane; idx = idx < 201 ? idx : 200;
    const int row = idx / 3, seg = idx - row * 3;
    touch_dma((const GAS bf16*)(a.ws + WS_PROJ) + ((ptrdiff_t)(b * TSEQ + c * 64 - 3 + row) * NPJ + C_CQKV + seg * 256 + h * 64), L);
}
template <int STAGE  > __device__ __forceinline__ void chunk_back(LAS unsigned char* L, const bool scaled, const size_t pu, unsigned char* ws, int tid) {
    asm volatile("" : "+v"(tid));
    const int lane = tid & 63, wave = __builtin_amdgcn_readfirstlane(tid >> 6), r = lane & 31, hh = lane >> 5;
    const lbf16* JAb = cl_mat(L, 0); const lbf16* JAk = cl_mat(L, scaled ? 0 : 1); const lbf16* TBa = cl_mat(L, scaled ? 0 : 2); const lbf16* TBr = cl_mat(L, 3);
    const lbf16* AT = cl_mat(L, scaled ? 4 : 2); const lbf16* RT = cl_mat(L, scaled ? 5 : 3); const lbf16* BHT = cl_mat(L, 6); const lbf16* KHT = cl_mat(L, 7); const lbf16* VT = cl_mat(L, 8);
    LAS float* AAB = (LAS float*)(L + CL_AAB); LAS float* YAK = (LAS float*)(L + CL_YAK); const LAS float* VEC = (const LAS float*)(L + CL_VEC);
    GAS unsigned char* pk = (GAS unsigned char*)(ws + WS_PK) + pu * 8192;
    if constexpr (STAGE == 0) {
    {
        const int g = wave >> 1, tb = wave & 1;
        const lbf16* JA = (g & 1) ? JAk : JAb; const lbf16* TB = (g < 2) ? TBa : TBr;
        f32x16 X0, X1;
#pragma unroll
        for (int i = 0; i < 16; ++i) { X0[i] = 0.f; X1[i] = 0.f; }
#pragma unroll
        for (int ks = 0; ks < 4; ++ks) { const bf16x8 bfr = frag_nat(TB, 32 * tb + r, 16 * ks + 8 * hh);
            X0 = MFMA32(frag_nat(JA, r, 16 * ks + 8 * hh), bfr, X0);
            if (tb) X1 = MFMA32(frag_nat(JA, 32 + r, 16 * ks + 8 * hh), bfr, X1); }
        const int t = 32 * tb + r; const int tlim = t + ((g < 2) ? 0 : 1);
        const LAS float* EJ = VEC + ((g & 1) ? 128 : 192); const LAS float* CF = VEC + ((g & 1) ? 64 : 0); const float et = scaled ? VEC[((g < 2) ? 192 : 128) + t] : 0.f;
#pragma unroll
        for (int i = 0; i < 16; ++i) { const int j0 = crow16(i, hh), j1 = 32 + j0;
            float s0 = 1.f, s1 = 1.f;
            if (scaled) { s0 = CF[j0] * __builtin_amdgcn_exp2f(fminf(et - EJ[j0], 0.f)); s1 = CF[j1] * __builtin_amdgcn_exp2f(fminf(et - EJ[j1], 0.f)); }
            X0[i] *= (j0 < tlim) ? s0 : 0.f; X1[i] *= (j1 < tlim) ? s1 : 0.f; }
        if (g == 0) {
            { LAS float* AT32 = (LAS float*)(L + CL_AT32);
#pragma unroll 8
              for (int i = 0; i < 32; ++i) AT32[(32 * tb + i) * 68 + lane] = bf2f(AT[(32 * tb + i) * LDM + lane]); }
#pragma unroll
            for (int q = 0; q < 4; ++q) { *(LAS f32x4*)(AAB + t * 68 + 8 * q + 4 * hh) = (f32x4){X0[4 * q], X0[4 * q + 1], X0[4 * q + 2], X0[4 * q + 3]};
                if (tb) *(LAS f32x4*)(AAB + t * 68 + 32 + 8 * q + 4 * hh) = (f32x4){X1[4 * q], X1[4 * q + 1], X1[4 * q + 2], X1[4 * q + 3]}; }
        } else if (g == 2) {
            GAS v4u* dst = (GAS v4u*)(pk + 2 * PK_STRIDE) + (size_t)(tb * 4) * 64 + lane;
            dst[0 * 64] = __builtin_bit_cast(v4u, PACK8(X0, 0)); dst[1 * 64] = __builtin_bit_cast(v4u, PACK8(X0, 1));
            if (tb) { dst[2 * 64] = __builtin_bit_cast(v4u, PACK8(X1, 0)); dst[3 * 64] = __builtin_bit_cast(v4u, PACK8(X1, 1)); }
        } else {
            const bf16x8 p00 = PACK8(X0, 0), p01 = PACK8(X0, 1), p10 = PACK8(X1, 0), p11 = PACK8(X1, 1);
#pragma unroll
            for (int ib = 0; ib < 2; ++ib) { f32x16 Y;
#pragma unroll
                for (int i = 0; i < 16; ++i) Y[i] = 0.f;
                Y = MFMA32(p00, frag_perm(VT, 32 * ib + r, 0, hh), Y); Y = MFMA32(p01, frag_perm(VT, 32 * ib + r, 1, hh), Y);
                if (tb) { Y = MFMA32(p10, frag_perm(VT, 32 * ib + r, 2, hh), Y); Y = MFMA32(p11, frag_perm(VT, 32 * ib + r, 3, hh), Y); }
                if (g == 1) {
#pragma unroll
                    for (int i = 0; i < 16; ++i) YAK[(32 * tb + crow16(i, hh)) * 68 + 32 * ib + r] = Y[i];
                } else { GAS v4u* dst = (GAS v4u*)(pk + 5 * PK_STRIDE) + (size_t)((ib * 2 + tb) * 2) * 64 + lane;
                    dst[0] = __builtin_bit_cast(v4u, PACK8(Y, 0)); dst[64] = __builtin_bit_cast(v4u, PACK8(Y, 1)); } }
        }
    }
    CL_BAR();
    }
}


#define SOLVE_DECL() f32x2 X2[32]; _Pragma("unroll") for (int i_ = 0; i_ < 32; ++i_) X2[i_] = (f32x2){0.f, 0.f}
#define SOLVE_BEGIN(t0_) f32x4 Aq[2][8], Ah[8]; float rq[2] = {0.f, 0.f}; const LAS float* aab_ = (const LAS float*)(L + CL_AAB); const LAS float* rhs_f = (const LAS float*)(L + (wave == 0 ? CL_AT32 : CL_YAK)) + lane; asm volatile("" : "+v"(aab_), "+v"(rhs_f)); \
            { rq[(t0_) & 1] = rhs_f[(t0_) * 68]; _Pragma("unroll") for (int q = 0; q < ((((t0_) + 3) / 4) < 8 ? (((t0_) + 3) / 4) : 8); ++q) Aq[(t0_) & 1][q] = *(const LAS f32x4*)(aab_ + (t0_) * 68 + 4 * q); }
#define SOLVE_ROW(t_) { constexpr int T_ = (t_), P_ = T_ & 1, NQ_ = (T_ + 3) / 4, NLO_ = NQ_ < 8 ? NQ_ : 8, NQN_ = (T_ + 4) / 4, NLON_ = NQN_ < 8 ? NQN_ : 8; \
            _Pragma("unroll") for (int q = 8; q < NQ_; ++q) Ah[q - 8] = *(const LAS f32x4*)(aab_ + T_ * 68 + 4 * q); \
            if (T_ + 1 < 64) { rq[1 - P_] = rhs_f[(T_ + 1) * 68]; _Pragma("unroll") for (int q = 0; q < NLON_; ++q) Aq[1 - P_][q] = *(const LAS f32x4*)(aab_ + (T_ + 1) * 68 + 4 * q); } \
            f32x2 a01 = (f32x2){rq[P_], 0.f}, a23 = (f32x2){0.f, 0.f}; \
            _Pragma("unroll") for (int q = 0; q < NLO_; ++q) { a01 += (f32x2){Aq[P_][q].x, Aq[P_][q].y} * X2[2 * q]; a23 += (f32x2){Aq[P_][q].z, Aq[P_][q].w} * X2[2 * q + 1]; } \
            _Pragma("unroll") for (int q = 8; q < NQ_; ++q) { a01 += (f32x2){Ah[q - 8].x, Ah[q - 8].y} * X2[2 * q]; a23 += (f32x2){Ah[q - 8].z, Ah[q - 8].w} * X2[2 * q + 1]; } \
            float acc = (a01.x + a01.y) + (a23.x + a23.y); \
            asm volatile("" : "+v"(acc) :: "memory");     \
            if (T_ & 1) X2[T_ >> 1].y = acc; else X2[T_ >> 1].x = acc; }
#define XS_(t_) (((t_) & 1) ? X2[(t_) >> 1].y : X2[(t_) >> 1].x)
#define SOLVE_R_0_28 { SOLVE_BEGIN(0) SOLVE_ROW(0) SOLVE_ROW(1) SOLVE_ROW(2) SOLVE_ROW(3) SOLVE_ROW(4) SOLVE_ROW(5) SOLVE_ROW(6) SOLVE_ROW(7) SOLVE_ROW(8) SOLVE_ROW(9) SOLVE_ROW(10) SOLVE_ROW(11) SOLVE_ROW(12) SOLVE_ROW(13) SOLVE_ROW(14) SOLVE_ROW(15) SOLVE_ROW(16) SOLVE_ROW(17) SOLVE_ROW(18) SOLVE_ROW(19) SOLVE_ROW(20) SOLVE_ROW(21) SOLVE_ROW(22) SOLVE_ROW(23) SOLVE_ROW(24) SOLVE_ROW(25) SOLVE_ROW(26) SOLVE_ROW(27) }
#define SOLVE_R_28_41 { SOLVE_BEGIN(28) SOLVE_ROW(28) SOLVE_ROW(29) SOLVE_ROW(30) SOLVE_ROW(31) SOLVE_ROW(32) SOLVE_ROW(33) SOLVE_ROW(34) SOLVE_ROW(35) SOLVE_ROW(36) SOLVE_ROW(37) SOLVE_ROW(38) SOLVE_ROW(39) SOLVE_ROW(40) }
#define SOLVE_R_41_51 { SOLVE_BEGIN(41) SOLVE_ROW(41) SOLVE_ROW(42) SOLVE_ROW(43) SOLVE_ROW(44) SOLVE_ROW(45) SOLVE_ROW(46) SOLVE_ROW(47) SOLVE_ROW(48) SOLVE_ROW(49) SOLVE_ROW(50) }
#define SOLVE_R_51_59 { SOLVE_BEGIN(51) SOLVE_ROW(51) SOLVE_ROW(52) SOLVE_ROW(53) SOLVE_ROW(54) SOLVE_ROW(55) SOLVE_ROW(56) SOLVE_ROW(57) SOLVE_ROW(58) }
#define SOLVE_R_59_64 { SOLVE_BEGIN(59) SOLVE_ROW(59) SOLVE_ROW(60) SOLVE_ROW(61) SOLVE_ROW(62) SOLVE_ROW(63) }
#define SOLVE_R_28_51 { SOLVE_BEGIN(28) SOLVE_ROW(28) SOLVE_ROW(29) SOLVE_ROW(30) SOLVE_ROW(31) SOLVE_ROW(32) SOLVE_ROW(33) SOLVE_ROW(34) SOLVE_ROW(35) SOLVE_ROW(36) SOLVE_ROW(37) SOLVE_ROW(38) SOLVE_ROW(39) SOLVE_ROW(40) SOLVE_ROW(41) SOLVE_ROW(42) SOLVE_ROW(43) SOLVE_ROW(44) SOLVE_ROW(45) SOLVE_ROW(46) SOLVE_ROW(47) SOLVE_ROW(48) SOLVE_ROW(49) SOLVE_ROW(50) }
#define SOLVE_R_51_64 { SOLVE_BEGIN(51) SOLVE_ROW(51) SOLVE_ROW(52) SOLVE_ROW(53) SOLVE_ROW(54) SOLVE_ROW(55) SOLVE_ROW(56) SOLVE_ROW(57) SOLVE_ROW(58) SOLVE_ROW(59) SOLVE_ROW(60) SOLVE_ROW(61) SOLVE_ROW(62) SOLVE_ROW(63) }
#define SOLVE_R_0_40 { SOLVE_BEGIN(0) SOLVE_ROW(0) SOLVE_ROW(1) SOLVE_ROW(2) SOLVE_ROW(3) SOLVE_ROW(4) SOLVE_ROW(5) SOLVE_ROW(6) SOLVE_ROW(7) SOLVE_ROW(8) SOLVE_ROW(9) SOLVE_ROW(10) SOLVE_ROW(11) SOLVE_ROW(12) SOLVE_ROW(13) SOLVE_ROW(14) SOLVE_ROW(15) SOLVE_ROW(16) SOLVE_ROW(17) SOLVE_ROW(18) SOLVE_ROW(19) SOLVE_ROW(20) SOLVE_ROW(21) SOLVE_ROW(22) SOLVE_ROW(23) SOLVE_ROW(24) SOLVE_ROW(25) SOLVE_ROW(26) SOLVE_ROW(27) SOLVE_ROW(28) SOLVE_ROW(29) SOLVE_ROW(30) SOLVE_ROW(31) SOLVE_ROW(32) SOLVE_ROW(33) SOLVE_ROW(34) SOLVE_ROW(35) SOLVE_ROW(36) SOLVE_ROW(37) SOLVE_ROW(38) SOLVE_ROW(39) }
#define SOLVE_R_40_64 { SOLVE_BEGIN(40) SOLVE_ROW(40) SOLVE_ROW(41) SOLVE_ROW(42) SOLVE_ROW(43) SOLVE_ROW(44) SOLVE_ROW(45) SOLVE_ROW(46) SOLVE_ROW(47) SOLVE_ROW(48) SOLVE_ROW(49) SOLVE_ROW(50) SOLVE_ROW(51) SOLVE_ROW(52) SOLVE_ROW(53) SOLVE_ROW(54) SOLVE_ROW(55) SOLVE_ROW(56) SOLVE_ROW(57) SOLVE_ROW(58) SOLVE_ROW(59) SOLVE_ROW(60) SOLVE_ROW(61) SOLVE_ROW(62) SOLVE_ROW(63) }
#define SOLVE_R_0_20 { SOLVE_BEGIN(0) SOLVE_ROW(0) SOLVE_ROW(1) SOLVE_ROW(2) SOLVE_ROW(3) SOLVE_ROW(4) SOLVE_ROW(5) SOLVE_ROW(6) SOLVE_ROW(7) SOLVE_ROW(8) SOLVE_ROW(9) SOLVE_ROW(10) SOLVE_ROW(11) SOLVE_ROW(12) SOLVE_ROW(13) SOLVE_ROW(14) SOLVE_ROW(15) SOLVE_ROW(16) SOLVE_ROW(17) SOLVE_ROW(18) SOLVE_ROW(19) }
#define SOLVE_R_20_39 { SOLVE_BEGIN(20) SOLVE_ROW(20) SOLVE_ROW(21) SOLVE_ROW(22) SOLVE_ROW(23) SOLVE_ROW(24) SOLVE_ROW(25) SOLVE_ROW(26) SOLVE_ROW(27) SOLVE_ROW(28) SOLVE_ROW(29) SOLVE_ROW(30) SOLVE_ROW(31) SOLVE_ROW(32) SOLVE_ROW(33) SOLVE_ROW(34) SOLVE_ROW(35) SOLVE_ROW(36) SOLVE_ROW(37) SOLVE_ROW(38) }
#define SOLVE_R_39_49 { SOLVE_BEGIN(39) SOLVE_ROW(39) SOLVE_ROW(40) SOLVE_ROW(41) SOLVE_ROW(42) SOLVE_ROW(43) SOLVE_ROW(44) SOLVE_ROW(45) SOLVE_ROW(46) SOLVE_ROW(47) SOLVE_ROW(48) }
#define SOLVE_R_49_55 { SOLVE_BEGIN(49) SOLVE_ROW(49) SOLVE_ROW(50) SOLVE_ROW(51) SOLVE_ROW(52) SOLVE_ROW(53) SOLVE_ROW(54) }
#define SOLVE_R_55_64 { SOLVE_BEGIN(55) SOLVE_ROW(55) SOLVE_ROW(56) SOLVE_ROW(57) SOLVE_ROW(58) SOLVE_ROW(59) SOLVE_ROW(60) SOLVE_ROW(61) SOLVE_ROW(62) SOLVE_ROW(63) }
#define SOLVE_R_0_39 { SOLVE_BEGIN(0) SOLVE_ROW(0) SOLVE_ROW(1) SOLVE_ROW(2) SOLVE_ROW(3) SOLVE_ROW(4) SOLVE_ROW(5) SOLVE_ROW(6) SOLVE_ROW(7) SOLVE_ROW(8) SOLVE_ROW(9) SOLVE_ROW(10) SOLVE_ROW(11) SOLVE_ROW(12) SOLVE_ROW(13) SOLVE_ROW(14) SOLVE_ROW(15) SOLVE_ROW(16) SOLVE_ROW(17) SOLVE_ROW(18) SOLVE_ROW(19) SOLVE_ROW(20) SOLVE_ROW(21) SOLVE_ROW(22) SOLVE_ROW(23) SOLVE_ROW(24) SOLVE_ROW(25) SOLVE_ROW(26) SOLVE_ROW(27) SOLVE_ROW(28) SOLVE_ROW(29) SOLVE_ROW(30) SOLVE_ROW(31) SOLVE_ROW(32) SOLVE_ROW(33) SOLVE_ROW(34) SOLVE_ROW(35) SOLVE_ROW(36) SOLVE_ROW(37) SOLVE_ROW(38) }
#define SOLVE_R_39_51 { SOLVE_BEGIN(39) SOLVE_ROW(39) SOLVE_ROW(40) SOLVE_ROW(41) SOLVE_ROW(42) SOLVE_ROW(43) SOLVE_ROW(44) SOLVE_ROW(45) SOLVE_ROW(46) SOLVE_ROW(47) SOLVE_ROW(48) SOLVE_ROW(49) SOLVE_ROW(50) }
#define SOLVE_R_0_51 { SOLVE_BEGIN(0) SOLVE_ROW(0) SOLVE_ROW(1) SOLVE_ROW(2) SOLVE_ROW(3) SOLVE_ROW(4) SOLVE_ROW(5) SOLVE_ROW(6) SOLVE_ROW(7) SOLVE_ROW(8) SOLVE_ROW(9) SOLVE_ROW(10) SOLVE_ROW(11) SOLVE_ROW(12) SOLVE_ROW(13) SOLVE_ROW(14) SOLVE_ROW(15) SOLVE_ROW(16) SOLVE_ROW(17) SOLVE_ROW(18) SOLVE_ROW(19) SOLVE_ROW(20) SOLVE_ROW(21) SOLVE_ROW(22) SOLVE_ROW(23) SOLVE_ROW(24) SOLVE_ROW(25) SOLVE_ROW(26) SOLVE_ROW(27) SOLVE_ROW(28) SOLVE_ROW(29) SOLVE_ROW(30) SOLVE_ROW(31) SOLVE_ROW(32) SOLVE_ROW(33) SOLVE_ROW(34) SOLVE_ROW(35) SOLVE_ROW(36) SOLVE_ROW(37) SOLVE_ROW(38) SOLVE_ROW(39) SOLVE_ROW(40) SOLVE_ROW(41) SOLVE_ROW(42) SOLVE_ROW(43) SOLVE_ROW(44) SOLVE_ROW(45) SOLVE_ROW(46) SOLVE_ROW(47) SOLVE_ROW(48) SOLVE_ROW(49) SOLVE_ROW(50) }
#define SOLVE_WRITEOUT(pu_) do { GAS unsigned char* pk_ = (GAS unsigned char*)(a.ws + WS_PK) + (pu_) * 8192; const int r_ = lane & 31, hh_ = lane >> 5; \
        if (wave == 0) { lbf16* WAl = (lbf16*)(L + CL_AT32); \
            _Pragma("unroll") for (int t = 0; t < 64; ++t) WAl[t * LDM + lane] = (unsigned short)f2bf(XS_(t)); \
            asm volatile("s_waitcnt lgkmcnt(0)" ::: "memory"); \
            GAS v4u* dstw = (GAS v4u*)(pk_) + lane; \
            _Pragma("unroll") for (int f = 0; f < 8; ++f) dstw[f * 64] = __builtin_bit_cast(v4u, frag_perm(WAl, 32 * (f >> 2) + r_, f & 3, hh_)); \
        } else { GAS v4u* dst = (GAS v4u*)(pk_ + 4 * PK_STRIDE); \
            _Pragma("unroll") for (int tb = 0; tb < 2; ++tb) _Pragma("unroll") for (int oc = 0; oc < 2; ++oc) _Pragma("unroll") for (int h2 = 0; h2 < 2; ++h2) \
                dst[(size_t)(((hh_ * 2 + tb) * 2 + oc) * 64) + r_ + 32 * h2] = __builtin_bit_cast(v4u, pack8v(XS_(32 * tb + 0 + 8 * (2 * oc) + 4 * h2), XS_(32 * tb + 1 + 8 * (2 * oc) + 4 * h2), XS_(32 * tb + 2 + 8 * (2 * oc) + 4 * h2), XS_(32 * tb + 3 + 8 * (2 * oc) + 4 * h2), \
                    XS_(32 * tb + 0 + 8 * (2 * oc + 1) + 4 * h2), XS_(32 * tb + 1 + 8 * (2 * oc + 1) + 4 * h2), XS_(32 * tb + 2 + 8 * (2 * oc + 1) + 4 * h2), XS_(32 * tb + 3 + 8 * (2 * oc + 1) + 4 * h2))); } } while (0)
__device__ __forceinline__ void chunk_jobs(LAS unsigned char* L, const bool scaled, const size_t pu, unsigned char* ws, int wave, int lane) {
    asm volatile("" : "+v"(lane));
    const int r = lane & 31, hh = lane >> 5;
    const lbf16* RT = cl_mat(L, scaled ? 5 : 3); const lbf16* BHT = cl_mat(L, 6); const lbf16* KHT = cl_mat(L, 7); const lbf16* VT = cl_mat(L, 8); const LAS float* VEC = (const LAS float*)(L + CL_VEC);
    GAS unsigned char* pk = (GAS unsigned char*)(ws + WS_PK) + pu * 8192;
    if (wave < 6) {
        const int kb = (wave - 2) >> 1, ib = (wave - 2) & 1; f32x16 Y;
#pragma unroll
        for (int i = 0; i < 16; ++i) Y[i] = 0.f;
#pragma unroll
        for (int js = 0; js < 4; ++js) Y = MFMA32(frag_nat(KHT, 32 * kb + r, 16 * js + 8 * hh), frag_nat(VT, 32 * ib + r, 16 * js + 8 * hh), Y);
        GAS v4u* dst = (GAS v4u*)(pk + 6 * PK_STRIDE) + (size_t)((ib * 2 + kb) * 2) * 64 + lane;
        dst[0] = __builtin_bit_cast(v4u, PACK8(Y, 0)); dst[64] = __builtin_bit_cast(v4u, PACK8(Y, 1));
    } else {
        const lbf16* Msrc = (wave == 6) ? RT : BHT; GAS v4u* dst = (GAS v4u*)(pk + (wave == 6 ? 1 : 3) * PK_STRIDE) + lane;
#pragma unroll
        for (int f = 0; f < 8; ++f) dst[f * 64] = __builtin_bit_cast(v4u, frag_perm(Msrc, 32 * (f >> 2) + r, f & 3, hh));
        if (wave == 7) ((GAS float*)(ws + WS_PKWC))[pu * 64 + lane] = VEC[256 + lane];
    }
}
__device__ __forceinline__ f32x2 raw2(const unsigned* p, int i) { return (f32x2){rawf(p, i), rawf(p, i + 1)}; }
__device__ __forceinline__ void st_bf2(lbf16* M, int t, int lane, f32x2 v) { const unsigned w = pk2(v.x, v.y); M[t * LDM + lane] = (unsigned short)w; M[(t + 1) * LDM + lane] = (unsigned short)(w >> 16); }
__device__ __forceinline__ f32x2 exp2_2(f32x2 v) { return (f32x2){__builtin_amdgcn_exp2f(v.x), __builtin_amdgcn_exp2f(v.y)}; }
__device__ __forceinline__ void rw_F1(const Args& a, int l, const RwkvConst& K, const RwkvRaw& R, int b, int c, int h, float (&xr)[8], float (&xk)[8], float (&xv)[8], LAS unsigned char* L, int wave, int lane) {
    asm volatile("" : "+v"(lane));
    const int t0 = wave * 8; const int m0 = b * TSEQ + c * 64;
    lbf16* TW = cl_mat(L, 4); lbf16* AL = cl_mat(L, 5);
    GAS float* RVg = (GAS float*)(a.ws + WS_RARR + 5 * ARR_STRIDE) + (size_t)(m0 + t0) * 256 + h * 64 + lane;
#pragma unroll
    for (int p = 0; p < 4; ++p) { const int i = 2 * p;
        const f32x2 cr = raw2(R.r, i + 1), ck = raw2(R.k, i + 1), cv = raw2(R.v, i + 1), cw = raw2(R.w, i + 1), ca = raw2(R.a, i + 1);
        const f32x2 x_r = cr + (raw2(R.r, i) - cr) * K.mur, x_k = ck + (raw2(R.k, i) - ck) * K.muk, x_v = cv + (raw2(R.v, i) - cv) * K.muv;
        const f32x2 x_w = cw + (raw2(R.w, i) - cw) * K.muw, x_a = ca + (raw2(R.a, i) - ca) * K.mua;
        xr[i] = x_r.x; xr[i + 1] = x_r.y; xk[i] = x_k.x; xk[i + 1] = x_k.y; xv[i] = x_v.x; xv[i + 1] = x_v.y;
        st_bf2(TW, t0 + i, lane, (f32x2){tanh_fast(x_w.x), tanh_fast(x_w.y)}); st_bf2(AL, t0 + i, lane, x_a);
        RVg[(size_t)i * 256] = x_v.x; RVg[(size_t)(i + 1) * 256] = x_v.y; }
}
__device__ __forceinline__ void rw_F2(const Args& a, int l, int h, LAS unsigned char* L, int wave, int lane) {
    asm volatile("" : "+v"(lane));
    const int mat = wave >> 2, tb = (wave >> 1) & 1, kb = wave & 1, r = lane & 31, hh = lane >> 5;
    bf16x8 bfr[4]; float biasv;
    { const GAS bf16* Bg = (const GAS bf16*)(a.ws + (mat ? WS_A2T : WS_W2T)) + ((size_t)l * 256 + h * 64 + 32 * kb + r) * 64 + 8 * hh;
#pragma unroll
      for (int ks = 0; ks < 4; ++ks) bfr[ks] = *(const GAS bf16x8*)(Bg + 16 * ks);
      biasv = a.in[mat ? 15 : 13][l * 256 + h * 64 + 32 * kb + r]; }
    const lbf16* Am = cl_mat(L, 4 + mat);
    f32x16 acc;
#pragma unroll
    for (int i = 0; i < 16; ++i) acc[i] = 0.f;
#pragma unroll
    for (int ks = 0; ks < 4; ++ks) acc = MFMA32(frag_nat(Am, 32 * tb + r, 16 * ks + 8 * hh), bfr[ks], acc);
    const int k = 32 * kb + r;
    if (mat) { LAS unsigned short* Dst = (LAS unsigned short*)(L + CL_AIB);
#pragma unroll
        for (int i = 0; i < 16; ++i) Dst[(32 * tb + crow16(i, hh)) * 64 + k] = (unsigned short)f2bf(sigmoid_f(biasv + acc[i]));
    } else { LAS float* Dst = (LAS float*)(L + CL_LW);
#pragma unroll
        for (int i = 0; i < 16; ++i) { acc[i] = -0.6065306597126334f * sigmoid_f(biasv + acc[i]); Dst[(32 * tb + crow16(i, hh)) * 64 + k] = acc[i]; }
        LAS float* SUM = (LAS float*)(L + CL_TMP);
#pragma unroll
        for (int j = 0; j < 4; ++j) { float ps = (acc[4 * j] + acc[4 * j + 1]) + (acc[4 * j + 2] + acc[4 * j + 3]);
            auto rr = __builtin_amdgcn_permlane32_swap(__float_as_uint(ps), __float_as_uint(ps), false, false); ps = __uint_as_float(rr[0]) + __uint_as_float(rr[1]);
            if (hh == 0) SUM[(4 * tb + j) * 64 + k] = ps; } }
}
__device__ __forceinline__ void rw_F3b(const Args& a, const RwkvConst& K, int b, int c, int h, const float (&xr)[8], const float (&xk)[8], const float (&xv)[8], LAS unsigned char* L, int wave, int lane) {
    asm volatile("" : "+v"(lane));
    const int t0 = wave * 8; const int m0 = b * TSEQ + c * 64;
    *(LAS bf16x8*)(cl_mat(L, 8) + lane * LDM + t0) = pack8v(xv[0], xv[1], xv[2], xv[3], xv[4], xv[5], xv[6], xv[7]);
    float cumC = 0.f, off = 0.f; f32x2 ai2[4], cum2[4];
    { const LAS float* SUM = (const LAS float*)(L + CL_TMP);
#pragma unroll
      for (int w = 0; w < 8; ++w) { const float sv = SUM[w * 64 + lane]; cumC += sv; if (w < wave) off += sv; } }
    off *= LOG2E; cumC *= LOG2E;
    float e_prev = __builtin_amdgcn_exp2f(off);
    { const LAS float* LW = (const LAS float*)(L + CL_LW); const LAS unsigned short* AI = (const LAS unsigned short*)(L + CL_AIB);
#pragma unroll
      for (int p = 0; p < 4; ++p) { const int i = 2 * p; const f32x2 l2 = (f32x2){LW[(t0 + i) * 64 + lane], LW[(t0 + i + 1) * 64 + lane]} * LOG2E;
          ai2[p] = (f32x2){bf2f(AI[(t0 + i) * 64 + lane]), bf2f(AI[(t0 + i + 1) * 64 + lane])}; cum2[p].x = off + l2.x; cum2[p].y = cum2[p].x + l2.y; off = cum2[p].y; } }
    const float eC = __builtin_amdgcn_exp2f(cumC);
    GAS float* BON = (GAS float*)(a.ws + WS_BONUS) + (size_t)(m0 + t0) * 4 + h;
    lbf16 *M0 = cl_mat(L, 0), *M1 = cl_mat(L, 1), *M2 = cl_mat(L, 2), *M3 = cl_mat(L, 3);
    float bh[8], kh[8];
#pragma unroll
    for (int p = 0; p < 4; ++p) { const int i = 2 * p, t = t0 + i;
        const f32x2 ec = exp2_2(cum2[p]), en = exp2_2(-cum2[p]); const f32x2 ep = (f32x2){e_prev, ec.x}; e_prev = ec.y; const f32x2 eh = en * eC;
        const f32x2 xk2 = (f32x2){xk[i], xk[i + 1]}, xr2 = (f32x2){xr[i], xr[i + 1]};
        const f32x2 kkr = xk2 * K.kkc, sq = kkr * kkr; const float ss0 = wave_sum_dpp(sq.x), ss1 = wave_sum_dpp(sq.y);
        const f32x2 kk = kkr * (f32x2){rcp_fast(fmaxf(__builtin_amdgcn_sqrtf(ss0), 1e-12f)), rcp_fast(fmaxf(__builtin_amdgcn_sqrtf(ss1), 1e-12f))};
        const f32x2 kmod = xk2 * ((ai2[p] - 1.f) * K.kac + 1.f); const f32x2 bo = xr2 * kmod * K.rkc; const float bon0 = wave_sum_dpp(bo.x), bon1 = wave_sum_dpp(bo.y);
        const f32x2 bt = -(kk * ai2[p]);
        st_bf2(M2, t, lane, kk * ep); st_bf2(M0, t, lane, bt * en); st_bf2(M1, t, lane, kmod * en); st_bf2(M3, t, lane, xr2 * ec);
        const f32x2 bh2 = bt * eh, kh2 = kmod * eh; bh[i] = bh2.x; bh[i + 1] = bh2.y; kh[i] = kh2.x; kh[i + 1] = kh2.y;
        if (lane == 0) { BON[(size_t)i * 4] = bon0; BON[(size_t)(i + 1) * 4] = bon1; } }
    *(LAS bf16x8*)(cl_mat(L, 6) + lane * LDM + t0) = pack8v(bh[0], bh[1], bh[2], bh[3], bh[4], bh[5], bh[6], bh[7]);
    *(LAS bf16x8*)(cl_mat(L, 7) + lane * LDM + t0) = pack8v(kh[0], kh[1], kh[2], kh[3], kh[4], kh[5], kh[6], kh[7]);
    if (wave == 7) ((LAS float*)(L + CL_VEC))[4 * 64 + lane] = eC;
}
__device__ __forceinline__ void gd_Fa(const GdnConst& K, const GdnRaw& R, float (&gl)[8], float (&vv)[8], LAS unsigned char* L, int wave, int lane) {
    asm volatile("" : "+v"(lane));
    const int t0 = wave * 8; float run = 0.f;
    lbf16 *M0 = cl_mat(L, 0), *M3 = cl_mat(L, 3); LAS float* VEC = (LAS float*)(L + CL_VEC);
    const float sval = (lane & 8) ? K.nea * softplus_f(R.sba + K.dtb) : sigmoid_f(R.sba);
#pragma unroll
    for (int p = 0; p < 4; ++p) { const int i = 2 * p; f32x2 y[3];
#pragma unroll
        for (int x = 0; x < 3; ++x) { f32x2 s2 = (f32x2){0.f, 0.f};
#pragma unroll
            for (int d = 0; d < 4; ++d) s2 += raw2(R.x[x], i + d) * K.cwv[d][x];
            y[x] = s2 * (f32x2){rcp_fast(1.f + __expf(-s2.x)), rcp_fast(1.f + __expf(-s2.y))}; }
        const f32x2 qq = y[0] * y[0], kq = y[1] * y[1];
        const float qs0 = wave_sum_dpp(qq.x), qs1 = wave_sum_dpp(qq.y), ks0 = wave_sum_dpp(kq.x), ks1 = wave_sum_dpp(kq.y);
        st_bf2(M3, t0 + i, lane, y[0] * ((f32x2){rsq_fast(qs0 + L2_EPS), rsq_fast(qs1 + L2_EPS)} * 0.125f)); st_bf2(M0, t0 + i, lane, y[1] * (f32x2){rsq_fast(ks0 + L2_EPS), rsq_fast(ks1 + L2_EPS)});
        vv[i] = y[2].x; vv[i + 1] = y[2].y;
#pragma unroll
        for (int e = 0; e < 2; ++e) { run += __int_as_float(__builtin_amdgcn_readlane(__float_as_int(sval), 8 + i + e)); gl[i + e] = run; } }
    if (lane < 8) { VEC[t0 + lane] = -sval; VEC[64 + t0 + lane] = sval; }
    if (lane == 0) ((LAS float*)(L + CL_TMP))[wave] = run;
}
__device__ __forceinline__ void gd_Fb(const float (&gl)[8], const float (&vv)[8], LAS unsigned char* L, int wave, int lane) {
    asm volatile("" : "+v"(lane));
    const int t0 = wave * 8; float gcC = 0.f, off = 0.f;
    *(LAS bf16x8*)(cl_mat(L, 8) + lane * LDM + t0) = pack8v(vv[0], vv[1], vv[2], vv[3], vv[4], vv[5], vv[6], vv[7]);
    { const LAS float* GS = (const LAS float*)(L + CL_TMP);
#pragma unroll
      for (int w = 0; w < 8; ++w) { const float sv = GS[w]; gcC += sv; if (w < wave) off += sv; } }
    off *= LOG2E; gcC *= LOG2E;
    float e_prev = __builtin_amdgcn_exp2f(off), eh_prev = __builtin_amdgcn_exp2f(gcC - off), gc_prev = off;
    lbf16 *M0 = cl_mat(L, 0), *M3 = cl_mat(L, 3), *M4 = cl_mat(L, 4), *M5 = cl_mat(L, 5);
    LAS float* VEC = (LAS float*)(L + CL_VEC);
    float bh[8], kh[8];
#pragma unroll
    for (int p = 0; p < 4; ++p) { const int i = 2 * p, t = t0 + i;
        const f32x2 gc2 = (f32x2){gl[i], gl[i + 1]} * LOG2E + off;
        const f32x2 e1 = exp2_2(gc2), eh = exp2_2(gcC - gc2); const f32x2 em = (f32x2){e_prev, e1.x}, ehm = (f32x2){eh_prev, eh.x}; e_prev = e1.y; eh_prev = eh.y;
        const f32x2 kn = (f32x2){bf2f(M0[t * LDM + lane]), bf2f(M0[(t + 1) * LDM + lane])}, qn = (f32x2){bf2f(M3[t * LDM + lane]), bf2f(M3[(t + 1) * LDM + lane])}, bet = (f32x2){VEC[64 + t], VEC[65 + t]};
        st_bf2(M4, t, lane, kn * em); st_bf2(M5, t, lane, qn * e1);
        const f32x2 bk = bet * kn, bh2 = -(bk * ehm), kh2 = bk * eh; bh[i] = bh2.x; bh[i + 1] = bh2.y; kh[i] = kh2.x; kh[i + 1] = kh2.y;
        if (lane == 0) { VEC[128 + t] = gc2.x; VEC[129 + t] = gc2.y; VEC[192 + t] = gc_prev; VEC[193 + t] = gc2.x; }
        gc_prev = gc2.y; }
    *(LAS bf16x8*)(cl_mat(L, 6) + lane * LDM + t0) = pack8v(bh[0], bh[1], bh[2], bh[3], bh[4], bh[5], bh[6], bh[7]);
    *(LAS bf16x8*)(cl_mat(L, 7) + lane * LDM + t0) = pack8v(kh[0], kh[1], kh[2], kh[3], kh[4], kh[5], kh[6], kh[7]);
    if (wave == 7) VEC[4 * 64 + lane] = __builtin_amdgcn_exp2f(gcC);
}
#define FOR_VW(stmt_) do { { const int vw = wave - 2; constexpr int vs = 0; stmt_; } if (wave < 4) { const int vw = wave + 4; constexpr int vs = 1; stmt_; } } while (0)
__device__ __forceinline__ void chunk_pipeline_rwkv(const Args& a, int l, int vcu, int h, LAS unsigned char* L, int tid) {
    const int lane = tid & 63, wave = __builtin_amdgcn_readfirstlane(tid >> 6);
    const int c0 = vcu >> 3;
#define PU_(i_) (((size_t)(((c0) + 32 * (i_)) >> 6) * 4 + h) * 64 + (((c0) + 32 * (i_)) & 63))
#define UB_(i_) (((c0) + 32 * (i_)) >> 6)
#define UC_(i_) (((c0) + 32 * (i_)) & 63)
    if (wave < 2) {
        SOLVE_DECL();
        CL_BAR(); CL_BAR(); CL_BAR();
        chunk_back<0>(L, false, PU_(0), a.ws, tid);
#pragma unroll 1
        for (int i = 0; i < 16; ++i) { const size_t pu = PU_(i);
            SOLVE_R_0_39
            if (i + 1 < 16) {
                CL_BAR();
                SOLVE_R_39_51
                CL_BAR();
                SOLVE_R_51_64 SOLVE_WRITEOUT(pu);
                CL_BAR();
                chunk_back<0>(L, false, PU_(i + 1), a.ws, tid);
            } else { SOLVE_R_39_51 SOLVE_R_51_64 SOLVE_WRITEOUT(pu); CL_BAR(); } }
    } else {
        RwkvConst K; rwkv_const_load(K, a, l, h, tid);
        RwkvRaw R[2]; float xr[2][8], xk[2][8], xv[2][8];
        FOR_VW(rwkv_raw_load_vw(R[vs], a, UB_(0), UC_(0), h, vw, lane));
        rwkv_touch(a, UB_(1), UC_(1), h, L, wave, lane);
        FOR_VW(rw_F1(a, l, K, R[vs], UB_(0), UC_(0), h, xr[vs], xk[vs], xv[vs], L, vw, lane));
        CL_BAR();
        FOR_VW(rw_F2(a, l, h, L, vw, lane));
        CL_BAR();
        FOR_VW(rw_F3b(a, K, UB_(0), UC_(0), h, xr[vs], xk[vs], xv[vs], L, vw, lane));
        CL_BAR();
        chunk_back<0>(L, false, PU_(0), a.ws, tid);
#pragma unroll 1
        for (int i = 0; i < 16; ++i) { const size_t pu = PU_(i);
            if (i + 1 < 16) { FOR_VW(rwkv_raw_load_vw(R[vs], a, UB_(i + 1), UC_(i + 1), h, vw, lane)); }
            chunk_jobs(L, false, pu, a.ws, wave, lane);
            if (i + 1 < 16) {
                FOR_VW(rw_F1(a, l, K, R[vs], UB_(i + 1), UC_(i + 1), h, xr[vs], xk[vs], xv[vs], L, vw, lane));
                rwkv_touch(a, UB_((i + 2) & 15), UC_((i + 2) & 15), h, L, wave, lane);
                CL_BAR();
                FOR_VW(rw_F2(a, l, h, L, vw, lane));
                CL_BAR();
                FOR_VW(rw_F3b(a, K, UB_(i + 1), UC_(i + 1), h, xr[vs], xk[vs], xv[vs], L, vw, lane));
                CL_BAR();
                chunk_back<0>(L, false, PU_(i + 1), a.ws, tid);
            } else { CL_BAR(); } }
    }
#undef PU_
}
__device__ __forceinline__ void chunk_pipeline_gdn(const Args& a, int l, int vcu, int h, LAS unsigned char* L, int tid) {
    const int lane = tid & 63, wave = __builtin_amdgcn_readfirstlane(tid >> 6);
    const int c0 = vcu >> 3;
#define PU_(i_) (((size_t)(NB + (((c0) + 32 * (i_)) >> 6)) * 4 + h) * 64 + (((c0) + 32 * (i_)) & 63))
    if (wave < 2) {
        SOLVE_DECL();
        CL_BAR(); CL_BAR();
        chunk_back<0>(L, true, PU_(0), a.ws, tid);
#pragma unroll 1
        for (int i = 0; i < 16; ++i) { const size_t pu = PU_(i);
            SOLVE_R_0_51
            if (i + 1 < 16) {
                CL_BAR();
                SOLVE_R_51_64 SOLVE_WRITEOUT(pu);
                CL_BAR();
                chunk_back<0>(L, true, PU_(i + 1), a.ws, tid);
            } else { SOLVE_R_51_64 SOLVE_WRITEOUT(pu); CL_BAR(); } }
    } else {
        GdnConst K; gdn_const_load(K, a, l, h, tid);
        GdnRaw R[2]; float gl[2][8], vv[2][8];
        FOR_VW(gdn_raw_load_vw(R[vs], a, UB_(0), UC_(0), h, vw, lane)); gdn_touch(a, UB_(1), UC_(1), h, L, wave, lane); FOR_VW(gd_Fa(K, R[vs], gl[vs], vv[vs], L, vw, lane));
        CL_BAR();
        FOR_VW(gd_Fb(gl[vs], vv[vs], L, vw, lane));
        CL_BAR();
        chunk_back<0>(L, true, PU_(0), a.ws, tid);
#pragma unroll 1
        for (int i = 0; i < 16; ++i) { const size_t pu = PU_(i);
            gdn_touch(a, UB_((i + 2) & 15), UC_((i + 2) & 15), h, L, wave, lane);
            if (i + 1 < 16) { FOR_VW(gdn_raw_load_vw(R[vs], a, UB_(i + 1), UC_(i + 1), h, vw, lane)); }
            chunk_jobs(L, true, pu, a.ws, wave, lane);
            if (i + 1 < 16) {
                FOR_VW(gd_Fa(K, R[vs], gl[vs], vv[vs], L, vw, lane));
                CL_BAR();
                FOR_VW(gd_Fb(gl[vs], vv[vs], L, vw, lane));
                CL_BAR();
                chunk_back<0>(L, true, PU_(i + 1), a.ws, tid);
            } else { CL_BAR(); } }
    }
#undef PU_
#undef UB_
#undef UC_
}
#undef FOR_VW

constexpr int CS_BUF = 7 * 8192 + 256;
static_assert(2 * CS_BUF + 2 * 16384 <= PH_SCRATCH, "chunk-scan LDS");
#define CS_BAR() asm volatile("s_waitcnt lgkmcnt(0)\n\ts_barrier" ::: "memory")
__device__ __forceinline__ void chunk_scan_unit(const Args& a, int l, int u, LAS unsigned char* L, int tid) {
    const int wave = __builtin_amdgcn_readfirstlane(tid >> 6), lane = tid & 63;
    const int mixer = u >> 5, bh = u & 31, b = bh >> 2, h = bh & 3;
    const size_t pu0 = ((size_t)(mixer * NB + b) * 4 + h) * 64;
    if (wave >= 2) {
        const GAS unsigned char* pkg = (const GAS unsigned char*)(a.ws + WS_PK) + pu0 * 8192;
        const GAS unsigned char* wcg = (const GAS unsigned char*)(a.ws + WS_PKWC) + pu0 * 256;
        const int ll = (wave - 2) * 64 + lane;
        v4u RA[10], RB[10];
#define CS_LD(set_, c_) do { _Pragma("unroll") for (int k_ = 0; k_ < 9; ++k_) { const int p_ = ll + 384 * k_; \
            set_[k_] = *(const GAS v4u*)(pkg + (size_t)(c_) * 8192 + (size_t)(p_ >> 9) * PK_STRIDE + (p_ & 511) * 16); } \
          { const int p_ = ll + 384 * 9; const int pw_ = (p_ < 3600 ? p_ : 3599) - 3584;     \
            const GAS v4u* src_ = (p_ < 3584) ? (const GAS v4u*)(pkg + (size_t)(c_) * 8192 + (size_t)6 * PK_STRIDE + (p_ & 511) * 16) : (const GAS v4u*)(wcg + (size_t)(c_) * 256 + pw_ * 16); \
            set_[9] = *src_; } } while (0)
#define CS_ST(set_, buf_) do { _Pragma("unroll") for (int k_ = 0; k_ < 9; ++k_) { const int p_ = ll + 384 * k_; *(LAS v4u*)(L + (buf_) * CS_BUF + p_ * 16) = set_[k_]; } \
          { const int p_ = ll + 384 * 9; if (p_ < 3600) *(LAS v4u*)(L + (buf_) * CS_BUF + p_ * 16) = set_[9]; } } while (0)
        typedef unsigned u32x2 __attribute__((ext_vector_type(2)));
        const int lw = wave - 2, rg = lane >> 4, j4 = 4 * (lane & 15), ch = h * 64 + j4;
        const GAS bf16* Pz = (const GAS bf16*)(a.ws + WS_PROJ) + (size_t)(b * TSEQ) * NPJ + (mixer ? C_CZ : C_AZ) + ch;
        const GAS float* RVp = (const GAS float*)(a.ws + WS_RARR + 5 * ARR_STRIDE) + (size_t)(b * TSEQ) * 256 + ch; const GAS float* BONp = (const GAS float*)(a.ws + WS_BONUS) + (size_t)(b * TSEQ) * 4 + h;
        GAS bf16* OCp = (GAS bf16*)(a.ws + WS_OC) + (size_t)(b * TSEQ) * 1024 + (mixer ? 768 : 0) + ch;
        const f32x4 gA = mixer ? *(const GAS f32x4*)((const GAS float*)a.in[26] + l * 64 + j4) : *(const GAS f32x4*)((const GAS float*)a.in[20] + l * 256 + ch);
        const f32x4 gB = mixer ? (f32x4){0.f, 0.f, 0.f, 0.f} : *(const GAS f32x4*)((const GAS float*)a.in[21] + l * 256 + ch);
        u32x2 pz[3]; f32x4 prv[3]; float pbon[3];
#pragma unroll
        for (int k_ = 0; k_ < 3; ++k_) { pz[k_] = (u32x2){0u, 0u}; prv[k_] = (f32x4){0.f, 0.f, 0.f, 0.f}; pbon[k_] = 0.f; }
  \
#define PO_LOAD(c_) do { _Pragma("unroll") for (int k_ = 0; k_ < 3; ++k_) { const int g0_ = lw + 6 * k_; const int g_ = g0_ < 16 ? g0_ : 15; const size_t t_ = (size_t)(c_) * 64 + 4 * g_ + rg; \
            pz[k_] = *(const GAS u32x2*)(Pz + t_ * NPJ); prv[k_] = *(const GAS f32x4*)(RVp + t_ * 256); pbon[k_] = BONp[t_ * 4]; } } while (0)
#define PO_RUN(c_) do { const LAS float* OB_ = (const LAS float*)(L + 2 * CS_BUF + ((c_) & 1) * 16384); \
        _Pragma("unroll") for (int k_ = 0; k_ < 3; ++k_) { const int g0_ = lw + 6 * k_; const int g_ = g0_ < 16 ? g0_ : 15; { const int tt_ = 4 * g_ + rg; const f32x4 o_ = *(const LAS f32x4*)(OB_ + tt_ * 64 + j4); f32x4 y_; \
            if (!mixer) { const float mean_ = row16_sum((o_.x + o_.y) + (o_.z + o_.w)) * (1.f / 64.f); const f32x4 d_ = o_ - mean_; \
                const float var_ = row16_sum((d_.x * d_.x + d_.y * d_.y) + (d_.z * d_.z + d_.w * d_.w)) * (1.f / 64.f); y_ = d_ * rsq_fast(var_ + GN_EPS) * gA + gB + pbon[k_] * prv[k_]; } \
            else { const float ms_ = row16_sum((o_.x * o_.x + o_.y * o_.y) + (o_.z * o_.z + o_.w * o_.w)) * (1.f / 64.f); y_ = o_ * rsq_fast(ms_ + GDN_EPS) * gA; } \
            y_.x *= silu_fast(__uint_as_float(pz[k_].x << 16)); y_.y *= silu_fast(__uint_as_float(pz[k_].x & 0xffff0000u)); y_.z *= silu_fast(__uint_as_float(pz[k_].y << 16)); y_.w *= silu_fast(__uint_as_float(pz[k_].y & 0xffff0000u)); \
            u32x2 w_; w_.x = pk2(y_.x, y_.y); w_.y = pk2(y_.z, y_.w); if ((c_) >= 0) *(GAS u32x2*)(OCp + ((size_t)(c_) * 64 + tt_) * 1024) = w_; } } } while (0)
        CS_LD(RA, 0); CS_ST(RA, 0); CS_LD(RB, 1); CS_LD(RA, 2);
        CS_BAR();
        for (int c = 0; c < 64; c += 2) {
            PO_RUN(c - 1);
            PO_LOAD(c);
            CS_ST(RB, 1); CS_LD(RB, (c + 3 < 64 ? c + 3 : 63));
            CS_BAR();
            PO_RUN(c); PO_LOAD(c + 1);
            CS_ST(RA, 0);
            CS_LD(RA, (c + 4 < 64 ? c + 4 : 63));
            CS_BAR();
        }
        PO_RUN(63);
#undef PO_LOAD
#undef PO_RUN
#undef CS_LD
#undef CS_ST
        return;
    }
    const int r = lane & 31, hh = lane >> 5, ib = wave;
    f32x16 S0, S1;
#pragma unroll
    for (int i = 0; i < 16; ++i) { S0[i] = 0.f; S1[i] = 0.f; }
    CS_BAR();
    __builtin_amdgcn_s_waitcnt(0x0F70);
    for (int c = 0; c < 64; ++c) {
        const LAS unsigned char* pk = L + (c & 1) * CS_BUF;
        const LAS v4u* fWA = (const LAS v4u*)(pk) + lane; const LAS v4u* fRT = (const LAS v4u*)(pk + 8192) + lane; const LAS v4u* fARB = (const LAS v4u*)(pk + 2 * 8192) + lane; const LAS v4u* fBHT = (const LAS v4u*)(pk + 3 * 8192) + lane;
        const LAS v4u* iUV = (const LAS v4u*)(pk + 4 * 8192) + (ib * 4) * 64 + lane; const LAS v4u* iOV = (const LAS v4u*)(pk + 5 * 8192) + (ib * 4) * 64 + lane; const LAS v4u* iKTV = (const LAS v4u*)(pk + 6 * 8192) + (ib * 4) * 64 + lane;
        const LAS float* wc = (const LAS float*)(pk + 7 * 8192) + 4 * hh;
        f32x16 U0, U1, O0, O1, N0, N1;
#define SB_() __builtin_amdgcn_sched_barrier(0)
#define FRV(p_, f_) ((p_)[(f_) * 64])
#define BF_(v_) __builtin_bit_cast(bf16x8, (v_))
        const v4u rU0 = iUV[0], rU1 = iUV[64], rU2 = iUV[128], rU3 = iUV[192], rO0 = iOV[0], rO1 = iOV[64], rO2 = iOV[128], rO3 = iOV[192];
        v4u fa0 = FRV(fWA, 0), fa1 = FRV(fWA, 4), fa2 = FRV(fRT, 0), fa3 = FRV(fRT, 4), fa4 = FRV(fWA, 1), fa5 = FRV(fWA, 5), fa6 = FRV(fRT, 1), fa7 = FRV(fRT, 5);
        SB_();
        unpack8(U0, 0, rU0); unpack8(U0, 1, rU1); unpack8(U1, 0, rU2); unpack8(U1, 1, rU3);
        unpack8(O0, 0, rO0); unpack8(O0, 1, rO1); unpack8(O1, 0, rO2); unpack8(O1, 1, rO3);
        const bf16x8 sb0 = PACK8(S0, 0), sb1 = PACK8(S0, 1), sb2 = PACK8(S1, 0), sb3 = PACK8(S1, 1);
        SB_();
        v4u fb0 = FRV(fWA, 2), fb1 = FRV(fWA, 6), fb2 = FRV(fRT, 2), fb3 = FRV(fRT, 6), fb4 = FRV(fWA, 3), fb5 = FRV(fWA, 7), fb6 = FRV(fRT, 3), fb7 = FRV(fRT, 7);
        const v4u rN0 = iKTV[0], rN1 = iKTV[64], rN2 = iKTV[128], rN3 = iKTV[192];
        f32x4 w0[4], w1[4];
#pragma unroll
        for (int q = 0; q < 4; ++q) { w0[q] = *(const LAS f32x4*)(wc + 8 * q); w1[q] = *(const LAS f32x4*)(wc + 32 + 8 * q); }
        SB_();
        U0 = MFMA32(BF_(fa0), sb0, U0); U1 = MFMA32(BF_(fa1), sb0, U1); O0 = MFMA32(BF_(fa2), sb0, O0); O1 = MFMA32(BF_(fa3), sb0, O1);
        U0 = MFMA32(BF_(fa4), sb1, U0); U1 = MFMA32(BF_(fa5), sb1, U1); O0 = MFMA32(BF_(fa6), sb1, O0); O1 = MFMA32(BF_(fa7), sb1, O1);
        SB_();
        unpack8(N0, 0, rN0); unpack8(N0, 1, rN1); unpack8(N1, 0, rN2); unpack8(N1, 1, rN3);
#pragma unroll
        for (int q = 0; q < 4; ++q) {
            N0[4 * q] += w0[q].x * S0[4 * q]; N0[4 * q + 1] += w0[q].y * S0[4 * q + 1]; N0[4 * q + 2] += w0[q].z * S0[4 * q + 2]; N0[4 * q + 3] += w0[q].w * S0[4 * q + 3];
            N1[4 * q] += w1[q].x * S1[4 * q]; N1[4 * q + 1] += w1[q].y * S1[4 * q + 1]; N1[4 * q + 2] += w1[q].z * S1[4 * q + 2]; N1[4 * q + 3] += w1[q].w * S1[4 * q + 3]; }
        SB_();
        fa0 = FRV(fARB, 0); fa1 = FRV(fARB, 4); fa2 = FRV(fBHT, 0); fa3 = FRV(fBHT, 4); fa4 = FRV(fARB, 1); fa5 = FRV(fARB, 5); fa6 = FRV(fBHT, 1); fa7 = FRV(fBHT, 5);
        SB_();
        U0 = MFMA32(BF_(fb0), sb2, U0); U1 = MFMA32(BF_(fb1), sb2, U1); O0 = MFMA32(BF_(fb2), sb2, O0); O1 = MFMA32(BF_(fb3), sb2, O1);
        U0 = MFMA32(BF_(fb4), sb3, U0); U1 = MFMA32(BF_(fb5), sb3, U1); O0 = MFMA32(BF_(fb6), sb3, O0); O1 = MFMA32(BF_(fb7), sb3, O1);
        SB_();
        fb0 = FRV(fARB, 6); fb1 = FRV(fBHT, 2); fb2 = FRV(fBHT, 6); fb3 = FRV(fARB, 7); fb4 = FRV(fBHT, 3); fb5 = FRV(fBHT, 7);
        const bf16x8 ub0 = PACK8(U0, 0), ub1 = PACK8(U0, 1), ub2 = PACK8(U1, 0), ub3 = PACK8(U1, 1);
        SB_();
        O0 = MFMA32(BF_(fa0), ub0, O0); O1 = MFMA32(BF_(fa1), ub0, O1); N0 = MFMA32(BF_(fa2), ub0, N0); N1 = MFMA32(BF_(fa3), ub0, N1);
        O0 = MFMA32(BF_(fa4), ub1, O0); O1 = MFMA32(BF_(fa5), ub1, O1); N0 = MFMA32(BF_(fa6), ub1, N0); N1 = MFMA32(BF_(fa7), ub1, N1);
        O1 = MFMA32(BF_(fb0), ub2, O1); N0 = MFMA32(BF_(fb1), ub2, N0); N1 = MFMA32(BF_(fb2), ub2, N1);
        O1 = MFMA32(BF_(fb3), ub3, O1); N0 = MFMA32(BF_(fb4), ub3, N0); N1 = MFMA32(BF_(fb5), ub3, N1);
        SB_();
#undef SB_
#undef FRV
#undef BF_
        LAS float* Oc = (LAS float*)(L + 2 * CS_BUF + (c & 1) * 16384) + 32 * ib + r;
#pragma unroll
        for (int i = 0; i < 16; ++i) { Oc[crow16(i, hh) * 64] = O0[i]; Oc[(32 + crow16(i, hh)) * 64] = O1[i]; }
        S0 = N0; S1 = N1;
        CS_BAR();
    }
    float* so = a.out + (mixer ? O_GDP : O_RWP) + ((size_t)(l * NB + b) * 4 + h) * 4096;
    const int i_ = 32 * ib + r;
#pragma unroll
    for (int q = 0; q < 16; ++q) { const int k0 = crow16(q, hh), k1 = 32 + k0;
        if (mixer) { so[k0 * 64 + i_] = S0[q]; so[k1 * 64 + i_] = S1[q]; } else { so[i_ * 64 + k0] = S0[q]; so[i_ * 64 + k1] = S1[q]; } }
}

__device__ __forceinline__ int win_src_col(int n) {
    if (n < 2688) return n;
    if (n < 3968) return n + 8;
    if (n < 4224) return n + 16;
    if (n < 4232) return 2688 + (n - 4224);
    if (n < 4236) return 3976 + (n - 4232);
    if (n < 4240) return 3980 + (n - 4236);
    return -1;
}
__device__ __forceinline__ void transpose_item(const float* W, int Nsrc, bf16* WT, LAS float* scr, int kb, int nb, int lane, bool is_win) {
    const int k0 = 64 * kb, n0 = 32 * nb;
    const int n = n0 + (lane & 31); const int sc = is_win ? win_src_col(n) : n;
    float wv_[32];
#pragma unroll
    for (int i = 0; i < 32; ++i) { const int kk = 2 * i + (lane >> 5); wv_[i] = (sc >= 0) ? W[(size_t)(k0 + kk) * Nsrc + sc] : 0.f; }
#pragma unroll
    for (int i = 0; i < 32; ++i) { const int kk = 2 * i + (lane >> 5); scr[kk * 33 + (lane & 31)] = wv_[i]; }
    LDS_WAIT(); asm volatile("" ::: "memory");
    const int c = lane & 7;
#pragma unroll
    for (int j = 0; j < 4; ++j) { const int nn = (lane >> 3) + 8 * j; const LAS float* s = scr + (8 * c) * 33 + nn;
        v4u o; o.x = pk2(s[0 * 33], s[1 * 33]); o.y = pk2(s[2 * 33], s[3 * 33]); o.z = pk2(s[4 * 33], s[5 * 33]); o.w = pk2(s[6 * 33], s[7 * 33]);
        *(v4u*)(WT + (size_t)(n0 + nn) * 1024 + k0 + 8 * c) = o; }
    LDS_WAIT(); asm volatile("" ::: "memory");
}
__device__ __forceinline__ void phase_prologue(const Args& a, LAS unsigned char* ldsb, int vcu, int G, int tid) {
    const int lane = tid & 63, wave = tid >> 6;
    LAS float* scr = (LAS float*)(ldsb + wave * 16384);
    const int gw = vcu * NWAVES + wave, NGW = G * NWAVES;
    bf16* WinT = (bf16*)(a.ws + WS_WIN); bf16* WoutT = (bf16*)(a.ws + WS_WOUT);
    constexpr int NB_IN = NPJ / 32, I_IN = 16 * NB_IN, I_OUT = 16 * 32, I_L = I_IN + I_OUT;
    for (int it = gw; it < NLAYER * I_L; it += NGW) {
        const int l = it / I_L; int r = it - l * I_L;
        if (r < I_IN) transpose_item(a.in[11] + (size_t)l * 1024 * NIN, NIN, WinT + (size_t)l * NPJ * 1024, scr, r / NB_IN, r % NB_IN, lane, true);
        else { r -= I_IN; transpose_item(a.in[27] + (size_t)l * 1024 * 1024, 1024, WoutT + (size_t)l * 1024 * 1024, scr, r / 32, r % 32, lane, false); }
    }
    { bf16* W2T = (bf16*)(a.ws + WS_W2T); bf16* A2T = (bf16*)(a.ws + WS_A2T);
      for (int idx = vcu * NTHREADS + tid; idx < NLAYER * 256 * 64; idx += G * NTHREADS) { const int l = idx >> 14, c = (idx >> 6) & 255, j = idx & 63;
          W2T[idx] = (bf16)f2bf(a.in[14][((size_t)l * 64 + j) * 256 + c]); A2T[idx] = (bf16)f2bf(a.in[16][((size_t)l * 64 + j) * 256 + c]); } }
    bf16* XB = (bf16*)(a.ws + WS_XB);
    { const GAS f32x4* g4 = (const GAS f32x4*)a.in[9] + lane; const GAS f32x4* b4 = (const GAS f32x4*)a.in[10] + lane; GAS float* XF = (GAS float*)a.out; GAS bf16* XBg = (GAS bf16*)XB;
      for (int m0 = gw * 2; m0 < MROWS; m0 += NGW * 2) {
        f32x4 v[2][4]; float sm[2];
#pragma unroll
        for (int rr = 0; rr < 2; ++rr) { const int m = m0 + rr; const GAS f32x4* xr = (const GAS f32x4*)((m < MP) ? a.in[0] + (size_t)m * 1024 : a.in[1] + (size_t)(m - MP) * 1024) + lane; sm[rr] = 0.f;
#pragma unroll
            for (int q = 0; q < 4; ++q) { v[rr][q] = xr[64 * q]; sm[rr] += (v[rr][q].x + v[rr][q].y) + (v[rr][q].z + v[rr][q].w); } }
        float mean[2], rstd[2];
#pragma unroll
        for (int rr = 0; rr < 2; ++rr) mean[rr] = wave_sum_dpp(sm[rr]) * (1.f / 1024.f);
#pragma unroll
        for (int rr = 0; rr < 2; ++rr) { float s2 = 0.f;
#pragma unroll
            for (int q = 0; q < 4; ++q) { v[rr][q] = v[rr][q] - mean[rr]; s2 += (v[rr][q].x * v[rr][q].x + v[rr][q].y * v[rr][q].y) + (v[rr][q].z * v[rr][q].z + v[rr][q].w * v[rr][q].w); }
            rstd[rr] = 1.f / sqrtf(wave_sum_dpp(s2) * (1.f / 1024.f) + LN_EPS); }
#pragma unroll
        for (int q = 0; q < 4; ++q) { const f32x4 gg = g4[64 * q], bb = b4[64 * q];
#pragma unroll
            for (int rr = 0; rr < 2; ++rr) { const f32x4 o = v[rr][q] * rstd[rr] * gg + bb;
                ((GAS unsigned long long*)(XBg + (size_t)(m0 + rr) * 1024))[lane + 64 * q] = (unsigned long long)pk2(o.x, o.y) | ((unsigned long long)pk2(o.z, o.w) << 32); } }
      } }
}

struct Arr6 { float* p[6]; };
__device__ __forceinline__ Arr6 arr6(unsigned char* ws, size_t base) { Arr6 r;
#pragma unroll
    for (int i = 0; i < 6; ++i) r.p[i] = (float*)(ws + base + (size_t)i * ARR_STRIDE); return r; }

__device__ __forceinline__ void rwkv_prep_tile(const Args& a, int l, int tile, LAS float* XS, int tid) {
    const GAS bf16* P = (const GAS bf16*)(a.ws + WS_PROJ);
    const int m0 = tile * 8; const bool samp = m0 >= MP;
    const int t0 = samp ? ((m0 - MP) & 15) : (m0 & 4095); const int bidx = samp ? ((m0 - MP) >> 4) : (m0 >> 12);
    const GAS float* mu = (const GAS float*)a.in[12] + l * NSHIFT; const GAS float* shst = (const GAS float*)a.in[5] + ((size_t)l * SBATCH + (samp ? bidx : 0)) * NSHIFT;
    for (int idx = tid; idx < 8 * NSHIFT; idx += NTHREADS) {
        const int tok = idx / NSHIFT, c = idx - tok * NSHIFT;
        const float p = bf2f(P[(size_t)(m0 + tok) * NPJ + c]);
        const bool hasp = (t0 + tok > 0); const float pv = bf2f(P[(size_t)(m0 + tok - (hasp ? 1 : 0)) * NPJ + c]); const float sv = shst[c];
        const float prev = hasp ? pv : (samp ? sv : 0.f);
        float xs = p + (prev - p) * mu[c];
        if (c >= 768 && c < 832) xs = tanhf(xs);
        XS[tok * NSHIFT + c] = xs;
    }
    __syncthreads();
    const int g = tid >> 8, c = tid & 255, lane = tid & 63, h = c >> 6;
    float accw[4], acca[4];
    { const float w0v = ((const GAS float*)a.in[13])[l * 256 + c], a0v = ((const GAS float*)a.in[15])[l * 256 + c];
#pragma unroll
      for (int k = 0; k < 4; ++k) { accw[k] = w0v; acca[k] = a0v; } }
    const GAS float* w2 = (const GAS float*)a.in[14] + (size_t)l * 64 * 256 + c; const GAS float* a2 = (const GAS float*)a.in[16] + (size_t)l * 64 * 256 + c;
    const LAS float* xg = XS + (g * 4) * NSHIFT;
#pragma unroll 4
    for (int j = 0; j < 64; ++j) { const float wv = w2[j * 256], av = a2[j * 256];
#pragma unroll
        for (int k = 0; k < 4; ++k) { accw[k] += xg[k * NSHIFT + 768 + j] * wv; acca[k] += xg[k * NSHIFT + 832 + j] * av; } }
    const float kkc = ((const GAS float*)a.in[17])[l * 256 + c], kac = ((const GAS float*)a.in[18])[l * 256 + c], rkc = ((const GAS float*)a.in[19])[l * 256 + c];
    Arr6 R = arr6(a.ws, WS_RARR); float* BON = (float*)(a.ws + WS_BONUS);
#pragma unroll
    for (int k = 0; k < 4; ++k) { const int m = m0 + g * 4 + k; const size_t o = (size_t)m * 256 + c;
        const float r = xg[k * NSHIFT + c], kx = xg[k * NSHIFT + 256 + c], v = xg[k * NSHIFT + 512 + c];
        const float dec = __expf(-0.6065306597126334f * sigmoid_f(accw[k]));
        const float aa = sigmoid_f(acca[k]);
        const float kkr = kx * kkc; const float ss = wave_sum(kkr * kkr); const float kkn = kkr * __builtin_amdgcn_rcpf(fmaxf(__builtin_amdgcn_sqrtf(ss), 1e-12f));
        const float kmod = kx * (1.f + (aa - 1.f) * kac);
        const float bon = wave_sum(r * kmod * rkc);
        R.p[0][o] = dec; R.p[1][o] = kkn; R.p[2][o] = -kkn * aa; R.p[3][o] = kmod; R.p[4][o] = r; R.p[5][o] = v;
        if (lane == 0) BON[m * 4 + h] = bon; }
    __syncthreads();
}
__device__ __forceinline__ void gdn_prep_tile(const Args& a, int l, int tile, int tid) {
    const GAS bf16* P = (const GAS bf16*)(a.ws + WS_PROJ); const GAS float* SM = (const GAS float*)(a.ws + WS_SMALL);
    const int m0 = tile * 8; const bool samp = m0 >= MP;
    const int t0 = samp ? ((m0 - MP) & 15) : (m0 & 4095); const int bidx = samp ? ((m0 - MP) >> 4) : (m0 >> 12);
    const int g = tid >> 8, c = tid & 255, lane = tid & 63, h = c >> 6;
    const GAS float* cw = (const GAS float*)a.in[23] + (size_t)l * 4 * NCONV; const GAS float* cst = (const GAS float*)a.in[7] + ((size_t)l * SBATCH + (samp ? bidx : 0)) * 3 * NCONV;
    float xr[7][3], cwv[4][3];
#pragma unroll
    for (int i = 0; i < 7; ++i) { const int tt = t0 + g * 4 - 3 + i;
#pragma unroll
        for (int x = 0; x < 3; ++x) { const int col = x * 256 + c;
            const float pv = bf2f(P[(size_t)(m0 - t0 + (tt < 0 ? 0 : tt)) * NPJ + C_CQKV + col]); const float cv = cst[(tt < 0 ? 3 + tt : 0) * NCONV + col];
            xr[i][x] = tt >= 0 ? pv : (samp ? cv : 0.f); } }
#pragma unroll
    for (int i = 0; i < 4; ++i)
#pragma unroll
        for (int x = 0; x < 3; ++x) cwv[i][x] = cw[i * NCONV + x * 256 + c];
    const float alog = ((const GAS float*)a.in[24])[l * 4 + h], dtb = ((const GAS float*)a.in[25])[l * 4 + h];
    Arr6 Gm = arr6(a.ws, WS_GARR);
#pragma unroll
    for (int k = 0; k < 4; ++k) { const int m = m0 + g * 4 + k; const size_t o = (size_t)m * 256 + c;
        float y[3];
#pragma unroll
        for (int x = 0; x < 3; ++x) { float s = 0.f;
#pragma unroll
            for (int i = 0; i < 4; ++i) s += cwv[i][x] * xr[k + i][x];
            y[x] = silu_f(s); }
        const float qs = wave_sum(y[0] * y[0]), ks = wave_sum(y[1] * y[1]);
        const float qn = y[0] * __builtin_amdgcn_rsqf(qs + L2_EPS) * 0.125f, kn = y[1] * __builtin_amdgcn_rsqf(ks + L2_EPS);
        const float beta = sigmoid_f(SM[(size_t)m * 16 + 8 + h]);
        const float gg = -__expf(alog) * softplus_f(SM[(size_t)m * 16 + 12 + h] + dtb); const float eg = __expf(gg);
        Gm.p[0][o] = eg; Gm.p[1][o] = kn; Gm.p[2][o] = -eg * beta * kn; Gm.p[3][o] = beta * kn; Gm.p[4][o] = qn; Gm.p[5][o] = y[2]; }
}
__device__ __forceinline__ void fox_cum_prompt(const Args& a, int l, int b, LAS float* SEG, int tid) {
    const GAS float* SM = (const GAS float*)(a.ws + WS_SMALL); const int h = tid & 7, seg = tid >> 3; const float bfv = a.in[22][l * 8 + h];
    GAS float* lfo = (GAS float*)a.out + O_FLP + ((size_t)(l * NB + b) * TSEQ) * 8;
    float sum = 0.f;
#pragma unroll 1
    for (int g = 0; g < 4; ++g) { float lf[16];
#pragma unroll
        for (int i = 0; i < 16; ++i) lf[i] = SM[((size_t)b * TSEQ + seg * 64 + g * 16 + i) * 16 + h];
#pragma unroll
        for (int i = 0; i < 16; ++i) { const float v = logsigmoid_f(lf[i] + bfv); lfo[(seg * 64 + g * 16 + i) * 8 + h] = v; sum += v; } }
    SEG[seg * 8 + h] = sum; __syncthreads();
    float c = 0.f; for (int s = 0; s < seg; ++s) c += SEG[s * 8 + h];
    GAS float* CB = (GAS float*)(a.ws + WS_CB) + (size_t)(b * 8 + h) * TSEQ;
#pragma unroll 1
    for (int g = 0; g < 4; ++g) { float lf[16];
#pragma unroll
        for (int i = 0; i < 16; ++i) lf[i] = SM[((size_t)b * TSEQ + seg * 64 + g * 16 + i) * 16 + h];
#pragma unroll
        for (int i = 0; i < 16; ++i) { c += logsigmoid_f(lf[i] + bfv); CB[seg * 64 + g * 16 + i] = c * LOG2E; } }
    __syncthreads();
}
__device__ __forceinline__ void fox_cum_sample(const Args& a, int l, int b, LAS float* SEG, int tid) {
    const GAS float* SM = (const GAS float*)(a.ws + WS_SMALL); const int h = tid & 7, seg = tid >> 3; const float bfv = a.in[22][l * 8 + h];
    const GAS float* clf = (const GAS float*)a.in[4] + ((size_t)(l * SBATCH + b) * PAST) * 8;
    float lf[32]; float sum = 0.f;
#pragma unroll
    for (int i = 0; i < 32; ++i) { lf[i] = clf[(seg * 32 + i) * 8 + h]; }
#pragma unroll
    for (int i = 0; i < 32; ++i) sum += lf[i];
    SEG[seg * 8 + h] = sum; __syncthreads();
    float post = 0.f; for (int s = seg + 1; s < 64; ++s) post += SEG[s * 8 + h];
    GAS float* CBS = (GAS float*)(a.ws + WS_CBS) + (size_t)(b * 8 + h) * 2064;
#pragma unroll
    for (int i = 31; i >= 0; --i) { CBS[seg * 32 + i] = post * LOG2E; post += lf[i]; }
    if (seg == 0) { float run = 0.f; GAS float* lfo = (GAS float*)a.out + O_FLS + ((size_t)(l * SBATCH + b) * STOK) * 8; float ln[STOK];
#pragma unroll
        for (int i = 0; i < STOK; ++i) ln[i] = SM[((size_t)MP + b * STOK + i) * 16 + h];
#pragma unroll
        for (int i = 0; i < STOK; ++i) { const float v = logsigmoid_f(ln[i] + bfv); lfo[i * 8 + h] = v; run += v; CBS[PAST + i] = -run * LOG2E; } }
    __syncthreads();
}
__device__ __forceinline__ void phase_prep(const Args& a, int l, LAS unsigned char* ldsb, int vcu, int G, int tid) {
    LAS float* XS = (LAS float*)ldsb; const int wvp = __builtin_amdgcn_readfirstlane(tid >> 6);
    { const int sub = vcu & 7, mixer = sub >> 2, h = sub & 3;
      if (mixer == 0) chunk_pipeline_rwkv(a, l, vcu, h, ldsb, tid); else chunk_pipeline_gdn(a, l, vcu, h, ldsb, tid); }
    { int wv_ = wvp; unsigned zz_ = 0u; asm volatile("" : "+s"(wv_), "+s"(zz_)); tid = (wv_ << 6) | (int)__builtin_amdgcn_mbcnt_hi(~0u, __builtin_amdgcn_mbcnt_lo(~0u, zz_)); asm volatile("" : "+v"(tid)); }
    for (int ht = vcu; ht < 2 * (MS / 8); ht += G) { const int tile = MP / 8 + (ht >> 1); if (ht & 1) gdn_prep_tile(a, l, tile, tid); else rwkv_prep_tile(a, l, tile, XS, tid); }
    LAS float* SEG = (LAS float*)(ldsb + 32768);
    for (int u = vcu - 128; u >= 0 && u < NB + SBATCH; u += G) { if (u < NB) fox_cum_prompt(a, l, u, SEG, tid); else fox_cum_sample(a, l, u - NB, SEG, tid); }
    const bf16* P = (const bf16*)(a.ws + WS_PROJ);
    for (int idx = vcu * NTHREADS + tid; idx < (NB + SBATCH) * 3200; idx += G * NTHREADS) {
        const int seq = idx / 3200, r = idx - seq * 3200; const bool pr = seq < NB; const int b = pr ? seq : seq - NB;
        const size_t last = pr ? (size_t)b * TSEQ + (TSEQ - 1) : (size_t)MP + b * STOK + (STOK - 1);
        if (r < NSHIFT) { const float v = bf2f(P[last * NPJ + r]); a.out[(pr ? O_SHP + (size_t)(l * NB + b) * NSHIFT : O_SHS + (size_t)(l * SBATCH + b) * NSHIFT) + r] = v; }
        else { const int r2 = r - NSHIFT, i = r2 / NCONV, c = r2 - i * NCONV; const float v = bf2f(P[(last - 2 + i) * NPJ + C_CQKV + c]);
            a.out[(pr ? O_CVP + (size_t)(l * NB + b) * 3 * NCONV : O_CVS + (size_t)(l * SBATCH + b) * 3 * NCONV) + i * NCONV + c] = v; }
    }
}
constexpr int SC_TS = 32, SC_BUF = SC_TS * 5 * 64 * 4, SC_VS_OFF = 2 * SC_BUF, SC_VS = SC_TS * 32 * 4, SC_OS_OFF = SC_VS_OFF + 2 * SC_VS, SC_END = SC_OS_OFF + 2 * SC_VS;
static_assert(SC_END <= PH_SCRATCH, "scan LDS");
__device__ __forceinline__ void scan_unit(LAS unsigned char* ldsb, const Arr6& X, float* O, int rowbase, int nsteps, int h, int half,
                                          const float* s_init, float* s_out, bool transposed, int tid) {
    const int lane = tid & 63, wave = tid >> 6, j = lane & 15, rg = lane >> 4, row = 32 * half + 4 * wave + rg;
    f32x4 s = (f32x4){0.f, 0.f, 0.f, 0.f};
    if (s_init) { if (!transposed) s = *(const f32x4*)(s_init + row * 64 + 4 * j);
                  else { s.x = s_init[(4 * j + 0) * 64 + row]; s.y = s_init[(4 * j + 1) * 64 + row]; s.z = s_init[(4 * j + 2) * 64 + row]; s.w = s_init[(4 * j + 3) * 64 + row]; } }
    const int lt = tid >> 4, lq = tid & 15;
    const int colw = h * 64 + lq * 4, colv = h * 64 + 32 * half + lq * 2;
    const int nchunks = (nsteps + SC_TS - 1) / SC_TS;
    f32x4 ld[5]; f32x2 lv;
#define SC_GLOAD(c_) do { const int t_ = (c_) * SC_TS + lt; if (t_ < nsteps) { const size_t ro_ = (size_t)(rowbase + t_) * 256; \
        _Pragma("unroll") for (int q_ = 0; q_ < 5; ++q_) ld[q_] = *(const f32x4*)(X.p[q_] + ro_ + colw); lv = *(const f32x2*)(X.p[5] + ro_ + colv); } \
        else { _Pragma("unroll") for (int q_ = 0; q_ < 5; ++q_) ld[q_] = (f32x4){0.f, 0.f, 0.f, 0.f}; lv = (f32x2){0.f, 0.f}; } } while (0)
#define SC_LSTORE(b_) do { LAS float* B_ = (LAS float*)(ldsb + (b_) * SC_BUF); \
        _Pragma("unroll") for (int q_ = 0; q_ < 5; ++q_) *(LAS f32x4*)(B_ + (lt * 5 + q_) * 64 + lq * 4) = ld[q_]; \
        *(LAS f32x2*)((LAS float*)(ldsb + SC_VS_OFF + (b_) * SC_VS) + lt * 32 + lq * 2) = lv; } while (0)
    SC_GLOAD(0); SC_LSTORE(0); __syncthreads();
    for (int c = 0; c < nchunks; ++c) {
        const int b = c & 1;
        if (c + 1 < nchunks) SC_GLOAD(c + 1);
        const int steps = (nsteps - c * SC_TS) < SC_TS ? (nsteps - c * SC_TS) : SC_TS;
        const LAS float* Bf = (const LAS float*)(ldsb + b * SC_BUF) + 4 * j;
        const LAS float* VSb = (const LAS float*)(ldsb + SC_VS_OFF + b * SC_VS) + 4 * wave + rg;
        LAS float* OSb = (LAS float*)(ldsb + SC_OS_OFF + b * SC_VS);
#pragma unroll 4
        for (int tt = 0; tt < steps; ++tt) {
            const f32x4 W4 = *(const LAS f32x4*)(Bf + (tt * 5 + 0) * 64), A4 = *(const LAS f32x4*)(Bf + (tt * 5 + 1) * 64), B4 = *(const LAS f32x4*)(Bf + (tt * 5 + 2) * 64),
                        K4 = *(const LAS f32x4*)(Bf + (tt * 5 + 3) * 64), R4 = *(const LAS f32x4*)(Bf + (tt * 5 + 4) * 64);
            const float v = VSb[tt * 32];
            float d = (s.x * A4.x + s.y * A4.y) + (s.z * A4.z + s.w * A4.w); d = row16_sum(d);
            s = s * W4 + d * B4 + v * K4;
            float o = (s.x * R4.x + s.y * R4.y) + (s.z * R4.z + s.w * R4.w); o = row16_sum(o);
            if (j == 0) OSb[tt * 32 + 4 * wave + rg] = o;
        }
        if (c + 1 < nchunks) SC_LSTORE(b ^ 1);
        __syncthreads();
        { const int t_ = c * SC_TS + lt; if (t_ < nsteps) *(f32x2*)(O + (size_t)(rowbase + t_) * 256 + colv) = *(const LAS f32x2*)(OSb + lt * 32 + lq * 2); }
    }
#undef SC_GLOAD
#undef SC_LSTORE
    if (!transposed) *(f32x4*)(s_out + row * 64 + 4 * j) = s;
    else { s_out[(4 * j + 0) * 64 + row] = s.x; s_out[(4 * j + 1) * 64 + row] = s.y; s_out[(4 * j + 2) * 64 + row] = s.z; s_out[(4 * j + 3) * 64 + row] = s.w; }
    __syncthreads();
}
__device__ __forceinline__ void scan_sample_unit(const Args& a, int l, int u, LAS unsigned char* ldsb, int tid) {
    const int mixer = u >> 8, bh = (u & 255) >> 1, half = u & 1, b = bh >> 2, h = bh & 3;
    const Arr6 X = arr6(a.ws, mixer ? WS_GARR : WS_RARR); float* O = (float*)(a.ws + (mixer ? WS_OG : WS_OA));
    const size_t so_ = ((size_t)(l * SBATCH + b) * 4 + h) * 4096;
    scan_unit(ldsb, X, O, MP + b * STOK, STOK, h, half, a.in[mixer ? 8 : 6] + so_, a.out + (mixer ? O_GDS : O_RWS) + so_, mixer != 0, tid);
}

__device__ __forceinline__ void fox_sample_unit(const Args& a, int l, int bh, LAS unsigned char* ldsb, int tid) {
    const int b = bh >> 3, h = bh & 7, lane = tid & 63, wave = __builtin_amdgcn_readfirstlane(tid >> 6), r = lane & 31, hh = lane >> 5;
    const GAS bf16* P = (const GAS bf16*)(a.ws + WS_PROJ); const int m0 = MP + b * STOK;
    LAS float* PM = (LAS float*)ldsb; LAS float* PL = PM + 128; LAS float* PO = PM + 256;
    LAS float* BL = (LAS float*)(ldsb + 36864); LAS float* WSF = (LAS float*)(ldsb + 49152) + wave * 64;
    { const GAS float* cbs = (const GAS float*)(a.ws + WS_CBS) + (size_t)bh * 2064;
      for (int i = tid; i < 2080; i += NTHREADS) BL[i] = (i < 2064) ? cbs[i] : 0.f; }
    bf16x8 qf[4];
#pragma unroll
    for (int s_ = 0; s_ < 4; ++s_) { qf[s_] = (bf16x8){0, 0, 0, 0, 0, 0, 0, 0}; if (r < 16) qf[s_] = *(const GAS bf16x8*)(P + (size_t)(m0 + r) * NPJ + C_Q + h * 64 + 16 * s_ + 8 * hh); }
    __syncthreads();
    const GAS float* Kc = (const GAS float*)a.in[2] + ((size_t)(l * SBATCH + b) * PAST * 8 + h) * 64; const GAS float* Vc = (const GAS float*)a.in[3] + ((size_t)(l * SBATCH + b) * PAST * 8 + h) * 64;
    const GAS float* Kn = (const GAS float*)a.out + O_FKS + ((size_t)(l * SBATCH + b) * STOK * 8 + h) * 64; const GAS float* Vn = (const GAS float*)a.out + O_FVS + ((size_t)(l * SBATCH + b) * STOK * 8 + h) * 64;
    f32x4 kr[8]; float vr[32];
#define FS_LOADT(t_) do { const bool nw_ = (t_) == 64; const GAS float* kb_ = nw_ ? Kn : Kc + (size_t)(t_) * 32 * 512; const GAS float* vb_ = nw_ ? Vn : Vc + (size_t)(t_) * 32 * 512; const int lim_ = nw_ ? 15 : 31; \
        const GAS float* kp_ = kb_ + (size_t)(r < lim_ ? r : lim_) * 512 + 8 * hh; \
        _Pragma("unroll") for (int s_ = 0; s_ < 4; ++s_) { kr[2 * s_] = *(const GAS f32x4*)(kp_ + 16 * s_); kr[2 * s_ + 1] = *(const GAS f32x4*)(kp_ + 16 * s_ + 4); } \
        _Pragma("unroll") for (int f_ = 0; f_ < 4; ++f_) _Pragma("unroll") for (int e_ = 0; e_ < 8; ++e_) { int ke_ = 16 * (f_ & 1) + 8 * (e_ >> 2) + 4 * hh + (e_ & 3); ke_ = ke_ < lim_ ? ke_ : lim_; \
            vr[f_ * 8 + e_] = vb_[(size_t)ke_ * 512 + 32 * (f_ >> 1) + r]; } } while (0)
    const int tstart = (wave == 0) ? 64 : 56 + wave;
    FS_LOADT(tstart);
    float mref = -1e30f, lsum = 0.f; f32x16 O0, O1;
#pragma unroll
    for (int i = 0; i < 16; ++i) { O0[i] = 0.f; O1[i] = 0.f; }
    for (int t = tstart; t >= 0; t -= 8) {
        bf16x8 kf[4], vf[4];
#pragma unroll
        for (int s_ = 0; s_ < 4; ++s_) kf[s_] = pack8v(kr[2 * s_].x, kr[2 * s_].y, kr[2 * s_].z, kr[2 * s_].w, kr[2 * s_ + 1].x, kr[2 * s_ + 1].y, kr[2 * s_ + 1].z, kr[2 * s_ + 1].w);
#pragma unroll
        for (int f_ = 0; f_ < 4; ++f_) vf[f_] = pack8v(vr[8 * f_], vr[8 * f_ + 1], vr[8 * f_ + 2], vr[8 * f_ + 3], vr[8 * f_ + 4], vr[8 * f_ + 5], vr[8 * f_ + 6], vr[8 * f_ + 7]);
        if (t >= 8) FS_LOADT(t - 8);
        f32x16 S;
#pragma unroll
        for (int i = 0; i < 16; ++i) S[i] = 0.f;
#pragma unroll
        for (int s_ = 0; s_ < 4; ++s_) S = MFMA32(kf[s_], qf[s_], S);
#pragma unroll
        for (int g = 0; g < 4; ++g) { const f32x4 b4 = *(const LAS f32x4*)(BL + 32 * t + 8 * g + 4 * hh); S[4 * g] += b4.x; S[4 * g + 1] += b4.y; S[4 * g + 2] += b4.z; S[4 * g + 3] += b4.w; }
        if (t == 64) {
#pragma unroll
            for (int i = 0; i < 16; ++i) { const int kn = crow16(i, hh); if (kn > r || kn >= STOK) S[i] = -INFINITY; } }
        float mt = S[0];
#pragma unroll
        for (int i = 1; i < 16; ++i) mt = fmaxf(mt, S[i]);
        { auto rr = __builtin_amdgcn_permlane32_swap(__float_as_uint(mt), __float_as_uint(mt), false, false); mt = fmaxf(__uint_as_float(rr[0]), __uint_as_float(rr[1])); }
        if (__any(mt > mref + 8.f)) {
            const float nref = fmaxf(mref, mt); const float f = __builtin_amdgcn_exp2f(mref - nref); mref = nref; lsum *= f;
            if (hh == 0) WSF[r] = f;
            asm volatile("s_waitcnt lgkmcnt(0)" ::: "memory");
#pragma unroll
            for (int i = 0; i < 16; ++i) { const float fr = WSF[crow16(i, hh)]; O0[i] *= fr; O1[i] *= fr; }
            asm volatile("s_waitcnt lgkmcnt(0)" ::: "memory");
        }
#pragma unroll
        for (int i = 0; i < 16; ++i) { S[i] = __builtin_amdgcn_exp2f(S[i] - mref); lsum += S[i]; }
        const bf16x8 pf0 = PACK8(S, 0), pf1 = PACK8(S, 1);
        O0 = MFMA32(pf0, vf[0], O0); O0 = MFMA32(pf1, vf[1], O0); O1 = MFMA32(pf0, vf[2], O1); O1 = MFMA32(pf1, vf[3], O1);
    }
#undef FS_LOADT
    { auto rr = __builtin_amdgcn_permlane32_swap(__float_as_uint(lsum), __float_as_uint(lsum), false, false); lsum = __uint_as_float(rr[0]) + __uint_as_float(rr[1]); }
    if (lane < 16) { PM[wave * 16 + lane] = mref; PL[wave * 16 + lane] = lsum; }
#pragma unroll
    for (int i = 0; i < 8; ++i) { const int q = crow16(i, hh); PO[(wave * 16 + q) * 64 + r] = O0[i]; PO[(wave * 16 + q) * 64 + 32 + r] = O1[i]; }
    __syncthreads();
    { const int q = tid >> 5, d = (tid & 31) * 2;
      float M_ = PM[q];
#pragma unroll
      for (int w = 1; w < 8; ++w) M_ = fmaxf(M_, PM[w * 16 + q]);
      float L_ = 0.f, o0 = 0.f, o1 = 0.f;
#pragma unroll
      for (int w = 0; w < 8; ++w) { const float e = __builtin_amdgcn_exp2f(PM[w * 16 + q] - M_); L_ += PL[w * 16 + q] * e; o0 += PO[(w * 16 + q) * 64 + d] * e; o1 += PO[(w * 16 + q) * 64 + d + 1] * e; }
      const unsigned zz = *(const unsigned*)(P + (size_t)(m0 + q) * NPJ + C_BZ + h * 64 + d);
      const float z0 = __uint_as_float(zz << 16), z1 = __uint_as_float(zz & 0xffff0000u);
      const float r = 1.f / L_;
      bf16* OC = (bf16*)(a.ws + WS_OC);
      *(unsigned*)(OC + (size_t)(m0 + q) * 1024 + 256 + h * 64 + d) = pk2(o0 * r * silu_f(z0), o1 * r * silu_f(z1)); }
    __syncthreads();
}

__device__ __forceinline__ void phase2_queue(const Args& a, int l, const attn_body::AttnTensors& T, LAS unsigned char* ldsb, unsigned* ctr, volatile LAS unsigned* qw) {
    const int tid = threadIdx.x; unsigned nxt = 0u;
    if (tid == 0) nxt = __hip_atomic_fetch_add(ctr, 1u, __ATOMIC_RELAXED, __HIP_MEMORY_SCOPE_AGENT);
    for (;;) {
        if (tid == 0) *qw = nxt;
        asm volatile("s_waitcnt lgkmcnt(0)\n\ts_barrier" ::: "memory");
        const unsigned n = (unsigned)__builtin_amdgcn_readfirstlane((int)*qw);
        asm volatile("s_waitcnt lgkmcnt(0)\n\ts_barrier" ::: "memory");
        if (n >= (unsigned)(8 * 8 * 16 + SBATCH * 8)) break;
        if (tid == 0) nxt = __hip_atomic_fetch_add(ctr, 1u, __ATOMIC_RELAXED, __HIP_MEMORY_SCOPE_AGENT);
        if (n < 512u && (n & 1u)) { int t2 = tid; asm volatile("" : "+v"(t2)); fox_sample_unit(a, l, (int)(n >> 1), ldsb, t2); }
        else { const unsigned an = n < 512u ? (n >> 1) : n - 256u; const int bh = (int)(an & 63u), qb = 15 - (int)(an >> 6);
            attn_body::attn_unit<8>(bh / 8, bh % 8, qb, T.Q, T.K, T.V, T.Z, T.CB + (long)bh * TSEQ, T.O, (char*)ldsb); }
    }
}

__device__ __forceinline__ void phase_ln(const Args& a, int l, int vcu, int G, int tid) {
    const int lane = tid & 63, wave = tid >> 6; const int gw = vcu * NWAVES + wave, NGW = G * NWAVES;
    const GAS bf16* H = (const GAS bf16*)(a.ws + WS_H); GAS bf16* XB = (GAS bf16*)(a.ws + WS_XB); GAS float* XF = (GAS float*)a.out;
    const GAS f32x4* g4 = (const GAS f32x4*)((const GAS float*)a.in[28] + l * 1024) + lane; const GAS f32x4* b4 = (const GAS f32x4*)((const GAS float*)a.in[29] + l * 1024) + lane;
    typedef unsigned long long u64_t;
    u64_t hwA[2][4], xwA[2][4], hwB[2][4], xwB[2][4];
#define LN_LOAD(hw_, xw_, m_) do { const int mm_ = (m_) < MROWS ? (m_) : MROWS - 2; _Pragma("unroll") for (int rr = 0; rr < 2; ++rr) { \
        const GAS u64_t* xr = (const GAS u64_t*)(XB + (size_t)(mm_ + rr) * 1024) + lane; const GAS u64_t* hr = (const GAS u64_t*)(H + (size_t)(mm_ + rr) * 1024) + lane; \
        _Pragma("unroll") for (int q = 0; q < 4; ++q) { hw_[rr][q] = hr[64 * q]; xw_[rr][q] = xr[64 * q]; } } } while (0)
#define LN_BODY(hw_, xw_, m_) do { f32x4 v[2][4]; float s[2]; \
        _Pragma("unroll") for (int rr = 0; rr < 2; ++rr) { s[rr] = 0.f; \
            _Pragma("unroll") for (int q = 0; q < 4; ++q) { const unsigned h0 = (unsigned)hw_[rr][q], h1 = (unsigned)(hw_[rr][q] >> 32); \
                const f32x4 hv = (f32x4){__uint_as_float(h0 << 16), __uint_as_float(h0 & 0xffff0000u), __uint_as_float(h1 << 16), __uint_as_float(h1 & 0xffff0000u)}; \
                const unsigned x0 = (unsigned)xw_[rr][q], x1 = (unsigned)(xw_[rr][q] >> 32); \
                const f32x4 xv = (f32x4){__uint_as_float(x0 << 16), __uint_as_float(x0 & 0xffff0000u), __uint_as_float(x1 << 16), __uint_as_float(x1 & 0xffff0000u)}; \
                v[rr][q] = xv * ALPHA + hv; s[rr] += (v[rr][q].x + v[rr][q].y) + (v[rr][q].z + v[rr][q].w); } } \
        float mean[2], rstd[2]; \
        _Pragma("unroll") for (int rr = 0; rr < 2; ++rr) mean[rr] = wave_sum_dpp(s[rr]) * (1.f / 1024.f); \
        _Pragma("unroll") for (int rr = 0; rr < 2; ++rr) { float s2 = 0.f; \
            _Pragma("unroll") for (int q = 0; q < 4; ++q) { v[rr][q] = v[rr][q] - mean[rr]; s2 += (v[rr][q].x * v[rr][q].x + v[rr][q].y * v[rr][q].y) + (v[rr][q].z * v[rr][q].z + v[rr][q].w * v[rr][q].w); } \
            rstd[rr] = rsq_fast(wave_sum_dpp(s2) * (1.f / 1024.f) + LN_EPS); } \
        if ((m_) < MROWS) { \
        _Pragma("unroll") for (int q = 0; q < 4; ++q) { \
            _Pragma("unroll") for (int rr = 0; rr < 2; ++rr) { const f32x4 o = v[rr][q] * rstd[rr] * ggv[q] + bbv[q]; \
                if (l == NLAYER - 1) ((GAS f32x4*)(XF + (size_t)((m_) + rr) * 1024))[lane + 64 * q] = o;        \
                else ((GAS u64_t*)(XB + (size_t)((m_) + rr) * 1024))[lane + 64 * q] = (u64_t)pk2(o.x, o.y) | ((u64_t)pk2(o.z, o.w) << 32); } } } } while (0)
    const int step = NGW * 2;
    f32x4 ggv[4], bbv[4];
#pragma unroll
    for (int q = 0; q < 4; ++q) { ggv[q] = g4[64 * q]; bbv[q] = b4[64 * q]; }
    LN_LOAD(hwA, xwA, gw * 2);
#pragma unroll 1
    for (int m0 = gw * 2; m0 < MROWS; m0 += 2 * step) {
        LN_LOAD(hwB, xwB, m0 + step);
        LN_BODY(hwA, xwA, m0);
        LN_LOAD(hwA, xwA, m0 + 2 * step);
        LN_BODY(hwB, xwB, m0 + step);
    }
#undef LN_LOAD
#undef LN_BODY
}
__device__ __forceinline__ void sample_mixer_unit(const Args& a, int l, int mixer, int b, LAS unsigned char* ldsb, int tid) {
    for (int u8 = 0; u8 < 8; ++u8) scan_sample_unit(a, l, mixer * 256 + (b * 4 + (u8 >> 1)) * 2 + (u8 & 1), ldsb, tid);
    typedef unsigned u32x2 __attribute__((ext_vector_type(2)));
    const int lane = tid & 63, wave = tid >> 6, rg = lane >> 4, j = lane & 15, ch = rg * 64 + 4 * j;
    const GAS bf16* P = (const GAS bf16*)(a.ws + WS_PROJ); GAS bf16* OC = (GAS bf16*)(a.ws + WS_OC);
    const GAS float* Om = (const GAS float*)(a.ws + (mixer ? WS_OG : WS_OA)); const GAS float* BON = (const GAS float*)(a.ws + WS_BONUS); const GAS float* RV = (const GAS float*)(a.ws + WS_RARR + 5 * ARR_STRIDE);
    const f32x4 gA = mixer ? *(const GAS f32x4*)((const GAS float*)a.in[26] + l * 64 + 4 * j) : *(const GAS f32x4*)((const GAS float*)a.in[20] + l * 256 + ch);
    const f32x4 gB = mixer ? (f32x4){0.f, 0.f, 0.f, 0.f} : *(const GAS f32x4*)((const GAS float*)a.in[21] + l * 256 + ch);
#pragma unroll
    for (int rr = 0; rr < 2; ++rr) { const size_t m = (size_t)MP + b * STOK + 2 * wave + rr;
        const f32x4 o = *(const GAS f32x4*)(Om + m * 256 + ch); const u32x2 z = *(const GAS u32x2*)(P + m * NPJ + (mixer ? C_CZ : C_AZ) + ch); f32x4 y;
        if (!mixer) { const f32x4 rv = *(const GAS f32x4*)(RV + m * 256 + ch); const float bon = BON[m * 4 + rg];
            const float mean = row16_sum((o.x + o.y) + (o.z + o.w)) * (1.f / 64.f); const f32x4 d = o - mean;
            const float var = row16_sum((d.x * d.x + d.y * d.y) + (d.z * d.z + d.w * d.w)) * (1.f / 64.f); y = d * rsq_fast(var + GN_EPS) * gA + gB + bon * rv; }
        else { const float ms = row16_sum((o.x * o.x + o.y * o.y) + (o.z * o.z + o.w * o.w)) * (1.f / 64.f); y = o * rsq_fast(ms + GDN_EPS) * gA; }
        y.x *= silu_fast(__uint_as_float(z.x << 16)); y.y *= silu_fast(__uint_as_float(z.x & 0xffff0000u)); y.z *= silu_fast(__uint_as_float(z.y << 16)); y.w *= silu_fast(__uint_as_float(z.y & 0xffff0000u));
        u32x2 w; w.x = pk2(y.x, y.y); w.y = pk2(y.z, y.w); *(GAS u32x2*)(OC + m * 1024 + (mixer ? 768 : 0) + ch) = w; }
}
__device__ __forceinline__ void sample_outproj(const Args& a, int l, int w, LAS unsigned char* ldsb, int tid) {
    const int lane = tid & 63, wave = __builtin_amdgcn_readfirstlane(tid >> 6), r = lane & 31, hh = lane >> 5, rb = w >> 4, cb = w & 15;
    const GAS bf16* A = (const GAS bf16*)(a.ws + WS_OC) + (size_t)(MP + 32 * rb + r) * 1024 + 128 * wave + 8 * hh;
    const GAS bf16* B0 = (const GAS bf16*)(a.ws + WS_WOUT) + (size_t)l * 1024 * 1024 + (size_t)(64 * cb + r) * 1024 + 128 * wave + 8 * hh; const GAS bf16* B1 = B0 + (size_t)32 * 1024;
    bf16x8 af[8], b0[8], b1[8];
#pragma unroll
    for (int s_ = 0; s_ < 8; ++s_) { af[s_] = *(const GAS bf16x8*)(A + 16 * s_); b0[s_] = *(const GAS bf16x8*)(B0 + 16 * s_); b1[s_] = *(const GAS bf16x8*)(B1 + 16 * s_); }
    f32x16 c0, c1;
#pragma unroll
    for (int i = 0; i < 16; ++i) { c0[i] = 0.f; c1[i] = 0.f; }
#pragma unroll
    for (int s_ = 0; s_ < 8; ++s_) { c0 = MFMA32(af[s_], b0[s_], c0); c1 = MFMA32(af[s_], b1[s_], c1); }
    LAS float* PS = (LAS float*)ldsb;
#pragma unroll
    for (int i = 0; i < 16; ++i) { PS[((wave * 2 + 0) * 16 + i) * 64 + lane] = c0[i]; PS[((wave * 2 + 1) * 16 + i) * 64 + lane] = c1[i]; }
    __syncthreads();
    GAS bf16* H = (GAS bf16*)(a.ws + WS_H);
#pragma unroll
    for (int q = 0; q < 4; ++q) { const int e = tid + 512 * q, t = e >> 10, i = (e >> 6) & 15, ln = e & 63; float sum = 0.f;
#pragma unroll
        for (int wv = 0; wv < 8; ++wv) sum += PS[((wv * 2 + t) * 16 + i) * 64 + ln];
        const int row = crow16(i, ln >> 5), col = 32 * t + (ln & 31);
        H[(size_t)(MP + 32 * rb + row) * 1024 + 64 * cb + col] = (bf16)f2bf(sum); }
    __syncthreads();
}

#ifndef MK_FUSED
#define MK_FUSED 1
#endif
constexpr int CW_Q = 8192;
constexpr int CW_BAR = 4096;
constexpr int NPHASE = 6;

__global__ void __launch_bounds__(NTHREADS, 2) trunk_fwd(Args a) {
    extern __shared__ __attribute__((aligned(16))) unsigned char lds[];
    LAS unsigned char* ldsb = (LAS unsigned char*)lds;
    const int tid = threadIdx.x; const int wv0 = __builtin_amdgcn_readfirstlane(tid >> 6);
    constexpr int G = 256; const int bx = blockIdx.x; const int vcu = (bx % 8) * (G / 8) + bx / 8;
    volatile LAS unsigned* MISC = (volatile LAS unsigned*)(ldsb + MISC_OFF);
    for (int u = tid; u < 128; u += NTHREADS) ((LAS unsigned*)(ldsb + MISC_OFF))[u] = 0u;
    __syncthreads();
    unsigned* ctl = (unsigned*)(a.ws + WS_CTL);
    XcdBarrier bar; bar.bar = ctl + CW_BAR; bar.x = 0; bar.st = nullptr;
    if (a.fused) bar = xcd_barrier_post(ctl + CW_BAR, MISC + 8);
#define SEAM() do { if (fused) xcd_barrier(bar); } while (0)
#define IN(k) (ph_lo <= (k) && (k) < ph_hi)

    if (a.do_pro) { const int fused = a.fused; phase_prologue(a, ldsb, vcu, G, tid); SEAM(); }

    for (int l = a.l_lo; l < a.l_hi; ++l) {
        int ph_lo = a.ph_lo, ph_hi = a.ph_hi, fused = a.fused; asm volatile("" : "+s"(ph_lo), "+s"(ph_hi), "+s"(fused));
#if defined(__HIP_DEVICE_COMPILE__)
#define LAUNDER_ARGS() const __attribute__((address_space(4))) Args* ap_ = (const __attribute__((address_space(4))) Args*)__builtin_amdgcn_kernarg_segment_ptr(); asm volatile("" : "+s"(ap_)); Args al = *ap_
#else
#define LAUNDER_ARGS() Args al = a
#endif
#define LAUNDER() int wv_ = wv0; unsigned zz_ = 0u; asm volatile("" : "+s"(wv_), "+s"(zz_)); int tid = (wv_ << 6) | (int)__builtin_amdgcn_mbcnt_hi(~0u, __builtin_amdgcn_mbcnt_lo(~0u, zz_)); asm volatile("" : "+v"(tid));     LAUNDER_ARGS(); int bxl = bx; asm volatile("" : "+s"(al.ws), "+s"(al.out), "+s"(bxl)); const int vcul = (bxl % 8) * (G / 8) + bxl / 8; (void)vcul
        if (IN(0)) { LAUNDER(); (void)tid;
            pg8::Gemm g{(const bf16*)(al.ws + WS_XB), (const bf16*)(al.ws + WS_WIN) + (size_t)l * NPJ * 1024, MROWS, NPJ, DMODEL}; pg8::StaticOrder S; S.init(MROWS, NPJ, G, bxl);
            pg8::EpiProj E{(bf16*)(al.ws + WS_PROJ), (bf16*)(al.ws + WS_KV), (float*)(al.ws + WS_SMALL), al.out + O_FKP + (size_t)l * MP * 512, al.out + O_FVP + (size_t)l * MP * 512, al.out + O_FKS + (size_t)l * MS * 512, al.out + O_FVS + (size_t)l * MS * 512};
            pg8::gemm_phase<pg8::EpiProj, pg8::StaticOrder, false, true>(ldsb, g, S, E);
            SEAM();
        }
        if (IN(1)) { LAUNDER(); phase_prep(al, l, ldsb, vcul, G, tid); SEAM(); }
        if (IN(2)) {
            if (bx < 64) { LAUNDER(); chunk_scan_unit(al, l, bxl, ldsb, tid); __syncthreads(); }
            else if (bx < 128) { LAUNDER(); const int k_ = bxl - 64; sample_mixer_unit(al, l, k_ >> 5, k_ & 31, ldsb, tid); }
            { LAUNDER(); (void)tid; const bf16* PJ = (const bf16*)(al.ws + WS_PROJ);
              const bf16* KVb = (const bf16*)(al.ws + WS_KV);
              const attn_body::AttnTensors AT{(const attn_body::bf16*)(PJ + C_Q), (const attn_body::bf16*)(KVb), (const attn_body::bf16*)(KVb + 512), (const attn_body::bf16*)(PJ + C_BZ),
                                             (const float*)(al.ws + WS_CB), (attn_body::bf16*)((bf16*)(al.ws + WS_OC) + 256)};
              phase2_queue(al, l, AT, ldsb, ctl + CW_Q + 64 * l, MISC + 16); }
            SEAM();
        }
        if (IN(4)) { LAUNDER(); (void)tid;
            pg8::Gemm g{(const bf16*)(al.ws + WS_OC), (const bf16*)(al.ws + WS_WOUT) + (size_t)l * 1024 * 1024, MP, DMODEL, DMODEL}; pg8::StaticOrder S; S.init(MP, DMODEL, G, bxl);
            pg8::EpiH E{(bf16*)(al.ws + WS_H), DMODEL};
            pg8::gemm_phase<pg8::EpiH, pg8::StaticOrder, true, true>(ldsb, g, S, E);
            sample_outproj(al, l, bxl, ldsb, tid);
            SEAM();
        }
        if (IN(5)) { LAUNDER(); phase_ln(al, l, vcul, G, tid); if (l + 1 < a.l_hi || !IN(5)) SEAM(); }
    }
#undef SEAM
#undef IN
}

extern "C" void kernel_launch(void* const* d_in, const int* in_sizes, int n_in, void* d_out, int out_size, void* d_ws, size_t ws_size, hipStream_t stream) {
    static int grid = 0;
    if (grid == 0) {
        if (n_in != 30 || (size_t)out_size != O_END || ws_size < WS_END2) { fprintf(stderr, "kernel_launch: unexpected sizes: n_in %d out %d ws %zu (need %zu); nothing launched\n", n_in, out_size, ws_size, (size_t)WS_END2); grid = -1; return; }
        int dev = 0, cus = 0, per_cu = 0;
        if (hipGetDevice(&dev) != hipSuccess || hipDeviceGetAttribute(&cus, hipDeviceAttributeMultiprocessorCount, dev) != hipSuccess) { fprintf(stderr, "kernel_launch: device query failed\n"); grid = -1; return; }
        if (hipFuncSetAttribute((const void*)trunk_fwd, hipFuncAttributeMaxDynamicSharedMemorySize, LDS_BYTES) != hipSuccess) { fprintf(stderr, "kernel_launch: hipFuncSetAttribute failed\n"); grid = -1; return; }
        if (hipOccupancyMaxActiveBlocksPerMultiprocessor(&per_cu, (const void*)trunk_fwd, NTHREADS, LDS_BYTES) != hipSuccess || per_cu < 1) fprintf(stderr, "kernel_launch: note: occupancy query reports %d workgroups per CU\n", per_cu);
        (void)hipGetLastError();
        if (cus < 256) { fprintf(stderr, "kernel_launch: %d CUs; this kernel needs 256 resident workgroups\n", cus); grid = -1; return; }
        grid = 256;
    }
    if (grid < 0) return;
    (void)in_sizes;
    if (hipMemsetAsync((char*)d_ws + WS_CTL, 0, CTL_ZERO_BYTES, stream) != hipSuccess) { fprintf(stderr, "kernel_launch: memset failed\n"); return; }
    Args a{};
    for (int i = 0; i < 30; ++i) a.in[i] = (const float*)d_in[i];
    a.out = (float*)d_out; a.ws = (unsigned char*)d_ws;
#if MK_FUSED
    a.do_pro = 1; a.fused = 1; a.l_lo = 0; a.l_hi = NLAYER; a.ph_lo = 0; a.ph_hi = NPHASE;
    hipLaunchKernelGGL(trunk_fwd, dim3(grid), dim3(NTHREADS), LDS_BYTES, stream, a);
#else
    a.fused = 0; a.do_pro = 1; a.l_lo = 0; a.l_hi = 0; a.ph_lo = 0; a.ph_hi = 0;
    hipLaunchKernelGGL(trunk_fwd, dim3(grid), dim3(NTHREADS), LDS_BYTES, stream, a);
    a.do_pro = 0;
    for (int l = 0; l < NLAYER; ++l) for (int ph = 0; ph < NPHASE; ++ph) { a.l_lo = l; a.l_hi = l + 1; a.ph_lo = ph; a.ph_hi = ph + 1;
        hipLaunchKernelGGL(trunk_fwd, dim3(grid), dim3(NTHREADS), LDS_BYTES, stream, a); }
#endif
    const hipError_t le = hipPeekAtLastError();
    if (le != hipSuccess) fprintf(stderr, "kernel_launch: launch failed: %s\n", hipGetErrorName(le));
}
```

```cpp
#include <hip/hip_runtime.h>
#include <hip/hip_bf16.h>
#include <cstdio>
#include <cstdint>
#include <cmath>

constexpr int DMODEL = 1024, NB = 8, TSEQ = 4096, NLAYER = 4, SBATCH = 32, STOK = 16, PAST = 2048;
constexpr int MP = NB * TSEQ, MS = SBATCH * STOK, MROWS = MP + MS;
constexpr int NIN = 4240, NPJ = 4352;
constexpr int C_ASH = 0, C_AZ = 896, C_Q = 1152, C_K = 1664, C_V = 2176, C_BZ = 2688, C_CQKV = 3200, C_CZ = 3968, C_SM = 4224;
constexpr int NSHIFT = 896, NCONV = 768;
constexpr float LOG2E = 1.4426950408889634f;
constexpr float QSCALE = 0.125f * LOG2E;
constexpr float ALPHA = 1.681792830507429f;
constexpr float LN_EPS = 1e-5f, GN_EPS = 64e-5f, GDN_EPS = 1e-6f, L2_EPS = 1e-6f;

constexpr size_t O_YP = 0, O_YS = O_YP + (size_t)MP * DMODEL;
constexpr size_t O_FKP = O_YS + (size_t)MS * DMODEL, O_FVP = O_FKP + (size_t)NLAYER * MP * 512, O_FLP = O_FVP + (size_t)NLAYER * MP * 512;
constexpr size_t O_SHP = O_FLP + (size_t)NLAYER * MP * 8, O_RWP = O_SHP + (size_t)NLAYER * NB * NSHIFT, O_CVP = O_RWP + (size_t)NLAYER * NB * 4 * 4096;
constexpr size_t O_GDP = O_CVP + (size_t)NLAYER * NB * 3 * NCONV;
constexpr size_t O_FKS = O_GDP + (size_t)NLAYER * NB * 4 * 4096, O_FVS = O_FKS + (size_t)NLAYER * MS * 512, O_FLS = O_FVS + (size_t)NLAYER * MS * 512;
constexpr size_t O_SHS = O_FLS + (size_t)NLAYER * MS * 8, O_RWS = O_SHS + (size_t)NLAYER * SBATCH * NSHIFT, O_CVS = O_RWS + (size_t)NLAYER * SBATCH * 4 * 4096;
constexpr size_t O_GDS = O_CVS + (size_t)NLAYER * SBATCH * 3 * NCONV, O_END = O_GDS + (size_t)NLAYER * SBATCH * 4 * 4096;
static_assert(O_END == 177213440ull, "output size");

constexpr size_t MiB = 1u << 20;
constexpr size_t WS_CTL = 0, CTL_ZERO_BYTES = 1 * MiB;
constexpr size_t WS_WIN = 1 * MiB;
constexpr size_t WS_WOUT = 36 * MiB;
constexpr size_t WS_XB = 44 * MiB;
constexpr size_t WS_PROJ = 112 * MiB;
constexpr size_t WS_SMALL = 392 * MiB;
constexpr size_t WS_OC = 396 * MiB;
constexpr size_t WS_H = 464 * MiB;
constexpr size_t WS_CB = 596 * MiB;
constexpr size_t WS_CBS = 597 * MiB;
constexpr size_t WS_BONUS = 600 * MiB;
constexpr size_t WS_OA = 602 * MiB;
constexpr size_t WS_OG = 636 * MiB;
constexpr size_t WS_RARR = 672 * MiB, ARR_STRIDE = 33 * MiB;
constexpr size_t WS_GARR = 870 * MiB;
constexpr size_t WS_END = 1068 * MiB;
static_assert(WS_WIN + (size_t)NLAYER * NPJ * DMODEL * 2 <= WS_WOUT && WS_XB + (size_t)MROWS * DMODEL * 2 <= WS_PROJ && WS_PROJ + (size_t)MROWS * NPJ * 2 <= WS_SMALL, "ws map 1");
static_assert(WS_OC + (size_t)MROWS * DMODEL * 2 <= WS_H && WS_H + (size_t)MROWS * DMODEL * 4 <= WS_CB && WS_CBS + (size_t)256 * 2064 * 4 <= WS_BONUS && WS_OA + (size_t)MROWS * 256 * 4 <= WS_OG && WS_OG + (size_t)MROWS * 256 * 4 <= WS_RARR, "ws map 2");
static_assert((size_t)MROWS * 256 * 4 <= ARR_STRIDE, "ws map 3");

namespace pg8 {
#define PG8_LAS __attribute__((address_space(3)))
#define PG8_GAS __attribute__((address_space(1)))
typedef unsigned short bf16_t;
typedef short bf16x8 __attribute__((ext_vector_type(8)));
typedef float f32x4 __attribute__((ext_vector_type(4)));
typedef unsigned u32x4 __attribute__((ext_vector_type(4)));
constexpr int BM = 256, BK = 64, HALF = 128, HTB = HALF * BK * 2  , STAGE_BYTES = 8 * HTB, NXCD = 8, WGM = 8;

__host__ __device__ __forceinline__ int lds_byte(int r, int c) { const int st = (r >> 4) * 2 + (c >> 5), rr = r & 15, cc = c & 31, ob = rr * 64 + cc * 2; return st * 1024 + (ob ^ (((ob >> 9) & 1) << 5)); }
__host__ __device__ __forceinline__ void stage_rc(int b, int& R, int& C) { const int st = b / 1024, sb = b % 1024, swz = sb ^ (((sb >> 9) & 1) << 5); R = (st >> 1) * 16 + swz / 64; C = (st & 1) * 32 + (swz % 64) / 2; }
__host__ __device__ __forceinline__ int perm32(int rho) { const int n = rho >> 4, i = rho & 15; return 8 * (i >> 2) + 4 * n + (i & 3); }

struct Unit { int pm, pn; };
struct Gemm { const bf16_t* A; const bf16_t* Bt; int M, N, K; };

struct StaticOrder {
    int nM, nN, nwg, G, c;
    __host__ __device__ void init(int M, int N, int G_, int c_) { nM = M / BM; nN = N / BM; nwg = nM * nN; G = G_; c = c_; }
    __host__ __device__ bool next(int i, Unit& u) const {
        const long L = (long)i * G + c; if (L >= nwg) return false;
        int wgid = (int)L; { const int q = nwg / NXCD, r = nwg % NXCD, xcd = wgid % NXCD, off = wgid / NXCD; wgid = (xcd < r ? xcd * (q + 1) : r * (q + 1) + (xcd - r) * q) + off; }
        const int nig = WGM * nN, gid = wgid / nig, fm = gid * WGM, gsz = (nM - fm) < WGM ? (nM - fm) : WGM;
        u.pm = fm + ((wgid % nig) % gsz); u.pn = (wgid % nig) / gsz; return true;
    }
    __device__ __forceinline__ void a_ready(const Unit&) const {}
    __device__ __forceinline__ void done(const Unit&) const {}
};

__device__ __forceinline__ unsigned cvt_pk_bf16(float lo, float hi) { unsigned r; asm volatile("v_cvt_pk_bf16_f32 %0, %1, %2" : "=v"(r) : "v"(lo), "v"(hi)); return r; }
struct EpiProj {
    static constexpr bool PERM = true, AFTER_DRAIN = false;
    bf16_t* P; bf16_t* KV; float* small; float* kp; float* vp; float* ks; float* vs;
    __device__ __forceinline__ void operator()(const f32x4 (&acc)[2][2][4][2], const Unit& u, int wr, int wc, int fr, int fq) const {
        const int row0 = u.pm * BM + wr * 64 + fr, col0 = u.pn * BM + wc * 32 + 8 * fq;
        const bool prow = (u.pm * BM) < MP;
#pragma unroll
        for (int ai = 0; ai < 2; ++ai)
#pragma unroll
            for (int m = 0; m < 4; ++m) { const int row = row0 + ai * HALF + m * 16;
#pragma unroll
                for (int bj = 0; bj < 2; ++bj) { const int col = col0 + bj * HALF, cb = 2 * u.pn + bj;
                    f32x4 v0 = acc[ai][bj][m][0], v1 = acc[ai][bj][m][1];
                    if (cb >= 13 && cb < 21) {
                        float* dst;
                        if (cb < 17) dst = (prow ? kp + (size_t)row * 512 : ks + (size_t)(row - MP) * 512) + (col - C_K);
                        else         dst = (prow ? vp + (size_t)row * 512 : vs + (size_t)(row - MP) * 512) + (col - C_V);
                        __builtin_nontemporal_store(v0, (PG8_GAS f32x4*)dst); __builtin_nontemporal_store(v1, (PG8_GAS f32x4*)(dst + 4));
                    }
                    if (cb == 33 && col < C_SM + 16) { float* dst = small + (size_t)row * 16 + (col - C_SM); *(PG8_GAS f32x4*)dst = v0; *(PG8_GAS f32x4*)(dst + 4) = v1; }
                    if (cb >= 9 && cb < 13) { v0 = v0 * QSCALE; v1 = v1 * QSCALE; }
                    u32x4 w; w.x = cvt_pk_bf16(v0[0], v0[1]); w.y = cvt_pk_bf16(v0[2], v0[3]); w.z = cvt_pk_bf16(v1[0], v1[1]); w.w = cvt_pk_bf16(v1[2], v1[3]);
                    if (cb >= 13 && cb < 21) { const int ck = col - C_K, hk = (ck >> 6) & 7, dk = ck & 63;
                        bf16_t* tb = KV + ((size_t)(row >> 6) * 8 + hk) * 8192 + (ck < 512 ? (dk >> 3) * 512 + (row & 63) * 8 : 4096 + (dk >> 5) * 2048 + (row & 63) * 32 + (dk & 31));
                        *(PG8_GAS u32x4*)tb = w; }
                    else *(PG8_GAS u32x4*)(P + (size_t)row * NPJ + col) = w; } }
    }
};
struct EpiH {
    static constexpr bool PERM = true, AFTER_DRAIN = false;
    bf16_t* H; int ldc;
    __device__ __forceinline__ void operator()(const f32x4 (&acc)[2][2][4][2], const Unit& u, int wr, int wc, int fr, int fq) const {
        const int row0 = u.pm * BM + wr * 64 + fr, col0 = u.pn * BM + wc * 32 + 8 * fq;
#pragma unroll
        for (int ai = 0; ai < 2; ++ai)
#pragma unroll
            for (int m = 0; m < 4; ++m) { bf16_t* rowp = H + (size_t)(row0 + ai * HALF + m * 16) * ldc + col0;
#pragma unroll
                for (int bj = 0; bj < 2; ++bj) { const f32x4 v0 = acc[ai][bj][m][0], v1 = acc[ai][bj][m][1];
                    u32x4 w; w.x = cvt_pk_bf16(v0[0], v0[1]); w.y = cvt_pk_bf16(v0[2], v0[3]); w.z = cvt_pk_bf16(v1[0], v1[1]); w.w = cvt_pk_bf16(v1[2], v1[3]);
                    *(PG8_GAS u32x4*)(rowp + bj * HALF) = w; } }
    }
};

template <class Epi, class Sched, bool ALIGN_EPI = false, bool SP2 = false>
__device__ __forceinline__ void gemm_phase(PG8_LAS unsigned char* lds, const Gemm g, const Sched& S, const Epi& E) {
    int tid_l = threadIdx.x; asm volatile("" : "+v"(tid_l));
    const int tid = tid_l, wid = __builtin_amdgcn_readfirstlane(tid >> 6), lane = tid & 63, wr = wid >> 2, wc = wid & 3, fr = lane & 15, fq = lane >> 4;
    const int K = g.K, nt = K / BK;
    unsigned voffA[2], voffB[2];
#pragma unroll
    for (int i = 0; i < 2; ++i) { int R, C; stage_rc(tid * 16 + i * 8192, R, C); const int Rb = Epi::PERM ? ((R & ~31) + perm32(R & 31)) : R;
        voffA[i] = (unsigned)(R * K + C) * 2u; voffB[i] = (unsigned)(Rb * K + C) * 2u; }
    const size_t kstep = (size_t)(BK * 2);
    const size_t hstep = (size_t)HALF * K * 2;
    const size_t tstep = 2 * hstep;
    const unsigned ldsw = (unsigned)wid * 1024u;
    const int aoff = lds_byte(wr * 64 + fr, fq * 8), boff = lds_byte(wc * 32 + fr, fq * 8);
#define PG8_SA(b, h) (((b) * 2 + (h)) * HTB)
#define PG8_SB(b, h) ((4 + (b) * 2 + (h)) * HTB)
#define PG8_STAGE(bufoff, gbase, voff) do { _Pragma("unroll") for (int _i = 0; _i < 2; ++_i) \
        __builtin_amdgcn_global_load_lds((const unsigned*)((const char*)(gbase) + (voff)[_i]), (PG8_LAS unsigned*)(lds + (bufoff) + ldsw + _i * 8192), 16, 0, 0); } while (0)
#define PG8_LDA(dst, b, h) do { _Pragma("unroll") for (int m = 0; m < 4; ++m) _Pragma("unroll") for (int k = 0; k < 2; ++k) dst[m][k] = *(const PG8_LAS bf16x8*)(lds + PG8_SA(b, h) + aoff + m * 2048 + k * 1024); } while (0)
#define PG8_LDB(dst, b, h) do { _Pragma("unroll") for (int n = 0; n < 2; ++n) _Pragma("unroll") for (int k = 0; k < 2; ++k) dst[n][k] = *(const PG8_LAS bf16x8*)(lds + PG8_SB(b, h) + boff + n * 2048 + k * 1024); } while (0)
#define PG8_MMA(ai, bj, At, Bt) do { __builtin_amdgcn_s_setprio(1); _Pragma("unroll") for (int m = 0; m < 4; ++m) _Pragma("unroll") for (int n = 0; n < 2; ++n) _Pragma("unroll") for (int k = 0; k < 2; ++k) \
        acc[ai][bj][m][n] = __builtin_amdgcn_mfma_f32_16x16x32_bf16(Bt[n][k], At[m][k], acc[ai][bj][m][n], 0, 0, 0); __builtin_amdgcn_s_setprio(0); } while (0)
#define PG8_WAIT_V(n) asm volatile("s_waitcnt vmcnt(" #n ")" ::: "memory")
#define PG8_WAIT_L(n) asm volatile("s_waitcnt lgkmcnt(" #n ")" ::: "memory")
#define PG8_BAR __builtin_amdgcn_s_barrier()
#define PG8_SCHED __builtin_amdgcn_sched_barrier(0)
    Unit cur, nxt; int ui = 0;
    if (!S.next(0, cur)) return;
    f32x4 acc[2][2][4][2];
#pragma unroll
    for (int a = 0; a < 2; ++a)
#pragma unroll
        for (int b = 0; b < 2; ++b)
#pragma unroll
            for (int m = 0; m < 4; ++m)
#pragma unroll
                for (int n = 0; n < 2; ++n) acc[a][b][m][n] = (f32x4){0.f, 0.f, 0.f, 0.f};
    bf16x8 At[4][2], B0[2][2], B1[2][2];
    const char* cA = (const char*)g.A + (size_t)cur.pm * tstep; const char* cB = (const char*)g.Bt + (size_t)cur.pn * tstep;
    S.a_ready(cur);
    if constexpr (SP2) {
        PG8_STAGE(PG8_SB(0, 0), cB, voffB); PG8_STAGE(PG8_SB(0, 1), cB + hstep, voffB); PG8_STAGE(PG8_SA(0, 0), cA, voffA); PG8_STAGE(PG8_SA(0, 1), cA + hstep, voffA);
        if (wr == 1) PG8_BAR;
        PG8_WAIT_V(2); PG8_BAR;
        PG8_STAGE(PG8_SB(1, 0), cB + kstep, voffB); PG8_STAGE(PG8_SA(1, 0), cA + kstep, voffA); PG8_STAGE(PG8_SB(1, 1), cB + hstep + kstep, voffB);
        PG8_WAIT_V(6); PG8_BAR;
    } else {
        PG8_STAGE(PG8_SB(0, 0), cB, voffB); PG8_STAGE(PG8_SA(0, 0), cA, voffA); PG8_STAGE(PG8_SB(0, 1), cB + hstep, voffB); PG8_STAGE(PG8_SA(0, 1), cA + hstep, voffA);
        if (wr == 1) PG8_BAR;
        PG8_WAIT_V(4); PG8_BAR;
        PG8_STAGE(PG8_SB(1, 0), cB + kstep, voffB); PG8_STAGE(PG8_SA(1, 0), cA + kstep, voffA); PG8_STAGE(PG8_SB(1, 1), cB + hstep + kstep, voffB);
        PG8_WAIT_V(6); PG8_BAR;
    }
    for (;;) {
        const bool has_next = S.next(ui + 1, nxt);
        const char* nA = has_next ? (const char*)g.A + (size_t)nxt.pm * tstep : cA; const char* nB = has_next ? (const char*)g.Bt + (size_t)nxt.pn * tstep : cB;
        for (int t = 0; t < nt; t += 2) {
            const bool last = (t == nt - 2);
            const char* a1 = cA + (size_t)(t + 1) * kstep;
            const char* a2 = last ? nA : cA + (size_t)(t + 2) * kstep; const char* b2 = last ? nB : cB + (size_t)(t + 2) * kstep;
            const char* a3 = a2 + kstep; const char* b3 = b2 + kstep;
            if (last && has_next) S.a_ready(nxt);
            if constexpr (SP2) {
            PG8_LDB(B0, 0, 0); PG8_LDB(B1, 0, 1); PG8_SCHED; PG8_LDA(At, 0, 0); PG8_STAGE(PG8_SA(1, 1), a1 + hstep, voffA);
            PG8_WAIT_V(8); PG8_WAIT_L(0); PG8_BAR; PG8_MMA(0, 0, At, B0); PG8_MMA(0, 1, At, B1); PG8_BAR; PG8_SCHED;
            PG8_LDA(At, 0, 1); PG8_STAGE(PG8_SB(0, 0), b2, voffB); PG8_STAGE(PG8_SB(0, 1), b2 + hstep, voffB); PG8_STAGE(PG8_SA(0, 0), a2, voffA);
            PG8_WAIT_V(8); PG8_WAIT_L(0); PG8_BAR; PG8_MMA(1, 0, At, B0); PG8_MMA(1, 1, At, B1); PG8_BAR; PG8_SCHED;
            PG8_LDB(B0, 1, 0); PG8_LDB(B1, 1, 1); PG8_SCHED; PG8_LDA(At, 1, 0); PG8_STAGE(PG8_SA(0, 1), a2 + hstep, voffA);
            PG8_WAIT_V(8); PG8_WAIT_L(0); PG8_BAR; PG8_MMA(0, 0, At, B0); PG8_MMA(0, 1, At, B1); PG8_BAR; PG8_SCHED;
            PG8_LDA(At, 1, 1); PG8_STAGE(PG8_SB(1, 0), b3, voffB); PG8_STAGE(PG8_SB(1, 1), b3 + hstep, voffB); PG8_STAGE(PG8_SA(1, 0), a3, voffA);
            PG8_WAIT_V(8); PG8_WAIT_L(0); PG8_BAR; PG8_MMA(1, 0, At, B0); PG8_MMA(1, 1, At, B1); PG8_BAR; PG8_SCHED;
            } else {
            PG8_LDB(B0, 0, 0); PG8_SCHED; PG8_LDA(At, 0, 0); PG8_STAGE(PG8_SA(1, 1), a1 + hstep, voffA);
            PG8_WAIT_L(8); PG8_BAR; PG8_WAIT_L(0); PG8_MMA(0, 0, At, B0); PG8_BAR; PG8_SCHED;
            PG8_LDB(B1, 0, 1); PG8_STAGE(PG8_SB(0, 0), b2, voffB);
            PG8_BAR; PG8_WAIT_L(0); PG8_MMA(0, 1, At, B1); PG8_BAR;
            PG8_LDA(At, 0, 1); PG8_STAGE(PG8_SA(0, 0), a2, voffA);
            PG8_BAR; PG8_WAIT_L(0); PG8_MMA(1, 0, At, B0); PG8_BAR; PG8_SCHED;
            PG8_STAGE(PG8_SB(0, 1), b2 + hstep, voffB);
            PG8_WAIT_V(6); PG8_BAR; PG8_MMA(1, 1, At, B1); PG8_BAR;
            PG8_LDB(B0, 1, 0); PG8_SCHED; PG8_LDA(At, 1, 0); PG8_STAGE(PG8_SA(0, 1), a2 + hstep, voffA);
            PG8_WAIT_L(8); PG8_BAR; PG8_WAIT_L(0); PG8_MMA(0, 0, At, B0); PG8_BAR; PG8_SCHED;
            PG8_LDB(B1, 1, 1); PG8_STAGE(PG8_SB(1, 0), b3, voffB);
            PG8_BAR; PG8_WAIT_L(0); PG8_MMA(0, 1, At, B1); PG8_BAR;
            PG8_LDA(At, 1, 1); PG8_STAGE(PG8_SA(1, 0), a3, voffA);
            PG8_BAR; PG8_WAIT_L(0); PG8_MMA(1, 0, At, B0); PG8_BAR; PG8_SCHED;
            PG8_STAGE(PG8_SB(1, 1), b3 + hstep, voffB);
            PG8_WAIT_V(6); PG8_BAR; PG8_MMA(1, 1, At, B1); PG8_BAR;
            }
        }
        if constexpr (ALIGN_EPI) { if (wr == 0) PG8_BAR; }
        if constexpr (!Epi::AFTER_DRAIN) { E(acc, cur, wr, wc, fr, fq); S.done(cur); }
        if (!has_next) break;
#pragma unroll
        for (int a = 0; a < 2; ++a)
#pragma unroll
            for (int b = 0; b < 2; ++b)
#pragma unroll
                for (int m = 0; m < 4; ++m)
#pragma unroll
                    for (int n = 0; n < 2; ++n) acc[a][b][m][n] = (f32x4){0.f, 0.f, 0.f, 0.f};
        cur = nxt; cA = nA; cB = nB; ++ui;
        if constexpr (ALIGN_EPI) { if (wr == 1) PG8_BAR; }
    }
    PG8_WAIT_V(0);
    if constexpr (!ALIGN_EPI) { if (wr == 0) PG8_BAR; }
    PG8_BAR;
    if constexpr (Epi::AFTER_DRAIN) { E.fused(acc, cur, wr, wc, fr, fq, lds, wid, lane); S.done(cur); }
#undef PG8_SA
#undef PG8_SB
#undef PG8_STAGE
#undef PG8_LDA
#undef PG8_LDB
#undef PG8_MMA
#undef PG8_WAIT_V
#undef PG8_WAIT_L
#undef PG8_BAR
#undef PG8_SCHED
}
}
#include <hip/hip_bf16.h>
#include <cmath>
namespace attn_body {
using bf16=__hip_bfloat16;
using bf16x8=__attribute__((ext_vector_type(8)))short;
using s16x4=__attribute__((ext_vector_type(4)))short;
using f32x16=__attribute__((ext_vector_type(16)))float;
using u32x4=__attribute__((ext_vector_type(4)))unsigned;
constexpr int BATCH=8,NHEAD=8,SEQ=4096,D=64,DM=4352,KDM=1024,OPITCH=1024;
constexpr int NW=8,QBLK=32,QB=QBLK*NW,KVBLK=64,NQB=SEQ/QB;
constexpr int ATTN_PITCH=DM, ATTN_UNIT_ROWS=QB;
__device__ __forceinline__ int crow(int r,int hi){return (r&3)+8*(r>>2)+4*hi;}
#define SBAR() __builtin_amdgcn_sched_barrier(0)
__device__ __forceinline__ void cmask(f32x16&p0,f32x16&p1,int jb,int qrel,int hi){
  const float NEG=-INFINITY; int kb=64*jb+4*hi;
  #pragma unroll
  for(int r=0;r<16;++r){int kv=kb+(r&3)+8*(r>>2); if(kv>qrel)p0[r]=NEG; if(kv+32>qrel)p1[r]=NEG;}
}

constexpr int NSLOT=3, SLOTB=8192;
constexpr int LDS_K=0, LDS_V=NSLOT*SLOTB, LDS_WS=2*NSLOT*SLOTB, LDS_OST=LDS_WS+NW*64*4, LDS_BIAS=LDS_OST+NW*4096, LDS_BYTES=LDS_BIAS+SEQ*8+512;
constexpr int ATTN_DUMP=163072+256;
constexpr float C2=0.125f*1.4426950408889634f;
__device__ __forceinline__ void glds16(const void*gsrc,unsigned lds_dst){unsigned keep;
  asm volatile("s_mov_b32 %0, m0\n\ts_mov_b32 m0, %2\n\ts_nop 0\n\tglobal_load_lds_dwordx4 %1, off\n\ts_mov_b32 m0, %0":"=&s"(keep):"v"(gsrc),"s"(lds_dst):"memory");}
__device__ __forceinline__ float max3f(float a,float b,float c){float r;asm("v_max3_f32 %0, %1, %2, %3":"=v"(r):"v"(a),"v"(b),"v"(c));return r;}
__device__ __forceinline__ float max2f(float a,float b){float r;asm("v_max_f32_e32 %0, %1, %2":"=v"(r):"v"(a),"v"(b));return r;}
__device__ __forceinline__ float fadd_s(float a,float b){float r;asm("v_add_f32_e32 %0, %1, %2":"=v"(r):"v"(a),"v"(b));return r;}
__device__ __forceinline__ float fsub_s(float a,float b){float r;asm("v_sub_f32_e32 %0, %1, %2":"=v"(r):"v"(a),"v"(b));return r;}
typedef float f32x2_t __attribute__((ext_vector_type(2))); typedef float f32x4_t __attribute__((ext_vector_type(4))); typedef __bf16 bf16x2_t __attribute__((ext_vector_type(2)));
__device__ __forceinline__ unsigned cvtpk_s(float lo,float hi){f32x2_t v={lo,hi};bf16x2_t b=__builtin_convertvector(v,bf16x2_t);return __builtin_bit_cast(unsigned,b);}
#define WAIT_BAR(N) asm volatile("s_waitcnt vmcnt(" #N ") lgkmcnt(0)\n\ts_barrier":::"memory")
typedef unsigned u32x2_t __attribute__((ext_vector_type(2)));
__device__ __forceinline__ u32x2_t split3(float x){ const unsigned h1=cvtpk_s(x,0.f)&0xffffu; const float r1=x-__uint_as_float(h1<<16); const unsigned h2=cvtpk_s(r1,0.f)&0xffffu; const float r2=r1-__uint_as_float(h2<<16);
  const unsigned h3=cvtpk_s(r2,0.f)&0xffffu; return (u32x2_t){h1|(h2<<16),h3}; }

__device__ __forceinline__ void qkt(f32x16&p0,f32x16&p1,const char*Kslot,const bf16x8*qr,const f32x16&ci0,const f32x16&ci1,int r32,int hi){
  const char*kb=Kslot+hi*1024+r32*16;
  #pragma unroll
  for(int d0=0;d0<4;++d0){
    const bf16x8 b0=*reinterpret_cast<const bf16x8*>(kb+d0*2048);
    const bf16x8 b1=*reinterpret_cast<const bf16x8*>(kb+d0*2048+512);
    if(d0==0){p0=__builtin_amdgcn_mfma_f32_32x32x16_bf16(b0,qr[0],ci0,0,0,0);p1=__builtin_amdgcn_mfma_f32_32x32x16_bf16(b1,qr[0],ci1,0,0,0);}
    else{p0=__builtin_amdgcn_mfma_f32_32x32x16_bf16(b0,qr[d0],p0,0,0,0);p1=__builtin_amdgcn_mfma_f32_32x32x16_bf16(b1,qr[d0],p1,0,0,0);}}
}
typedef __attribute__((address_space(3))) const char* lds_cptr;
typedef short v4i16_t __attribute__((ext_vector_type(4)));
__device__ __forceinline__ void kload8(bf16x8*kf,lds_cptr kp){
  kf[0]=*(const __attribute__((address_space(3))) bf16x8*)(kp);      kf[1]=*(const __attribute__((address_space(3))) bf16x8*)(kp+512);
  kf[2]=*(const __attribute__((address_space(3))) bf16x8*)(kp+2048); kf[3]=*(const __attribute__((address_space(3))) bf16x8*)(kp+2560);
  kf[4]=*(const __attribute__((address_space(3))) bf16x8*)(kp+4096); kf[5]=*(const __attribute__((address_space(3))) bf16x8*)(kp+4608);
  kf[6]=*(const __attribute__((address_space(3))) bf16x8*)(kp+6144); kf[7]=*(const __attribute__((address_space(3))) bf16x8*)(kp+6656);
}
__device__ __forceinline__ void kload2(bf16x8*kf,lds_cptr kp,int j){ kf[2*j]=*(const __attribute__((address_space(3))) bf16x8*)(kp+j*2048); kf[2*j+1]=*(const __attribute__((address_space(3))) bf16x8*)(kp+j*2048+512); }
__device__ __forceinline__ s16x4 vtr(lds_cptr p){ return __builtin_bit_cast(s16x4,__builtin_amdgcn_ds_read_tr16_b64_v4i16((__attribute__((address_space(3))) v4i16_t*)p)); }
__device__ __forceinline__ float rowmax(const f32x16&p0,const f32x16&p1){
  float a=max3f(p0[0],p0[1],p1[0]),b=max3f(p0[2],p0[3],p1[1]);a=max3f(a,p1[2],p1[3]);
  #pragma unroll
  for(int r=4;r<16;r+=4){a=max3f(a,p0[r],p0[r+1]);b=max3f(b,p0[r+2],p0[r+3]);a=max3f(a,p1[r],p1[r+1]);b=max3f(b,p1[r+2],p1[r+3]);}
  const float m=max2f(a,b);
  auto rr=__builtin_amdgcn_permlane32_swap(__float_as_uint(m),__float_as_uint(m),false,false);
  return max2f(__uint_as_float(rr[0]),__uint_as_float(rr[1]));
}
__device__ __forceinline__ void pv(f32x16*o,int vb,bf16x8 pa0,bf16x8 pa1,bf16x8 pa2,bf16x8 pa3){
  #pragma unroll
  for(int d0=0;d0<2;++d0){s16x4 lo[4],hi[4];
    #pragma unroll
    for(int ks=0;ks<4;++ks){
      asm volatile("ds_read_b64_tr_b16 %0,%1 offset:%c2":"=&v"(lo[ks]):"v"(vb),"i"(d0*4096+ks*1024):"memory");
      asm volatile("ds_read_b64_tr_b16 %0,%1 offset:%c2":"=&v"(hi[ks]):"v"(vb),"i"(d0*4096+ks*1024+512):"memory");}
    asm volatile("s_waitcnt lgkmcnt(0)":::"memory");SBAR();
    #define PK(k) (bf16x8){lo[k][0],lo[k][1],lo[k][2],lo[k][3],hi[k][0],hi[k][1],hi[k][2],hi[k][3]}
    o[d0]=__builtin_amdgcn_mfma_f32_32x32x16_bf16(pa0,PK(0),o[d0],0,0,0);
    o[d0]=__builtin_amdgcn_mfma_f32_32x32x16_bf16(pa1,PK(1),o[d0],0,0,0);
    o[d0]=__builtin_amdgcn_mfma_f32_32x32x16_bf16(pa2,PK(2),o[d0],0,0,0);
    o[d0]=__builtin_amdgcn_mfma_f32_32x32x16_bf16(pa3,PK(3),o[d0],0,0,0);
    #undef PK
  }
}

#ifndef ATTN_STORE16
#define ATTN_STORE16(p,v) (*(__attribute__((address_space(1))) u32x4*)(p)=(v))
#endif
template<int THRL> __device__ __forceinline__ void attn_unit(int b,int h,int qb,const bf16*Q,const bf16*__restrict__ K,const bf16*__restrict__ V,const bf16*__restrict__ Z,const float*__restrict__ CBG,bf16*O,char*shm){
  int tid_l=threadIdx.x; asm volatile("":"+v"(tid_l));
  const int tid=tid_l,lane=tid&63,r32=lane&31,hi=lane>>5; const int wid=__builtin_amdgcn_readfirstlane(tid>>6);
  const long rowbase=(long)b*SEQ; const int q0=qb*QB;
  const bf16*Qw=Q+(rowbase+q0+wid*QBLK)*DM+h*D;
  const bf16*Kh=K+((rowbase>>6)*NHEAD+h)*8192;
  (void)V;
  const unsigned lds0=(unsigned)(uintptr_t)shm;
  float*wsf=(float*)(shm+LDS_WS)+wid*64;
  const bf16*ksrc=Kh+wid*512+lane*8;
  const bf16*vsrc=Kh+4096+(wid>>2)*2048+(16*(wid&3))*32+lane*8;
  const unsigned kdst=lds0+LDS_K+wid*1024, vdst=lds0+LDS_V+wid*1024;
  #define DMA_K(t,slot) glds16(ksrc+(long)(t)*(NHEAD*8192),(unsigned)__builtin_amdgcn_readfirstlane(kdst+(slot)))
  #define DMA_V(t,slot) glds16(vsrc+(long)(t)*(NHEAD*8192),(unsigned)__builtin_amdgcn_readfirstlane(vdst+(slot)))
  const int vb0=(int)(lds0+LDS_V)+((lane>>4)&1)*32+(lane&3)*8+(4*hi+((lane&15)>>2))*64;
  const char*Kbase=shm+LDS_K; bf16x8 kf[8];
  const lds_cptr shm3=(lds_cptr)shm; const lds_cptr kp0=shm3+LDS_K+hi*1024+r32*16; const lds_cptr vp0=shm3+LDS_V+((lane>>4)&1)*32+(lane&3)*8+(4*hi+((lane&15)>>2))*64;
  const int NT=(q0+QB)/KVBLK;
  if(wid<4){ unsigned keep_; const bf16* zp_=Z+(rowbase+q0+tid)*DM+h*D;
    asm volatile("s_mov_b32 %0, m0\n\ts_mov_b32 m0, %2\n\ts_nop 0\n\tglobal_load_lds_dword %1, off\n\ts_mov_b32 m0, %0":"=&s"(keep_):"v"(zp_),"s"(lds0+(unsigned)ATTN_DUMP):"memory"); }
  DMA_K(0,0);DMA_V(0,0);DMA_K(1,SLOTB);
  float bias_own;
  { __attribute__((address_space(3))) u32x2_t* bw=(__attribute__((address_space(3))) u32x2_t*)(shm3+LDS_BIAS);
    const __attribute__((address_space(1))) float* cg=(const __attribute__((address_space(1))) float*)CBG; float cb_[8];
    _Pragma("unroll") for(int k_=0;k_<8;++k_){ const int i_=tid+k_*NW*64; cb_[k_]=(i_<NT*KVBLK)?cg[i_]:0.f; }
    const float cref=cg[q0]; const float cown=cg[q0+wid*QBLK+(lane&31)];
    _Pragma("unroll") for(int k_=0;k_<8;++k_){ const int i_=tid+k_*NW*64; if(i_<NT*KVBLK) bw[i_]=split3(cref-cb_[k_]); }
    if(tid<64) bw[SEQ+tid]=(u32x2_t){0x3F803F80u,0x00003F80u};
    bias_own=cref-cown; }
  bf16x8 qr[4];
  #pragma unroll
  for(int d0=0;d0<4;++d0)qr[d0]=*(const __attribute__((address_space(1))) bf16x8*)(&Qw[(long)r32*DM+d0*16+hi*8]);
  bf16x8 kq[4];
  #pragma unroll
  for(int d0=0;d0<4;++d0){ const int qr_=q0+wid*QBLK+r32; kq[d0]=*(const __attribute__((address_space(1))) bf16x8*)(&Kh[(long)(qr_>>6)*(NHEAD*8192)+(2*d0+hi)*512+(qr_&63)*8]); }
  float mhat=0.f,l_reg=0.f;f32x16 o[2];o[0]=f32x16{};o[1]=f32x16{};
  const int qrel=wid*QBLK+r32;
  #define CMASK(P0,P1,t) do{int jb_=(t)-(NT-4); if(jb_>=0)cmask(P0,P1,jb_,qrel,hi);}while(0)
  const __attribute__((address_space(3))) char* kbp=(const __attribute__((address_space(3))) char*)(shm3+LDS_BIAS)+(hi?SEQ*8:0)+r32*8; const int kbstride=hi?0:KVBLK*8;
  u32x2_t kba,kbb; bf16x8 qm;
  #define KBLOAD() do{ kba=*(const __attribute__((address_space(3))) u32x2_t*)(kbp); kbb=*(const __attribute__((address_space(3))) u32x2_t*)(kbp+256); }while(0)
  #define KBF(v) __builtin_bit_cast(bf16x8,(u32x4){(v)[0],(v)[1],0u,0u})
  #define QMSET() do{ const u32x2_t v_=hi?split3(-mhat):(u32x2_t){0x3F803F80u,0x00003F80u}; qm=__builtin_bit_cast(bf16x8,(u32x4){v_[0],v_[1],0u,0u}); }while(0)
  #define CZERO (f32x16){0.f,0.f,0.f,0.f,0.f,0.f,0.f,0.f,0.f,0.f,0.f,0.f,0.f,0.f,0.f,0.f}
  bool resc=false;
  #define START(P0,P1) do{ const float rm=rowmax(P0,P1); resc=false; \
    { const float dl=__builtin_fmaxf(rm,sdiag); mhat=fadd_s(mhat,dl); QMSET(); \
      _Pragma("unroll") for(int r=0;r<16;++r){P0[r]=fsub_s(P0[r],dl);P1[r]=fsub_s(P1[r],dl);} } \
    _Pragma("unroll") for(int r=0;r<16;++r)P0[r]=__builtin_amdgcn_exp2f(P0[r]); }while(0)
  #define RESC() do{ if(resc){ asm volatile("s_waitcnt lgkmcnt(0)":::"memory"); \
      _Pragma("unroll") for(int d_=0;d_<2;++d_) _Pragma("unroll") for(int r=0;r<16;++r)o[d_][r]*=wsf[crow(r,hi)]; } }while(0)
  f32x16 pA0,pA1,pB0,pB1;
  int sl_prev=0,sl_cur=0,sl_next=SLOTB;
  #define ROT() do{sl_prev=sl_cur;sl_cur=sl_next;sl_next=(sl_next==(NSLOT-1)*SLOTB)?0:sl_next+SLOTB;}while(0)
  DMA_K(2,2*SLOTB);
  WAIT_BAR(3);
  float sdiag;
  { float acc_=0.f;
    #pragma unroll
    for(int d0=0;d0<4;++d0){
      #pragma unroll
      for(int e=0;e<8;++e)acc_+=__uint_as_float((unsigned)(unsigned short)qr[d0][e]<<16)*__uint_as_float((unsigned)(unsigned short)kq[d0][e]<<16);}
    auto rr_=__builtin_amdgcn_permlane32_swap(__float_as_uint(acc_),__float_as_uint(acc_),false,false);
    sdiag=__uint_as_float(rr_[0])+__uint_as_float(rr_[1])+bias_own; }
  { QMSET(); KBLOAD(); f32x16 ci0=__builtin_amdgcn_mfma_f32_32x32x16_bf16(KBF(kba),qm,CZERO,0,0,0),ci1=__builtin_amdgcn_mfma_f32_32x32x16_bf16(KBF(kbb),qm,CZERO,0,0,0); qkt(pA0,pA1,Kbase,qr,ci0,ci1,r32,hi); } asm volatile("s_nop 15\n\ts_nop 7":"+v"(pA0),"+v"(pA1));CMASK(pA0,pA1,0);
  START(pA0,pA1);
  _Pragma("unroll") for(int r=0;r<16;++r)pA1[r]=__builtin_amdgcn_exp2f(pA1[r]);
  WAIT_BAR(0);
  DMA_K(3,0);DMA_V(1,SLOTB);
  ROT();
  kload8(kf,kp0+sl_cur);
  WAIT_BAR(2);
  s16x4 vlo[8],vhi[8]; u32x4 pw0,pw1,pw2,pw3;
  #define PKW(P,B) cvtpk_s(P[B],P[B+1])
  #define PAF(k) __builtin_bit_cast(bf16x8,pw##k)
  #define VFR(i) (bf16x8){vlo[i][0],vlo[i][1],vlo[i][2],vlo[i][3],vhi[i][0],vhi[i][1],vhi[i][2],vhi[i][3]}
  #define PIN(x) asm volatile("":"+v"(x))
  #define MX3(a,b,c) __builtin_fmaxf(__builtin_fmaxf((a),(b)),(c))
  #define GAPA(MF,A0,A1,A2,A3,W0,W1,PW) do{ MF; sacc+=A0; sacc+=A1; sacc+=A2; sacc+=A3; PIN(sacc); W0; W1; PIN(PW); SBAR(); }while(0)
  #define EX(v) __builtin_amdgcn_exp2f(v)
  #define GAPB(MF,X,B) do{ MF; X[B]=EX(X[B]); X[B+1]=EX(X[B+1]); X[B+2]=EX(X[B+2]); X[B+3]=EX(X[B+3]); PIN(X); SBAR(); }while(0)
  #define VRD(i) do{ vlo[i]=vtr(vp_+(((i)>>2)*4096+((i)&3)*1024)); vhi[i]=vtr(vp_+(((i)>>2)*4096+((i)&3)*1024+512)); }while(0)
  #define KRD(G,j) do{ if(G){ kload2(kf,kp0+sl_next,j); SBAR(); } }while(0)
  #define STEP(C0,C1,P0,P1,t,GK,GV,GL) do{ SBAR(); \
    const lds_cptr vp_=vp0+sl_prev; \
    C0=__builtin_amdgcn_mfma_f32_32x32x16_bf16(KBF(kba),qm,CZERO,0,0,0); C1=__builtin_amdgcn_mfma_f32_32x32x16_bf16(KBF(kbb),qm,CZERO,0,0,0); SBAR(); \
    VRD(0); SBAR(); float sacc=(P0[0]+P0[1]); \
    GAPA(C0=__builtin_amdgcn_mfma_f32_32x32x16_bf16(kf[0],qr[0],C0,0,0,0), P0[2],P0[3],P0[4],P0[5],     pw0[0]=PKW(P0,0), pw0[1]=PKW(P0,2), pw0); \
    VRD(4); SBAR(); GAPA(C1=__builtin_amdgcn_mfma_f32_32x32x16_bf16(kf[1],qr[0],C1,0,0,0), P0[6],P0[7],P0[8],P0[9],     pw0[2]=PKW(P0,4), pw0[3]=PKW(P0,6), pw0); \
    VRD(1); SBAR(); GAPA(C0=__builtin_amdgcn_mfma_f32_32x32x16_bf16(kf[2],qr[1],C0,0,0,0),   P0[10],P0[11],P0[12],P0[13], pw1[0]=PKW(P0,8), pw1[1]=PKW(P0,10), pw1); \
    VRD(5); SBAR(); GAPA(C1=__builtin_amdgcn_mfma_f32_32x32x16_bf16(kf[3],qr[1],C1,0,0,0),   P0[14],P0[15],P1[0],P1[1],   pw1[2]=PKW(P0,12),pw1[3]=PKW(P0,14), pw1); \
    VRD(2); SBAR(); GAPA(C0=__builtin_amdgcn_mfma_f32_32x32x16_bf16(kf[4],qr[2],C0,0,0,0),   P1[2],P1[3],P1[4],P1[5],     pw2[0]=PKW(P1,0), pw2[1]=PKW(P1,2), pw2); \
    VRD(6); SBAR(); GAPA(C1=__builtin_amdgcn_mfma_f32_32x32x16_bf16(kf[5],qr[2],C1,0,0,0),   P1[6],P1[7],P1[8],P1[9],     pw2[2]=PKW(P1,4), pw2[3]=PKW(P1,6), pw2); \
    VRD(3); SBAR(); GAPA(C0=__builtin_amdgcn_mfma_f32_32x32x16_bf16(kf[6],qr[3],C0,0,0,0),   P1[10],P1[11],P1[12],P1[13], pw3[0]=PKW(P1,8), pw3[1]=PKW(P1,10), pw3); \
    VRD(7); SBAR(); GAPA(C1=__builtin_amdgcn_mfma_f32_32x32x16_bf16(kf[7],qr[3],C1,0,0,0),   P1[14],P1[15],0.f,0.f,       pw3[2]=PKW(P1,12),pw3[3]=PKW(P1,14), pw3); \
    l_reg+=sacc; \
    if(GK){DMA_K((t)+3,sl_cur);} if(GV){DMA_V((t)+1,sl_next);} \
    CMASK(C0,C1,t); \
    { float a=MX3(C0[0],C0[1],C1[0]),b=MX3(C0[2],C0[3],C1[1]); a=MX3(a,C1[2],C1[3]); \
      _Pragma("unroll") for(int r=4;r<16;r+=4){a=MX3(a,C0[r],C0[r+1]);b=MX3(b,C0[r+2],C0[r+3]);a=MX3(a,C1[r],C1[r+1]);b=MX3(b,C1[r+2],C1[r+3]);} \
      float rm=__builtin_fmaxf(a,b); { auto rr=__builtin_amdgcn_permlane32_swap(__float_as_uint(rm),__float_as_uint(rm),false,false); rm=__builtin_fmaxf(__uint_as_float(rr[0]),__uint_as_float(rr[1])); } \
      resc=false; \
      if(__builtin_expect(__any(rm>(float)THRL),0)){ const float dl=__builtin_fmaxf(rm,0.f); mhat+=dl; QMSET(); \
        _Pragma("unroll") for(int r=0;r<16;++r){C0[r]-=dl;C1[r]-=dl;} \
        const float f=__builtin_amdgcn_exp2f(-dl); l_reg*=f; if(hi==0)wsf[r32]=f; resc=true; } } \
    SBAR(); \
    GAPB(o[0]=__builtin_amdgcn_mfma_f32_32x32x16_bf16(PAF(0),VFR(0),o[0],0,0,0), C0,0); \
    GAPB(o[1]=__builtin_amdgcn_mfma_f32_32x32x16_bf16(PAF(0),VFR(4),o[1],0,0,0), C0,4); \
    KRD(GL,0); GAPB(o[0]=__builtin_amdgcn_mfma_f32_32x32x16_bf16(PAF(1),VFR(1),o[0],0,0,0), C0,8); \
    KRD(GL,1); GAPB(o[1]=__builtin_amdgcn_mfma_f32_32x32x16_bf16(PAF(1),VFR(5),o[1],0,0,0), C0,12); \
    KRD(GL,2); GAPB(o[0]=__builtin_amdgcn_mfma_f32_32x32x16_bf16(PAF(2),VFR(2),o[0],0,0,0), C1,0); \
    KRD(GL,3); GAPB(o[1]=__builtin_amdgcn_mfma_f32_32x32x16_bf16(PAF(2),VFR(6),o[1],0,0,0), C1,4); \
    GAPB(o[0]=__builtin_amdgcn_mfma_f32_32x32x16_bf16(PAF(3),VFR(3),o[0],0,0,0), C1,8); \
    GAPB(o[1]=__builtin_amdgcn_mfma_f32_32x32x16_bf16(PAF(3),VFR(7),o[1],0,0,0), C1,12); \
    kbp+=kbstride; KBLOAD();   \
    }while(0)
  kbp+=kbstride; KBLOAD();
  int t=1;
  #undef CMASK
  #define CMASK(P0,P1,t) do{}while(0)
  for(;t+5<NT;t+=2){
    STEP(pB0,pB1,pA0,pA1,t,true,true,true);     WAIT_BAR(2); RESC(); ROT();
    STEP(pA0,pA1,pB0,pB1,t+1,true,true,true);   WAIT_BAR(2); RESC(); ROT();
  }
  #undef CMASK
  #define CMASK(P0,P1,t) do{int jb_=(t)-(NT-4); if(jb_>=0)cmask(P0,P1,jb_,qrel,hi);}while(0)
  #define ENDW(tt) do{ if((tt)+3<NT){WAIT_BAR(2);} else if((tt)+2<NT){WAIT_BAR(1);} else {WAIT_BAR(0);} }while(0)
  for(;t+1<NT;t+=2){
    STEP(pB0,pB1,pA0,pA1,t,(t+3<NT),(t+1<NT),(t+1<NT));       ENDW(t);   RESC(); ROT();
    STEP(pA0,pA1,pB0,pB1,t+1,(t+4<NT),(t+2<NT),(t+2<NT));     ENDW(t+1); RESC(); ROT();
  }
  STEP(pB0,pB1,pA0,pA1,NT-1,false,false,false); RESC();
  { float sacc=pB0[0]+pB0[1]; _Pragma("unroll") for(int r=2;r<16;++r)sacc+=pB0[r]; _Pragma("unroll") for(int r=0;r<16;++r)sacc+=pB1[r]; l_reg+=sacc;
    pw0=(u32x4){PKW(pB0,0),PKW(pB0,2),PKW(pB0,4),PKW(pB0,6)};pw1=(u32x4){PKW(pB0,8),PKW(pB0,10),PKW(pB0,12),PKW(pB0,14)};pw2=(u32x4){PKW(pB1,0),PKW(pB1,2),PKW(pB1,4),PKW(pB1,6)};pw3=(u32x4){PKW(pB1,8),PKW(pB1,10),PKW(pB1,12),PKW(pB1,14)};
    SBAR(); pv(o,vb0+sl_cur,PAF(0),PAF(1),PAF(2),PAF(3)); }
  #undef PKW
  #undef PAF
  #undef VFR
  #undef PIN
  #undef MX3
  #undef GAPA
  #undef GAPB
  #undef EX
  #undef VRD
  #undef KRD
  #undef STEP
  #undef ENDW
  {auto rr=__builtin_amdgcn_permlane32_swap(__float_as_uint(l_reg),__float_as_uint(l_reg),false,false);l_reg=__uint_as_float(rr[0])+__uint_as_float(rr[1]);}
  if(hi==0)wsf[32+r32]=l_reg;asm volatile("s_waitcnt lgkmcnt(0)":::"memory");
  float rli[16];
  #pragma unroll
  for(int r=0;r<16;++r)rli[r]=__builtin_amdgcn_rcpf(wsf[32+crow(r,hi)]);
  bf16*Ow=O+(rowbase+q0+wid*QBLK)*OPITCH+h*D;
  const bf16*Zw=Z+(rowbase+q0+wid*QBLK)*DM+h*D;
  { bf16*stg=(bf16*)(shm+LDS_OST)+wid*2048;
    const __attribute__((address_space(1))) unsigned short* Zg=(const __attribute__((address_space(1))) unsigned short*)Zw; unsigned zr[32];
    #pragma unroll
    for(int r=0;r<16;++r){const int orow=crow(r,hi);
      #pragma unroll
      for(int d0=0;d0<2;++d0) zr[2*r+d0]=Zg[(long)orow*DM+d0*32+r32]; }
    #pragma unroll
    for(int r=0;r<16;++r){const int orow=crow(r,hi);
      #pragma unroll
      for(int d0=0;d0<2;++d0){ const float z=__uint_as_float(zr[2*r+d0]<<16); const float sg=z*__builtin_amdgcn_rcpf(1.f+__expf(-z)); stg[orow*64+d0*32+r32]=__float2bfloat16(o[d0][r]*rli[r]*sg);} }
    asm volatile("s_waitcnt lgkmcnt(0)":::"memory");
    #pragma unroll
    for(int i=0;i<4;++i){const int row=i*8+(lane>>3),ch=lane&7; const u32x4 v=*(const u32x4*)(stg+row*64+ch*8); ATTN_STORE16(Ow+(long)row*OPITCH+ch*8,v);} }
  asm volatile("s_waitcnt lgkmcnt(0)\n\ts_barrier":::"memory");
  #undef DMA_K
  #undef DMA_V
  #undef CMASK
  #undef START
  #undef KBLOAD
  #undef KBF
  #undef QMSET
  #undef CZERO
  #undef RESC
  #undef ROT
}
constexpr int ATTN_LDS_BYTES=LDS_BYTES;
struct AttnTensors { const bf16* Q; const bf16* K; const bf16* V; const bf16* Z; const float* CB; bf16* O; };
struct AttnUnit { int bh; int qb; };
struct StaticOrder {
  int vcu;
  __device__ __forceinline__ explicit StaticOrder(int grid,int block):vcu((grid%8==0)?((block%8)*(grid/8)+block/8):block){}
  __device__ __forceinline__ bool next(int i,AttnUnit&u)const{ const int L=vcu*4+i; if(i>=4||L>=BATCH*NHEAD*NQB)return false; const int s=vcu&3; u.bh=vcu>>2; u.qb=(i==0)?15-s:(i==1)?11-s:(i==2)?4+s:s; return true; }
  __device__ __forceinline__ void a_ready(const AttnUnit&)const{}
  __device__ __forceinline__ void done(const AttnUnit&)const{}
};
template<class Sched,int THRL=8> __device__ __forceinline__ void attn_phase(char*lds,const AttnTensors&T,const Sched&S){
  AttnUnit u;
  for(int i=0;S.next(i,u);++i){ S.a_ready(u); attn_unit<THRL>(u.bh/NHEAD,u.bh%NHEAD,u.qb,T.Q,T.K,T.V,T.Z,T.CB+(long)u.bh*SEQ,T.O,lds); S.done(u); }
}
template<int THRL=8> __device__ __forceinline__ void attn_phase_queue(char*lds,const AttnTensors&T,unsigned*ctr,volatile __attribute__((address_space(3))) unsigned*qw){
  const int tid=threadIdx.x; unsigned nxt=0u;
  if(tid==0)nxt=__hip_atomic_fetch_add(ctr,1u,__ATOMIC_RELAXED,__HIP_MEMORY_SCOPE_AGENT);
  for(;;){
    if(tid==0)*qw=nxt;
    asm volatile("s_waitcnt lgkmcnt(0)\n\ts_barrier":::"memory");
    const unsigned n=(unsigned)__builtin_amdgcn_readfirstlane((int)*qw);
    asm volatile("s_waitcnt lgkmcnt(0)\n\ts_barrier":::"memory");
    if(n>=(unsigned)(BATCH*NHEAD*NQB))break;
    if(tid==0)nxt=__hip_atomic_fetch_add(ctr,1u,__ATOMIC_RELAXED,__HIP_MEMORY_SCOPE_AGENT);
    const int bh=(int)(n&63u),qb=15-(int)(n>>6);
    attn_unit<THRL>(bh/NHEAD,bh%NHEAD,qb,T.Q,T.K,T.V,T.Z,T.CB+(long)bh*SEQ,T.O,lds);
  }
}
#undef SBAR
#undef WAIT_BAR
}
#define GAS __attribute__((address_space(1)))
#define LAS __attribute__((address_space(3)))
typedef unsigned short bf16;
typedef unsigned v4u __attribute__((ext_vector_type(4)));
typedef float f32x4 __attribute__((ext_vector_type(4)));
typedef short bf16x8 __attribute__((ext_vector_type(8)));
typedef GAS unsigned gu32;
typedef GAS unsigned long long gu64;
#define RLX_AGENT __ATOMIC_RELAXED, __HIP_MEMORY_SCOPE_AGENT
#define LDS_WAIT() asm volatile("s_waitcnt lgkmcnt(0)" ::: "memory")
#define VM_WAIT() asm volatile("s_waitcnt vmcnt(0)" ::: "memory")
__device__ __forceinline__ unsigned long long rt() { return __builtin_amdgcn_s_memrealtime(); }
typedef float f32x2_hw __attribute__((ext_vector_type(2))); typedef __bf16 bf16x2_hw __attribute__((ext_vector_type(2)));
__device__ __forceinline__ unsigned pk2(float lo, float hi) { f32x2_hw v = {lo, hi}; bf16x2_hw b = __builtin_convertvector(v, bf16x2_hw); return __builtin_bit_cast(unsigned, b); }
__device__ __forceinline__ unsigned f2bf(float f) { return pk2(f, 0.f) & 0xffffu; }

#define XB_TMO      128
#define XB_XCNT(j)  (256  + 64 * (j))
#define XB_XSUB(j)  (1280 + 64 * (j))
#define XB_XGEN(j)  (2304 + 64 * (j))
#define XB_TOP      3328
#define XB_TOPGEN   3392
#define XCD_BAR_WORDS 3456
#define XB_SPIN_CAP (1u << 18)

__device__ __forceinline__ unsigned xb_ld(unsigned* p)              { return __hip_atomic_load(p, __ATOMIC_RELAXED, __HIP_MEMORY_SCOPE_AGENT); }
__device__ __forceinline__ unsigned xb_add(unsigned* p, unsigned v) { return __hip_atomic_fetch_add(p, v, __ATOMIC_RELAXED, __HIP_MEMORY_SCOPE_AGENT); }
__device__ __forceinline__ unsigned xb_xcc_id() { return (unsigned)__builtin_amdgcn_s_getreg((3 << 11) | 20) & 0xFu; }
#define XB_SPIN(cond, bar) do { unsigned _sp = 0; while (cond) { __builtin_amdgcn_s_sleep(1); \
    if ((++_sp & 255u) == 0u) { if (xb_ld(&(bar)[XB_TMO])) break; if (_sp > XB_SPIN_CAP) { atomicAdd(&(bar)[XB_TMO], 1u); break; } } } } while (0)

struct XcdBarrier {
    unsigned* bar; unsigned x;
    volatile LAS unsigned* st;
};

__device__ __forceinline__ XcdBarrier xcd_barrier_post(unsigned* bar, volatile LAS unsigned* st) {
    XcdBarrier b; b.bar = bar; b.x = xb_xcc_id(); b.st = st;
    if (threadIdx.x == 0) (void)xb_add(&bar[XB_XCNT(b.x)], 1u);
    return b;
}
__device__ __forceinline__ void xcd_barrier_complete(unsigned* bar, unsigned x, unsigned& nloc, unsigned& nx) {
    const unsigned G = gridDim.x * gridDim.y * gridDim.z;
    unsigned sum, cnt, mine, sp = 0u;
    for (;;) {
        sum = 0u; cnt = 0u; mine = 0u;
#pragma unroll
        for (unsigned j = 0; j < 16; ++j) { const unsigned c = xb_ld(&bar[XB_XCNT(j)]); sum += c; cnt += (c > 0u) ? 1u : 0u; mine = (j == x) ? c : mine; }
        if (sum == G) break;
        __builtin_amdgcn_s_sleep(1);
        if ((++sp & 255u) == 0u) { if (xb_ld(&bar[XB_TMO])) break; if (sp > XB_SPIN_CAP) { atomicAdd(&bar[XB_TMO], 1u); break; } }
    }
    nloc = mine > 0u ? mine : 1u; nx = cnt > 0u ? cnt : 1u;
}

__device__ __forceinline__ void xcd_barrier(const XcdBarrier& b) {
    asm volatile("s_waitcnt vmcnt(0)" ::: "memory");
    __syncthreads();
    if (threadIdx.x == 0) {
        unsigned* bar = b.bar;
        __builtin_amdgcn_s_waitcnt(0);
        unsigned nloc = b.st[0], nx = b.st[1];
        if (nloc == 0u) { xcd_barrier_complete(bar, b.x, nloc, nx); b.st[0] = nloc; b.st[1] = nx; }
        const unsigned old = xb_add(&bar[XB_XSUB(b.x)], 1u);
        const unsigned gen = old / nloc;
        if (old + 1u == (gen + 1u) * nloc) {
            __builtin_amdgcn_fence(__ATOMIC_RELEASE, "agent");
            asm volatile("s_waitcnt vmcnt(0)" ::: "memory");
            const unsigned og = xb_add(&bar[XB_TOP], 1u);
            const unsigned tg = og / nx;
            if (og + 1u == (tg + 1u) * nx) xb_add(&bar[XB_TOPGEN], 1u);
            else XB_SPIN(xb_ld(&bar[XB_TOPGEN]) == tg, bar);
            __builtin_amdgcn_fence(__ATOMIC_ACQUIRE, "agent");
            xb_add(&bar[XB_XGEN(b.x)], 1u);
            asm volatile("s_waitcnt vmcnt(0)" ::: "memory");
        } else {
            XB_SPIN(xb_ld(&bar[XB_XGEN(b.x)]) == gen, bar);
            __builtin_amdgcn_fence(__ATOMIC_ACQUIRE, "agent");
            asm volatile("s_waitcnt vmcnt(0)" ::: "memory");
        }
    }
    __syncthreads();
}
constexpr int NWAVES = 8, NTHREADS = 512;
constexpr int PH_SCRATCH = 163072;
constexpr int MISC_OFF = PH_SCRATCH;
constexpr int LDS_BYTES = PH_SCRATCH + 512;
typedef float f32x2 __attribute__((ext_vector_type(2)));

struct Args { const float* in[30]; float* out; unsigned char* ws; int do_pro, fused, l_lo, l_hi, ph_lo, ph_hi; };

__device__ __forceinline__ float bf2f(bf16 v) { return __uint_as_float((unsigned)v << 16); }
__device__ __forceinline__ float sigmoid_f(float x) { return __builtin_amdgcn_rcpf(1.f + __expf(-x)); }
__device__ __forceinline__ float silu_f(float x) { return x * __builtin_amdgcn_rcpf(1.f + __expf(-x)); }
__device__ __forceinline__ float log1p_fast(float u) { const float w = 1.f + u; const float d = w - 1.f; return (d == 0.f) ? u : __logf(w) * u * __builtin_amdgcn_rcpf(d); }
__device__ __forceinline__ float softplus_f(float x) { return fmaxf(x, 0.f) + log1p_fast(__expf(-fabsf(x))); }
__device__ __forceinline__ float rcp_fast(float x) { return __builtin_amdgcn_rcpf(x); }
__device__ __forceinline__ float rsq_fast(float x) { return __builtin_amdgcn_rsqf(x); }
__device__ __forceinline__ float sigmoid_fast(float x) { return __builtin_amdgcn_rcpf(1.f + __expf(-x)); }
__device__ __forceinline__ float silu_fast(float x) { return x * __builtin_amdgcn_rcpf(1.f + __expf(-x)); }
__device__ __forceinline__ float softplus_fast(float x) { return fmaxf(x, 0.f) + __logf(1.f + __expf(-fabsf(x))); }
__device__ __forceinline__ float tanh_fast(float x) { const float e = __expf(-2.f * fabsf(x)); const float t = (1.f - e) * __builtin_amdgcn_rcpf(1.f + e); return x < 0.f ? -t : t; }
__device__ __forceinline__ float logsigmoid_f(float x) { return fminf(x, 0.f) - log1p_fast(__expf(-fabsf(x))); }
template <int CTRL> __device__ __forceinline__ float dpp_f(float v) { return __int_as_float(__builtin_amdgcn_update_dpp(0, __float_as_int(v), CTRL, 0xF, 0xF, true)); }
__device__ __forceinline__ float wave_sum_dpp(float v) { v += dpp_f<0xB1>(v); v += dpp_f<0x4E>(v); v += dpp_f<0x141>(v); v += dpp_f<0x140>(v);
    v += __int_as_float(__builtin_amdgcn_update_dpp(0, __float_as_int(v), 0x142, 0xA, 0xF, false)); v += __int_as_float(__builtin_amdgcn_update_dpp(0, __float_as_int(v), 0x143, 0xC, 0xF, false));
    return __int_as_float(__builtin_amdgcn_readlane(__float_as_int(v), 63)); }
__device__ __forceinline__ float wave_sum(float v) { return wave_sum_dpp(v); }
__device__ __forceinline__ float row16_sum(float v) { v += dpp_f<0xB1>(v); v += dpp_f<0x4E>(v); v += dpp_f<0x141>(v); v += dpp_f<0x140>(v); return v; }

typedef float f32x16 __attribute__((ext_vector_type(16)));
typedef __bf16 bf16x2_t __attribute__((ext_vector_type(2)));
#define MFMA32(a_, b_, c_) __builtin_amdgcn_mfma_f32_32x32x16_bf16((a_), (b_), (c_), 0, 0, 0)
constexpr size_t WS_PK = 1068 * MiB, PK_STRIDE = 32 * MiB;
constexpr size_t WS_PKWC = 1292 * MiB;
constexpr size_t WS_W2T = 1293 * MiB, WS_A2T = WS_W2T + 256 * 1024;
constexpr size_t WS_KV = 1294 * MiB;
constexpr size_t WS_END2 = 1360 * MiB;
constexpr int LDM = 72;
constexpr int CL_MSZ = 64 * LDM * 2, CL_AAB = 9 * CL_MSZ, CL_YAK = CL_AAB + 64 * 68 * 4, CL_AT32 = CL_YAK + 64 * 68 * 4, CL_LW = CL_AT32 + 64 * 68 * 4, CL_AIB = CL_LW + 64 * 64 * 4, CL_VEC = CL_AIB + 64 * 64 * 2, CL_TMP = CL_VEC + 5 * 256, CL_END = CL_TMP + 8 * 256;
static_assert(CL_END <= PH_SCRATCH, "chunk LDS");
__device__ __forceinline__ int crow16(int reg, int hh) { return (reg & 3) + 8 * (reg >> 2) + 4 * hh; }
__device__ __forceinline__ unsigned cvtpk(float lo, float hi) { f32x2 v = {lo, hi}; bf16x2_t b = __builtin_convertvector(v, bf16x2_t); return __builtin_bit_cast(unsigned, b); }
__device__ __forceinline__ bf16x8 pack8v(float e0, float e1, float e2, float e3, float e4, float e5, float e6, float e7) { v4u p; p.x = cvtpk(e0, e1); p.y = cvtpk(e2, e3); p.z = cvtpk(e4, e5); p.w = cvtpk(e6, e7); return __builtin_bit_cast(bf16x8, p); }
#define PACK8(x_, s_) pack8v((x_)[8 * (s_)], (x_)[8 * (s_) + 1], (x_)[8 * (s_) + 2], (x_)[8 * (s_) + 3], (x_)[8 * (s_) + 4], (x_)[8 * (s_) + 5], (x_)[8 * (s_) + 6], (x_)[8 * (s_) + 7])
__device__ __forceinline__ void unpack8(f32x16& x, int s, v4u p) {
    x[8 * s + 0] = __uint_as_float(p.x << 16); x[8 * s + 1] = __uint_as_float(p.x & 0xffff0000u); x[8 * s + 2] = __uint_as_float(p.y << 16); x[8 * s + 3] = __uint_as_float(p.y & 0xffff0000u);
    x[8 * s + 4] = __uint_as_float(p.z << 16); x[8 * s + 5] = __uint_as_float(p.z & 0xffff0000u); x[8 * s + 6] = __uint_as_float(p.w << 16); x[8 * s + 7] = __uint_as_float(p.w & 0xffff0000u);
}
typedef LAS unsigned short lbf16;
__device__ __forceinline__ bf16x8 frag_nat(const lbf16* M, int row, int k0) { return *(const LAS bf16x8*)(M + row * LDM + k0); }
__device__ __forceinline__ bf16x8 frag_perm(const lbf16* M, int row, int s, int hh) {
    typedef unsigned u32x2 __attribute__((ext_vector_type(2)));
    const u32x2 lo = *(const LAS u32x2*)(M + row * LDM + 16 * s + 4 * hh), hi = *(const LAS u32x2*)(M + row * LDM + 16 * s + 8 + 4 * hh);
    v4u p; p.x = lo.x; p.y = lo.y; p.z = hi.x; p.w = hi.y; return __builtin_bit_cast(bf16x8, p);
}
__device__ __forceinline__ lbf16* cl_mat(LAS unsigned char* L, int i) { return (lbf16*)(L + i * CL_MSZ); }

#define CL_BAR() asm volatile("s_waitcnt lgkmcnt(0)\n\ts_barrier" ::: "memory")
struct RwkvConst { float mur, muk, muv, muw, mua, kkc, kac, rkc, bias; bf16x8 bfr[4]; };
struct RwkvRaw { unsigned r[5], k[5], v[5], w[5], a[5]; };
__device__ __forceinline__ float rawf(const unsigned* p, int i) { return (i & 1) ? __uint_as_float(p[i >> 1] & 0xffff0000u) : __uint_as_float(p[i >> 1] << 16); }
__device__ __forceinline__ void rwkv_const_load(RwkvConst& K, const Args& a, int l, int h, int tid) {
    const int lane = tid & 63, wave = __builtin_amdgcn_readfirstlane(tid >> 6);
    const GAS float* mu = (const GAS float*)a.in[12] + l * NSHIFT;
    K.mur = mu[h * 64 + lane]; K.muk = mu[256 + h * 64 + lane]; K.muv = mu[512 + h * 64 + lane]; K.muw = mu[768 + lane]; K.mua = mu[832 + lane];
    K.kkc = a.in[17][l * 256 + h * 64 + lane]; K.kac = a.in[18][l * 256 + h * 64 + lane]; K.rkc = a.in[19][l * 256 + h * 64 + lane];
    const int mat = wave >> 2, kb = wave & 1, r = lane & 31, hh = lane >> 5;
    const GAS bf16* Bg = (const GAS bf16*)(a.ws + (mat ? WS_A2T : WS_W2T)) + ((size_t)l * 256 + h * 64 + 32 * kb + r) * 64 + 8 * hh;
#pragma unroll
    for (int ks = 0; ks < 4; ++ks) K.bfr[ks] = *(const GAS bf16x8*)(Bg + 16 * ks);
    K.bias = a.in[mat ? 15 : 13][l * 256 + h * 64 + 32 * kb + r];
}
__device__ __forceinline__ void rwkv_raw_load_vw(RwkvRaw& R, const Args& a, int b, int c, int h, int wave, int lane) {
    const GAS bf16* p0 = (const GAS bf16*)(a.ws + WS_PROJ) + (size_t)(b * TSEQ + c * 64 + wave * 8 - 1) * NPJ;
    const bool first = (c == 0 && wave == 0);
    unsigned T[9][5];
#pragma unroll
    for (int i = 0; i < 9; ++i) { const GAS bf16* pp = p0 + (size_t)((i == 0 && first) ? 1 : i) * NPJ;
        T[i][0] = pp[h * 64 + lane]; T[i][1] = pp[256 + h * 64 + lane]; T[i][2] = pp[512 + h * 64 + lane]; T[i][3] = pp[768 + lane]; T[i][4] = pp[832 + lane]; }
#pragma unroll
    for (int s_ = 0; s_ < 5; ++s_) if (first) T[0][s_] = 0u;
#pragma unroll
    for (int p = 0; p < 5; ++p) { const int i = 2 * p;
        R.r[p] = T[i][0] | (i + 1 < 9 ? T[i + 1 < 9 ? i + 1 : 8][0] << 16 : 0u); R.k[p] = T[i][1] | (i + 1 < 9 ? T[i + 1 < 9 ? i + 1 : 8][1] << 16 : 0u); R.v[p] = T[i][2] | (i + 1 < 9 ? T[i + 1 < 9 ? i + 1 : 8][2] << 16 : 0u);
        R.w[p] = T[i][3] | (i + 1 < 9 ? T[i + 1 < 9 ? i + 1 : 8][3] << 16 : 0u); R.a[p] = T[i][4] | (i + 1 < 9 ? T[i + 1 < 9 ? i + 1 : 8][4] << 16 : 0u); }
}
struct GdnConst { float cwv[4][3]; float nea, dtb; };
struct GdnRaw { unsigned x[3][6]; float sba; };
__device__ __forceinline__ void gdn_const_load(GdnConst& K, const Args& a, int l, int h, int tid) {
    const int lane = tid & 63;
    const GAS float* cw = (const GAS float*)a.in[23] + (size_t)l * 4 * NCONV + h * 64 + lane;
#pragma unroll
    for (int d = 0; d < 4; ++d)
#pragma unroll
        for (int x = 0; x < 3; ++x) K.cwv[d][x] = cw[d * NCONV + x * 256];
    K.nea = -__expf(a.in[24][l * 4 + h]); K.dtb = a.in[25][l * 4 + h];
}
__device__ __forceinline__ void gdn_raw_load_vw(GdnRaw& R, const Args& a, int b, int c, int h, int wave, int lane) {
    const int t0 = wave * 8;
    const GAS bf16* P = (const GAS bf16*)(a.ws + WS_PROJ); const GAS float* SM = (const GAS float*)(a.ws + WS_SMALL);
    unsigned T[12][3];
#pragma unroll
    for (int i = 0; i < 11; ++i) { const int tt = c * 64 + t0 - 3 + i; const int tc = tt < 0 ? 0 : tt;
#pragma unroll
        for (int x = 0; x < 3; ++x) T[i][x] = P[(size_t)(b * TSEQ + tc) * NPJ + C_CQKV + x * 256 + h * 64 + lane]; }
    { const size_t m = (size_t)b * TSEQ + c * 64 + t0 + (lane & 7); R.sba = SM[m * 16 + 8 + 4 * ((lane >> 3) & 1) + h]; }
#pragma unroll
    for (int i = 0; i < 3; ++i) { const bool neg = (c * 64 + t0 - 3 + i) < 0;
#pragma unroll
        for (int x = 0; x < 3; ++x) if (neg) T[i][x] = 0u; }
#pragma unroll
    for (int x = 0; x < 3; ++x) { T[11][x] = 0u;
#pragma unroll
        for (int p = 0; p < 6; ++p) R.x[x][p] = T[2 * p][x] | (T[2 * p + 1][x] << 16); }
}
__device__ __forceinline__ void touch_dma(const GAS void* p, LAS unsigned char* L) {
    const unsigned dst = (unsigned)(size_t)(L + MISC_OFF + 256); unsigned keep;
    asm volatile("s_mov_b32 %0, m0\n\ts_mov_b32 m0, %2\n\ts_nop 0\n\tglobal_load_lds_dword %1, off\n\ts_mov_b32 m0, %0" : "=&s"(keep) : "v"(p), "s"(dst) : "memory");
}
__device__ __forceinline__ void rwkv_touch(const Args& a, int b, int c, int h, LAS unsigned char* L, int wave, int lane) {
    int idx = (wave - 2) * 64 + lane; idx = idx < 325 ? idx : 324;
    const int row = idx / 5, seg = idx - row * 5; const int col = seg < 3 ? seg * 256 + h * 64 : 768 + (seg - 3) * 64;
    touch_dma((const GAS bf16*)(a.ws + WS_PROJ) + ((ptrdiff_t)(b * TSEQ + c * 64 - 1 + row) * NPJ + col), L);
}
__device__ __forceinline__ void gdn_touch(const Args& a, int b, int c, int h, LAS unsigned char* L, int wave, int lane) {
    int idx = (wave - 2) * 64 + lane; idx = idx < 201 ? idx : 200;
    const int row = idx / 3, seg = idx - row * 3;
    touch_dma((const GAS bf16*)(a.ws + WS_PROJ) + ((ptrdiff_t)(b * TSEQ + c * 64 - 3 + row) * NPJ + C_CQKV + seg * 256 + h * 64), L);
}
template <int STAGE  > __device__ __forceinline__ void chunk_back(LAS unsigned char* L, const bool scaled, const size_t pu, unsigned char* ws, int tid) {
    asm volatile("" : "+v"(tid));
    const int lane = tid & 63, wave = __builtin_amdgcn_readfirstlane(tid >> 6), r = lane & 31, hh = lane >> 5;
    const lbf16* JAb = cl_mat(L, 0); const lbf16* JAk = cl_mat(L, scaled ? 0 : 1); const lbf16* TBa = cl_mat(L, scaled ? 0 : 2); const lbf16* TBr = cl_mat(L, 3);
    const lbf16* AT = cl_mat(L, scaled ? 4 : 2); const lbf16* RT = cl_mat(L, scaled ? 5 : 3); const lbf16* BHT = cl_mat(L, 6); const lbf16* KHT = cl_mat(L, 7); const lbf16* VT = cl_mat(L, 8);
    LAS float* AAB = (LAS float*)(L + CL_AAB); LAS float* YAK = (LAS float*)(L + CL_YAK); const LAS float* VEC = (const LAS float*)(L + CL_VEC);
    GAS unsigned char* pk = (GAS unsigned char*)(ws + WS_PK) + pu * 8192;
    if constexpr (STAGE == 0) {
    {
        const int g = wave >> 1, tb = wave & 1;
        const lbf16* JA = (g & 1) ? JAk : JAb; const lbf16* TB = (g < 2) ? TBa : TBr;
        f32x16 X0, X1;
#pragma unroll
        for (int i = 0; i < 16; ++i) { X0[i] = 0.f; X1[i] = 0.f; }
#pragma unroll
        for (int ks = 0; ks < 4; ++ks) { const bf16x8 bfr = frag_nat(TB, 32 * tb + r, 16 * ks + 8 * hh);
            X0 = MFMA32(frag_nat(JA, r, 16 * ks + 8 * hh), bfr, X0);
            if (tb) X1 = MFMA32(frag_nat(JA, 32 + r, 16 * ks + 8 * hh), bfr, X1); }
        const int t = 32 * tb + r; const int tlim = t + ((g < 2) ? 0 : 1);
        const LAS float* EJ = VEC + ((g & 1) ? 128 : 192); const LAS float* CF = VEC + ((g & 1) ? 64 : 0); const float et = scaled ? VEC[((g < 2) ? 192 : 128) + t] : 0.f;
#pragma unroll
        for (int i = 0; i < 16; ++i) { const int j0 = crow16(i, hh), j1 = 32 + j0;
            float s0 = 1.f, s1 = 1.f;
            if (scaled) { s0 = CF[j0] * __builtin_amdgcn_exp2f(fminf(et - EJ[j0], 0.f)); s1 = CF[j1] * __builtin_amdgcn_exp2f(fminf(et - EJ[j1], 0.f)); }
            X0[i] *= (j0 < tlim) ? s0 : 0.f; X1[i] *= (j1 < tlim) ? s1 : 0.f; }
        if (g == 0) {
            { LAS float* AT32 = (LAS float*)(L + CL_AT32);
#pragma unroll 8
              for (int i = 0; i < 32; ++i) AT32[(32 * tb + i) * 68 + lane] = bf2f(AT[(32 * tb + i) * LDM + lane]); }
#pragma unroll
            for (int q = 0; q < 4; ++q) { *(LAS f32x4*)(AAB + t * 68 + 8 * q + 4 * hh) = (f32x4){X0[4 * q], X0[4 * q + 1], X0[4 * q + 2], X0[4 * q + 3]};
                if (tb) *(LAS f32x4*)(AAB + t * 68 + 32 + 8 * q + 4 * hh) = (f32x4){X1[4 * q], X1[4 * q + 1], X1[4 * q + 2], X1[4 * q + 3]}; }
        } else if (g == 2) {
            GAS v4u* dst = (GAS v4u*)(pk + 2 * PK_STRIDE) + (size_t)(tb * 4) * 64 + lane;
            dst[0 * 64] = __builtin_bit_cast(v4u, PACK8(X0, 0)); dst[1 * 64] = __builtin_bit_cast(v4u, PACK8(X0, 1));
            if (tb) { dst[2 * 64] = __builtin_bit_cast(v4u, PACK8(X1, 0)); dst[3 * 64] = __builtin_bit_cast(v4u, PACK8(X1, 1)); }
        } else {
            const bf16x8 p00 = PACK8(X0, 0), p01 = PACK8(X0, 1), p10 = PACK8(X1, 0), p11 = PACK8(X1, 1);
#pragma unroll
            for (int ib = 0; ib < 2; ++ib) { f32x16 Y;
#pragma unroll
                for (int i = 0; i < 16; ++i) Y[i] = 0.f;
                Y = MFMA32(p00, frag_perm(VT, 32 * ib + r, 0, hh), Y); Y = MFMA32(p01, frag_perm(VT, 32 * ib + r, 1, hh), Y);
                if (tb) { Y = MFMA32(p10, frag_perm(VT, 32 * ib + r, 2, hh), Y); Y = MFMA32(p11, frag_perm(VT, 32 * ib + r, 3, hh), Y); }
                if (g == 1) {
#pragma unroll
                    for (int i = 0; i < 16; ++i) YAK[(32 * tb + crow16(i, hh)) * 68 + 32 * ib + r] = Y[i];
                } else { GAS v4u* dst = (GAS v4u*)(pk + 5 * PK_STRIDE) + (size_t)((ib * 2 + tb) * 2) * 64 + lane;
                    dst[0] = __builtin_bit_cast(v4u, PACK8(Y, 0)); dst[64] = __builtin_bit_cast(v4u, PACK8(Y, 1)); } }
        }
    }
    CL_BAR();
    }
}


#define SOLVE_DECL() f32x2 X2[32]; _Pragma("unroll") for (int i_ = 0; i_ < 32; ++i_) X2[i_] = (f32x2){0.f, 0.f}
#define SOLVE_BEGIN(t0_) f32x4 Aq[2][8], Ah[8]; float rq[2] = {0.f, 0.f}; const LAS float* aab_ = (const LAS float*)(L + CL_AAB); const LAS float* rhs_f = (const LAS float*)(L + (wave == 0 ? CL_AT32 : CL_YAK)) + lane; asm volatile("" : "+v"(aab_), "+v"(rhs_f)); \
            { rq[(t0_) & 1] = rhs_f[(t0_) * 68]; _Pragma("unroll") for (int q = 0; q < ((((t0_) + 3) / 4) < 8 ? (((t0_) + 3) / 4) : 8); ++q) Aq[(t0_) & 1][q] = *(const LAS f32x4*)(aab_ + (t0_) * 68 + 4 * q); }
#define SOLVE_ROW(t_) { constexpr int T_ = (t_), P_ = T_ & 1, NQ_ = (T_ + 3) / 4, NLO_ = NQ_ < 8 ? NQ_ : 8, NQN_ = (T_ + 4) / 4, NLON_ = NQN_ < 8 ? NQN_ : 8; \
            _Pragma("unroll") for (int q = 8; q < NQ_; ++q) Ah[q - 8] = *(const LAS f32x4*)(aab_ + T_ * 68 + 4 * q); \
            if (T_ + 1 < 64) { rq[1 - P_] = rhs_f[(T_ + 1) * 68]; _Pragma("unroll") for (int q = 0; q < NLON_; ++q) Aq[1 - P_][q] = *(const LAS f32x4*)(aab_ + (T_ + 1) * 68 + 4 * q); } \
            f32x2 a01 = (f32x2){rq[P_], 0.f}, a23 = (f32x2){0.f, 0.f}; \
            _Pragma("unroll") for (int q = 0; q < NLO_; ++q) { a01 += (f32x2){Aq[P_][q].x, Aq[P_][q].y} * X2[2 * q]; a23 += (f32x2){Aq[P_][q].z, Aq[P_][q].w} * X2[2 * q + 1]; } \
            _Pragma("unroll") for (int q = 8; q < NQ_; ++q) { a01 += (f32x2){Ah[q - 8].x, Ah[q - 8].y} * X2[2 * q]; a23 += (f32x2){Ah[q - 8].z, Ah[q - 8].w} * X2[2 * q + 1]; } \
            float acc = (a01.x + a01.y) + (a23.x + a23.y); \
            asm volatile("" : "+v"(acc) :: "memory");     \
            if (T_ & 1) X2[T_ >> 1].y = acc; else X2[T_ >> 1].x = acc; }
#define XS_(t_) (((t_) & 1) ? X2[(t_) >> 1].y : X2[(t_) >> 1].x)
#define SOLVE_R_0_28 { SOLVE_BEGIN(0) SOLVE_ROW(0) SOLVE_ROW(1) SOLVE_ROW(2) SOLVE_ROW(3) SOLVE_ROW(4) SOLVE_ROW(5) SOLVE_ROW(6) SOLVE_ROW(7) SOLVE_ROW(8) SOLVE_ROW(9) SOLVE_ROW(10) SOLVE_ROW(11) SOLVE_ROW(12) SOLVE_ROW(13) SOLVE_ROW(14) SOLVE_ROW(15) SOLVE_ROW(16) SOLVE_ROW(17) SOLVE_ROW(18) SOLVE_ROW(19) SOLVE_ROW(20) SOLVE_ROW(21) SOLVE_ROW(22) SOLVE_ROW(23) SOLVE_ROW(24) SOLVE_ROW(25) SOLVE_ROW(26) SOLVE_ROW(27) }
#define SOLVE_R_28_41 { SOLVE_BEGIN(28) SOLVE_ROW(28) SOLVE_ROW(29) SOLVE_ROW(30) SOLVE_ROW(31) SOLVE_ROW(32) SOLVE_ROW(33) SOLVE_ROW(34) SOLVE_ROW(35) SOLVE_ROW(36) SOLVE_ROW(37) SOLVE_ROW(38) SOLVE_ROW(39) SOLVE_ROW(40) }
#define SOLVE_R_41_51 { SOLVE_BEGIN(41) SOLVE_ROW(41) SOLVE_ROW(42) SOLVE_ROW(43) SOLVE_ROW(44) SOLVE_ROW(45) SOLVE_ROW(46) SOLVE_ROW(47) SOLVE_ROW(48) SOLVE_ROW(49) SOLVE_ROW(50) }
#define SOLVE_R_51_59 { SOLVE_BEGIN(51) SOLVE_ROW(51) SOLVE_ROW(52) SOLVE_ROW(53) SOLVE_ROW(54) SOLVE_ROW(55) SOLVE_ROW(56) SOLVE_ROW(57) SOLVE_ROW(58) }
#define SOLVE_R_59_64 { SOLVE_BEGIN(59) SOLVE_ROW(59) SOLVE_ROW(60) SOLVE_ROW(61) SOLVE_ROW(62) SOLVE_ROW(63) }
#define SOLVE_R_28_51 { SOLVE_BEGIN(28) SOLVE_ROW(28) SOLVE_ROW(29) SOLVE_ROW(30) SOLVE_ROW(31) SOLVE_ROW(32) SOLVE_ROW(33) SOLVE_ROW(34) SOLVE_ROW(35) SOLVE_ROW(36) SOLVE_ROW(37) SOLVE_ROW(38) SOLVE_ROW(39) SOLVE_ROW(40) SOLVE_ROW(41) SOLVE_ROW(42) SOLVE_ROW(43) SOLVE_ROW(44) SOLVE_ROW(45) SOLVE_ROW(46) SOLVE_ROW(47) SOLVE_ROW(48) SOLVE_ROW(49) SOLVE_ROW(50) }
#define SOLVE_R_51_64 { SOLVE_BEGIN(51) SOLVE_ROW(51) SOLVE_ROW(52) SOLVE_ROW(53) SOLVE_ROW(54) SOLVE_ROW(55) SOLVE_ROW(56) SOLVE_ROW(57) SOLVE_ROW(58) SOLVE_ROW(59) SOLVE_ROW(60) SOLVE_ROW(61) SOLVE_ROW(62) SOLVE_ROW(63) }
#define SOLVE_R_0_40 { SOLVE_BEGIN(0) SOLVE_ROW(0) SOLVE_ROW(1) SOLVE_ROW(2) SOLVE_ROW(3) SOLVE_ROW(4) SOLVE_ROW(5) SOLVE_ROW(6) SOLVE_ROW(7) SOLVE_ROW(8) SOLVE_ROW(9) SOLVE_ROW(10) SOLVE_ROW(11) SOLVE_ROW(12) SOLVE_ROW(13) SOLVE_ROW(14) SOLVE_ROW(15) SOLVE_ROW(16) SOLVE_ROW(17) SOLVE_ROW(18) SOLVE_ROW(19) SOLVE_ROW(20) SOLVE_ROW(21) SOLVE_ROW(22) SOLVE_ROW(23) SOLVE_ROW(24) SOLVE_ROW(25) SOLVE_ROW(26) SOLVE_ROW(27) SOLVE_ROW(28) SOLVE_ROW(29) SOLVE_ROW(30) SOLVE_ROW(31) SOLVE_ROW(32) SOLVE_ROW(33) SOLVE_ROW(34) SOLVE_ROW(35) SOLVE_ROW(36) SOLVE_ROW(37) SOLVE_ROW(38) SOLVE_ROW(39) }
#define SOLVE_R_40_64 { SOLVE_BEGIN(40) SOLVE_ROW(40) SOLVE_ROW(41) SOLVE_ROW(42) SOLVE_ROW(43) SOLVE_ROW(44) SOLVE_ROW(45) SOLVE_ROW(46) SOLVE_ROW(47) SOLVE_ROW(48) SOLVE_ROW(49) SOLVE_ROW(50) SOLVE_ROW(51) SOLVE_ROW(52) SOLVE_ROW(53) SOLVE_ROW(54) SOLVE_ROW(55) SOLVE_ROW(56) SOLVE_ROW(57) SOLVE_ROW(58) SOLVE_ROW(59) SOLVE_ROW(60) SOLVE_ROW(61) SOLVE_ROW(62) SOLVE_ROW(63) }
#define SOLVE_R_0_20 { SOLVE_BEGIN(0) SOLVE_ROW(0) SOLVE_ROW(1) SOLVE_ROW(2) SOLVE_ROW(3) SOLVE_ROW(4) SOLVE_ROW(5) SOLVE_ROW(6) SOLVE_ROW(7) SOLVE_ROW(8) SOLVE_ROW(9) SOLVE_ROW(10) SOLVE_ROW(11) SOLVE_ROW(12) SOLVE_ROW(13) SOLVE_ROW(14) SOLVE_ROW(15) SOLVE_ROW(16) SOLVE_ROW(17) SOLVE_ROW(18) SOLVE_ROW(19) }
#define SOLVE_R_20_39 { SOLVE_BEGIN(20) SOLVE_ROW(20) SOLVE_ROW(21) SOLVE_ROW(22) SOLVE_ROW(23) SOLVE_ROW(24) SOLVE_ROW(25) SOLVE_ROW(26) SOLVE_ROW(27) SOLVE_ROW(28) SOLVE_ROW(29) SOLVE_ROW(30) SOLVE_ROW(31) SOLVE_ROW(32) SOLVE_ROW(33) SOLVE_ROW(34) SOLVE_ROW(35) SOLVE_ROW(36) SOLVE_ROW(37) SOLVE_ROW(38) }
#define SOLVE_R_39_49 { SOLVE_BEGIN(39) SOLVE_ROW(39) SOLVE_ROW(40) SOLVE_ROW(41) SOLVE_ROW(42) SOLVE_ROW(43) SOLVE_ROW(44) SOLVE_ROW(45) SOLVE_ROW(46) SOLVE_ROW(47) SOLVE_ROW(48) }
#define SOLVE_R_49_55 { SOLVE_BEGIN(49) SOLVE_ROW(49) SOLVE_ROW(50) SOLVE_ROW(51) SOLVE_ROW(52) SOLVE_ROW(53) SOLVE_ROW(54) }
#define SOLVE_R_55_64 { SOLVE_BEGIN(55) SOLVE_ROW(55) SOLVE_ROW(56) SOLVE_ROW(57) SOLVE_ROW(58) SOLVE_ROW(59) SOLVE_ROW(60) SOLVE_ROW(61) SOLVE_ROW(62) SOLVE_ROW(63) }
#define SOLVE_R_0_39 { SOLVE_BEGIN(0) SOLVE_ROW(0) SOLVE_ROW(1) SOLVE_ROW(2) SOLVE_ROW(3) SOLVE_ROW(4) SOLVE_ROW(5) SOLVE_ROW(6) SOLVE_ROW(7) SOLVE_ROW(8) SOLVE_ROW(9) SOLVE_ROW(10) SOLVE_ROW(11) SOLVE_ROW(12) SOLVE_ROW(13) SOLVE_ROW(14) SOLVE_ROW(15) SOLVE_ROW(16) SOLVE_ROW(17) SOLVE_ROW(18) SOLVE_ROW(19) SOLVE_ROW(20) SOLVE_ROW(21) SOLVE_ROW(22) SOLVE_ROW(23) SOLVE_ROW(24) SOLVE_ROW(25) SOLVE_ROW(26) SOLVE_ROW(27) SOLVE_ROW(28) SOLVE_ROW(29) SOLVE_ROW(30) SOLVE_ROW(31) SOLVE_ROW(32) SOLVE_ROW(33) SOLVE_ROW(34) SOLVE_ROW(35) SOLVE_ROW(36) SOLVE_ROW(37) SOLVE_ROW(38) }
#define SOLVE_R_39_51 { SOLVE_BEGIN(39) SOLVE_ROW(39) SOLVE_ROW(40) SOLVE_ROW(41) SOLVE_ROW(42) SOLVE_ROW(43) SOLVE_ROW(44) SOLVE_ROW(45) SOLVE_ROW(46) SOLVE_ROW(47) SOLVE_ROW(48) SOLVE_ROW(49) SOLVE_ROW(50) }
#define SOLVE_R_0_51 { SOLVE_BEGIN(0) SOLVE_ROW(0) SOLVE_ROW(1) SOLVE_ROW(2) SOLVE_ROW(3) SOLVE_ROW(4) SOLVE_ROW(5) SOLVE_ROW(6) SOLVE_ROW(7) SOLVE_ROW(8) SOLVE_ROW(9) SOLVE_ROW(10) SOLVE_ROW(11) SOLVE_ROW(12) SOLVE_ROW(13) SOLVE_ROW(14) SOLVE_ROW(15) SOLVE_ROW(16) SOLVE_ROW(17) SOLVE_ROW(18) SOLVE_ROW(19) SOLVE_ROW(20) SOLVE_ROW(21) SOLVE_ROW(22) SOLVE_ROW(23) SOLVE_ROW(24) SOLVE_ROW(25) SOLVE_ROW(26) SOLVE_ROW(27) SOLVE_ROW(28) SOLVE_ROW(29) SOLVE_ROW(30) SOLVE_ROW(31) SOLVE_ROW(32) SOLVE_ROW(33) SOLVE_ROW(34) SOLVE_ROW(35) SOLVE_ROW(36) SOLVE_ROW(37) SOLVE_ROW(38) SOLVE_ROW(39) SOLVE_ROW(40) SOLVE_ROW(41) SOLVE_ROW(42) SOLVE_ROW(43) SOLVE_ROW(44) SOLVE_ROW(45) SOLVE_ROW(46) SOLVE_ROW(47) SOLVE_ROW(48) SOLVE_ROW(49) SOLVE_ROW(50) }
#define SOLVE_WRITEOUT(pu_) do { GAS unsigned char* pk_ = (GAS unsigned char*)(a.ws + WS_PK) + (pu_) * 8192; const int r_ = lane & 31, hh_ = lane >> 5; \
        if (wave == 0) { lbf16* WAl = (lbf16*)(L + CL_AT32); \
            _Pragma("unroll") for (int t = 0; t < 64; ++t) WAl[t * LDM + lane] = (unsigned short)f2bf(XS_(t)); \
            asm volatile("s_waitcnt lgkmcnt(0)" ::: "memory"); \
            GAS v4u* dstw = (GAS v4u*)(pk_) + lane; \
            _Pragma("unroll") for (int f = 0; f < 8; ++f) dstw[f * 64] = __builtin_bit_cast(v4u, frag_perm(WAl, 32 * (f >> 2) + r_, f & 3, hh_)); \
        } else { GAS v4u* dst = (GAS v4u*)(pk_ + 4 * PK_STRIDE); \
            _Pragma("unroll") for (int tb = 0; tb < 2; ++tb) _Pragma("unroll") for (int oc = 0; oc < 2; ++oc) _Pragma("unroll") for (int h2 = 0; h2 < 2; ++h2) \
                dst[(size_t)(((hh_ * 2 + tb) * 2 + oc) * 64) + r_ + 32 * h2] = __builtin_bit_cast(v4u, pack8v(XS_(32 * tb + 0 + 8 * (2 * oc) + 4 * h2), XS_(32 * tb + 1 + 8 * (2 * oc) + 4 * h2), XS_(32 * tb + 2 + 8 * (2 * oc) + 4 * h2), XS_(32 * tb + 3 + 8 * (2 * oc) + 4 * h2), \
                    XS_(32 * tb + 0 + 8 * (2 * oc + 1) + 4 * h2), XS_(32 * tb + 1 + 8 * (2 * oc + 1) + 4 * h2), XS_(32 * tb + 2 + 8 * (2 * oc + 1) + 4 * h2), XS_(32 * tb + 3 + 8 * (2 * oc + 1) + 4 * h2))); } } while (0)
__device__ __forceinline__ void chunk_jobs(LAS unsigned char* L, const bool scaled, const size_t pu, unsigned char* ws, int wave, int lane) {
    asm volatile("" : "+v"(lane));
    const int r = lane & 31, hh = lane >> 5;
    const lbf16* RT = cl_mat(L, scaled ? 5 : 3); const lbf16* BHT = cl_mat(L, 6); const lbf16* KHT = cl_mat(L, 7); const lbf16* VT = cl_mat(L, 8); const LAS float* VEC = (const LAS float*)(L + CL_VEC);
    GAS unsigned char* pk = (GAS unsigned char*)(ws + WS_PK) + pu * 8192;
    if (wave < 6) {
        const int kb = (wave - 2) >> 1, ib = (wave - 2) & 1; f32x16 Y;
#pragma unroll
        for (int i = 0; i < 16; ++i) Y[i] = 0.f;
#pragma unroll
        for (int js = 0; js < 4; ++js) Y = MFMA32(frag_nat(KHT, 32 * kb + r, 16 * js + 8 * hh), frag_nat(VT, 32 * ib + r, 16 * js + 8 * hh), Y);
        GAS v4u* dst = (GAS v4u*)(pk + 6 * PK_STRIDE) + (size_t)((ib * 2 + kb) * 2) * 64 + lane;
        dst[0] = __builtin_bit_cast(v4u, PACK8(Y, 0)); dst[64] = __builtin_bit_cast(v4u, PACK8(Y, 1));
    } else {
        const lbf16* Msrc = (wave == 6) ? RT : BHT; GAS v4u* dst = (GAS v4u*)(pk + (wave == 6 ? 1 : 3) * PK_STRIDE) + lane;
#pragma unroll
        for (int f = 0; f < 8; ++f) dst[f * 64] = __builtin_bit_cast(v4u, frag_perm(Msrc, 32 * (f >> 2) + r, f & 3, hh));
        if (wave == 7) ((GAS float*)(ws + WS_PKWC))[pu * 64 + lane] = VEC[256 + lane];
    }
}
__device__ __forceinline__ f32x2 raw2(const unsigned* p, int i) { return (f32x2){rawf(p, i), rawf(p, i + 1)}; }
__device__ __forceinline__ void st_bf2(lbf16* M, int t, int lane, f32x2 v) { const unsigned w = pk2(v.x, v.y); M[t * LDM + lane] = (unsigned short)w; M[(t + 1) * LDM + lane] = (unsigned short)(w >> 16); }
__device__ __forceinline__ f32x2 exp2_2(f32x2 v) { return (f32x2){__builtin_amdgcn_exp2f(v.x), __builtin_amdgcn_exp2f(v.y)}; }
__device__ __forceinline__ void rw_F1(const Args& a, int l, const RwkvConst& K, const RwkvRaw& R, int b, int c, int h, float (&xr)[8], float (&xk)[8], float (&xv)[8], LAS unsigned char* L, int wave, int lane) {
    asm volatile("" : "+v"(lane));
    const int t0 = wave * 8; const int m0 = b * TSEQ + c * 64;
    lbf16* TW = cl_mat(L, 4); lbf16* AL = cl_mat(L, 5);
    GAS float* RVg = (GAS float*)(a.ws + WS_RARR + 5 * ARR_STRIDE) + (size_t)(m0 + t0) * 256 + h * 64 + lane;
#pragma unroll
    for (int p = 0; p < 4; ++p) { const int i = 2 * p;
        const f32x2 cr = raw2(R.r, i + 1), ck = raw2(R.k, i + 1), cv = raw2(R.v, i + 1), cw = raw2(R.w, i + 1), ca = raw2(R.a, i + 1);
        const f32x2 x_r = cr + (raw2(R.r, i) - cr) * K.mur, x_k = ck + (raw2(R.k, i) - ck) * K.muk, x_v = cv + (raw2(R.v, i) - cv) * K.muv;
        const f32x2 x_w = cw + (raw2(R.w, i) - cw) * K.muw, x_a = ca + (raw2(R.a, i) - ca) * K.mua;
        xr[i] = x_r.x; xr[i + 1] = x_r.y; xk[i] = x_k.x; xk[i + 1] = x_k.y; xv[i] = x_v.x; xv[i + 1] = x_v.y;
        st_bf2(TW, t0 + i, lane, (f32x2){tanh_fast(x_w.x), tanh_fast(x_w.y)}); st_bf2(AL, t0 + i, lane, x_a);
        RVg[(size_t)i * 256] = x_v.x; RVg[(size_t)(i + 1) * 256] = x_v.y; }
}
__device__ __forceinline__ void rw_F2(const Args& a, int l, int h, LAS unsigned char* L, int wave, int lane) {
    asm volatile("" : "+v"(lane));
    const int mat = wave >> 2, tb = (wave >> 1) & 1, kb = wave & 1, r = lane & 31, hh = lane >> 5;
    bf16x8 bfr[4]; float biasv;
    { const GAS bf16* Bg = (const GAS bf16*)(a.ws + (mat ? WS_A2T : WS_W2T)) + ((size_t)l * 256 + h * 64 + 32 * kb + r) * 64 + 8 * hh;
#pragma unroll
      for (int ks = 0; ks < 4; ++ks) bfr[ks] = *(const GAS bf16x8*)(Bg + 16 * ks);
      biasv = a.in[mat ? 15 : 13][l * 256 + h * 64 + 32 * kb + r]; }
    const lbf16* Am = cl_mat(L, 4 + mat);
    f32x16 acc;
#pragma unroll
    for (int i = 0; i < 16; ++i) acc[i] = 0.f;
#pragma unroll
    for (int ks = 0; ks < 4; ++ks) acc = MFMA32(frag_nat(Am, 32 * tb + r, 16 * ks + 8 * hh), bfr[ks], acc);
    const int k = 32 * kb + r;
    if (mat) { LAS unsigned short* Dst = (LAS unsigned short*)(L + CL_AIB);
#pragma unroll
        for (int i = 0; i < 16; ++i) Dst[(32 * tb + crow16(i, hh)) * 64 + k] = (unsigned short)f2bf(sigmoid_f(biasv + acc[i]));
    } else { LAS float* Dst = (LAS float*)(L + CL_LW);
#pragma unroll
        for (int i = 0; i < 16; ++i) { acc[i] = -0.6065306597126334f * sigmoid_f(biasv + acc[i]); Dst[(32 * tb + crow16(i, hh)) * 64 + k] = acc[i]; }
        LAS float* SUM = (LAS float*)(L + CL_TMP);
#pragma unroll
        for (int j = 0; j < 4; ++j) { float ps = (acc[4 * j] + acc[4 * j + 1]) + (acc[4 * j + 2] + acc[4 * j + 3]);
            auto rr = __builtin_amdgcn_permlane32_swap(__float_as_uint(ps), __float_as_uint(ps), false, false); ps = __uint_as_float(rr[0]) + __uint_as_float(rr[1]);
            if (hh == 0) SUM[(4 * tb + j) * 64 + k] = ps; } }
}
__device__ __forceinline__ void rw_F3b(const Args& a, const RwkvConst& K, int b, int c, int h, const float (&xr)[8], const float (&xk)[8], const float (&xv)[8], LAS unsigned char* L, int wave, int lane) {
    asm volatile("" : "+v"(lane));
    const int t0 = wave * 8; const int m0 = b * TSEQ + c * 64;
    *(LAS bf16x8*)(cl_mat(L, 8) + lane * LDM + t0) = pack8v(xv[0], xv[1], xv[2], xv[3], xv[4], xv[5], xv[6], xv[7]);
    float cumC = 0.f, off = 0.f; f32x2 ai2[4], cum2[4];
    { const LAS float* SUM = (const LAS float*)(L + CL_TMP);
#pragma unroll
      for (int w = 0; w < 8; ++w) { const float sv = SUM[w * 64 + lane]; cumC += sv; if (w < wave) off += sv; } }
    off *= LOG2E; cumC *= LOG2E;
    float e_prev = __builtin_amdgcn_exp2f(off);
    { const LAS float* LW = (const LAS float*)(L + CL_LW); const LAS unsigned short* AI = (const LAS unsigned short*)(L + CL_AIB);
#pragma unroll
      for (int p = 0; p < 4; ++p) { const int i = 2 * p; const f32x2 l2 = (f32x2){LW[(t0 + i) * 64 + lane], LW[(t0 + i + 1) * 64 + lane]} * LOG2E;
          ai2[p] = (f32x2){bf2f(AI[(t0 + i) * 64 + lane]), bf2f(AI[(t0 + i + 1) * 64 + lane])}; cum2[p].x = off + l2.x; cum2[p].y = cum2[p].x + l2.y; off = cum2[p].y; } }
    const float eC = __builtin_amdgcn_exp2f(cumC);
    GAS float* BON = (GAS float*)(a.ws + WS_BONUS) + (size_t)(m0 + t0) * 4 + h;
    lbf16 *M0 = cl_mat(L, 0), *M1 = cl_mat(L, 1), *M2 = cl_mat(L, 2), *M3 = cl_mat(L, 3);
    float bh[8], kh[8];
#pragma unroll
    for (int p = 0; p < 4; ++p) { const int i = 2 * p, t = t0 + i;
        const f32x2 ec = exp2_2(cum2[p]), en = exp2_2(-cum2[p]); const f32x2 ep = (f32x2){e_prev, ec.x}; e_prev = ec.y; const f32x2 eh = en * eC;
        const f32x2 xk2 = (f32x2){xk[i], xk[i + 1]}, xr2 = (f32x2){xr[i], xr[i + 1]};
        const f32x2 kkr = xk2 * K.kkc, sq = kkr * kkr; const float ss0 = wave_sum_dpp(sq.x), ss1 = wave_sum_dpp(sq.y);
        const f32x2 kk = kkr * (f32x2){rcp_fast(fmaxf(__builtin_amdgcn_sqrtf(ss0), 1e-12f)), rcp_fast(fmaxf(__builtin_amdgcn_sqrtf(ss1), 1e-12f))};
        const f32x2 kmod = xk2 * ((ai2[p] - 1.f) * K.kac + 1.f); const f32x2 bo = xr2 * kmod * K.rkc; const float bon0 = wave_sum_dpp(bo.x), bon1 = wave_sum_dpp(bo.y);
        const f32x2 bt = -(kk * ai2[p]);
        st_bf2(M2, t, lane, kk * ep); st_bf2(M0, t, lane, bt * en); st_bf2(M1, t, lane, kmod * en); st_bf2(M3, t, lane, xr2 * ec);
        const f32x2 bh2 = bt * eh, kh2 = kmod * eh; bh[i] = bh2.x; bh[i + 1] = bh2.y; kh[i] = kh2.x; kh[i + 1] = kh2.y;
        if (lane == 0) { BON[(size_t)i * 4] = bon0; BON[(size_t)(i + 1) * 4] = bon1; } }
    *(LAS bf16x8*)(cl_mat(L, 6) + lane * LDM + t0) = pack8v(bh[0], bh[1], bh[2], bh[3], bh[4], bh[5], bh[6], bh[7]);
    *(LAS bf16x8*)(cl_mat(L, 7) + lane * LDM + t0) = pack8v(kh[0], kh[1], kh[2], kh[3], kh[4], kh[5], kh[6], kh[7]);
    if (wave == 7) ((LAS float*)(L + CL_VEC))[4 * 64 + lane] = eC;
}
__device__ __forceinline__ void gd_Fa(const GdnConst& K, const GdnRaw& R, float (&gl)[8], float (&vv)[8], LAS unsigned char* L, int wave, int lane) {
    asm volatile("" : "+v"(lane));
    const int t0 = wave * 8; float run = 0.f;
    lbf16 *M0 = cl_mat(L, 0), *M3 = cl_mat(L, 3); LAS float* VEC = (LAS float*)(L + CL_VEC);
    const float sval = (lane & 8) ? K.nea * softplus_f(R.sba + K.dtb) : sigmoid_f(R.sba);
#pragma unroll
    for (int p = 0; p < 4; ++p) { const int i = 2 * p; f32x2 y[3];
#pragma unroll
        for (int x = 0; x < 3; ++x) { f32x2 s2 = (f32x2){0.f, 0.f};
#pragma unroll
            for (int d = 0; d < 4; ++d) s2 += raw2(R.x[x], i + d) * K.cwv[d][x];
            y[x] = s2 * (f32x2){rcp_fast(1.f + __expf(-s2.x)), rcp_fast(1.f + __expf(-s2.y))}; }
        const f32x2 qq = y[0] * y[0], kq = y[1] * y[1];
        const float qs0 = wave_sum_dpp(qq.x), qs1 = wave_sum_dpp(qq.y), ks0 = wave_sum_dpp(kq.x), ks1 = wave_sum_dpp(kq.y);
        st_bf2(M3, t0 + i, lane, y[0] * ((f32x2){rsq_fast(qs0 + L2_EPS), rsq_fast(qs1 + L2_EPS)} * 0.125f)); st_bf2(M0, t0 + i, lane, y[1] * (f32x2){rsq_fast(ks0 + L2_EPS), rsq_fast(ks1 + L2_EPS)});
        vv[i] = y[2].x; vv[i + 1] = y[2].y;
#pragma unroll
        for (int e = 0; e < 2; ++e) { run += __int_as_float(__builtin_amdgcn_readlane(__float_as_int(sval), 8 + i + e)); gl[i + e] = run; } }
    if (lane < 8) { VEC[t0 + lane] = -sval; VEC[64 + t0 + lane] = sval; }
    if (lane == 0) ((LAS float*)(L + CL_TMP))[wave] = run;
}
__device__ __forceinline__ void gd_Fb(const float (&gl)[8], const float (&vv)[8], LAS unsigned char* L, int wave, int lane) {
    asm volatile("" : "+v"(lane));
    const int t0 = wave * 8; float gcC = 0.f, off = 0.f;
    *(LAS bf16x8*)(cl_mat(L, 8) + lane * LDM + t0) = pack8v(vv[0], vv[1], vv[2], vv[3], vv[4], vv[5], vv[6], vv[7]);
    { const LAS float* GS = (const LAS float*)(L + CL_TMP);
#pragma unroll
      for (int w = 0; w < 8; ++w) { const float sv = GS[w]; gcC += sv; if (w < wave) off += sv; } }
    off *= LOG2E; gcC *= LOG2E;
    float e_prev = __builtin_amdgcn_exp2f(off), eh_prev = __builtin_amdgcn_exp2f(gcC - off), gc_prev = off;
    lbf16 *M0 = cl_mat(L, 0), *M3 = cl_mat(L, 3), *M4 = cl_mat(L, 4), *M5 = cl_mat(L, 5);
    LAS float* VEC = (LAS float*)(L + CL_VEC);
    float bh[8], kh[8];
#pragma unroll
    for (int p = 0; p < 4; ++p) { const int i = 2 * p, t = t0 + i;
        const f32x2 gc2 = (f32x2){gl[i], gl[i + 1]} * LOG2E + off;
        const f32x2 e1 = exp2_2(gc2), eh = exp2_2(gcC - gc2); const f32x2 em = (f32x2){e_prev, e1.x}, ehm = (f32x2){eh_prev, eh.x}; e_prev = e1.y; eh_prev = eh.y;
        const f32x2 kn = (f32x2){bf2f(M0[t * LDM + lane]), bf2f(M0[(t + 1) * LDM + lane])}, qn = (f32x2){bf2f(M3[t * LDM + lane]), bf2f(M3[(t + 1) * LDM + lane])}, bet = (f32x2){VEC[64 + t], VEC[65 + t]};
        st_bf2(M4, t, lane, kn * em); st_bf2(M5, t, lane, qn * e1);
        const f32x2 bk = bet * kn, bh2 = -(bk * ehm), kh2 = bk * eh; bh[i] = bh2.x; bh[i + 1] = bh2.y; kh[i] = kh2.x; kh[i + 1] = kh2.y;
        if (lane == 0) { VEC[128 + t] = gc2.x; VEC[129 + t] = gc2.y; VEC[192 + t] = gc_prev; VEC[193 + t] = gc2.x; }
        gc_prev = gc2.y; }
    *(LAS bf16x8*)(cl_mat(L, 6) + lane * LDM + t0) = pack8v(bh[0], bh[1], bh[2], bh[3], bh[4], bh[5], bh[6], bh[7]);
    *(LAS bf16x8*)(cl_mat(L, 7) + lane * LDM + t0) = pack8v(kh[0], kh[1], kh[2], kh[3], kh[4], kh[5], kh[6], kh[7]);
    if (wave == 7) VEC[4 * 64 + lane] = __builtin_amdgcn_exp2f(gcC);
}
#define FOR_VW(stmt_) do { { const int vw = wave - 2; constexpr int vs = 0; stmt_; } if (wave < 4) { const int vw = wave + 4; constexpr int vs = 1; stmt_; } } while (0)
__device__ __forceinline__ void chunk_pipeline_rwkv(const Args& a, int l, int vcu, int h, LAS unsigned char* L, int tid) {
    const int lane = tid & 63, wave = __builtin_amdgcn_readfirstlane(tid >> 6);
    const int c0 = vcu >> 3;
#define PU_(i_) (((size_t)(((c0) + 32 * (i_)) >> 6) * 4 + h) * 64 + (((c0) + 32 * (i_)) & 63))
#define UB_(i_) (((c0) + 32 * (i_)) >> 6)
#define UC_(i_) (((c0) + 32 * (i_)) & 63)
    if (wave < 2) {
        SOLVE_DECL();
        CL_BAR(); CL_BAR(); CL_BAR();
        chunk_back<0>(L, false, PU_(0), a.ws, tid);
#pragma unroll 1
        for (int i = 0; i < 16; ++i) { const size_t pu = PU_(i);
            SOLVE_R_0_39
            if (i + 1 < 16) {
                CL_BAR();
                SOLVE_R_39_51
                CL_BAR();
                SOLVE_R_51_64 SOLVE_WRITEOUT(pu);
                CL_BAR();
                chunk_back<0>(L, false, PU_(i + 1), a.ws, tid);
            } else { SOLVE_R_39_51 SOLVE_R_51_64 SOLVE_WRITEOUT(pu); CL_BAR(); } }
    } else {
        RwkvConst K; rwkv_const_load(K, a, l, h, tid);
        RwkvRaw R[2]; float xr[2][8], xk[2][8], xv[2][8];
        FOR_VW(rwkv_raw_load_vw(R[vs], a, UB_(0), UC_(0), h, vw, lane));
        rwkv_touch(a, UB_(1), UC_(1), h, L, wave, lane);
        FOR_VW(rw_F1(a, l, K, R[vs], UB_(0), UC_(0), h, xr[vs], xk[vs], xv[vs], L, vw, lane));
        CL_BAR();
        FOR_VW(rw_F2(a, l, h, L, vw, lane));
        CL_BAR();
        FOR_VW(rw_F3b(a, K, UB_(0), UC_(0), h, xr[vs], xk[vs], xv[vs], L, vw, lane));
        CL_BAR();
        chunk_back<0>(L, false, PU_(0), a.ws, tid);
#pragma unroll 1
        for (int i = 0; i < 16; ++i) { const size_t pu = PU_(i);
            if (i + 1 < 16) { FOR_VW(rwkv_raw_load_vw(R[vs], a, UB_(i + 1), UC_(i + 1), h, vw, lane)); }
            chunk_jobs(L, false, pu, a.ws, wave, lane);
            if (i + 1 < 16) {
                FOR_VW(rw_F1(a, l, K, R[vs], UB_(i + 1), UC_(i + 1), h, xr[vs], xk[vs], xv[vs], L, vw, lane));
                rwkv_touch(a, UB_((i + 2) & 15), UC_((i + 2) & 15), h, L, wave, lane);
                CL_BAR();
                FOR_VW(rw_F2(a, l, h, L, vw, lane));
                CL_BAR();
                FOR_VW(rw_F3b(a, K, UB_(i + 1), UC_(i + 1), h, xr[vs], xk[vs], xv[vs], L, vw, lane));
                CL_BAR();
                chunk_back<0>(L, false, PU_(i + 1), a.ws, tid);
            } else { CL_BAR(); } }
    }
#undef PU_
}
__device__ __forceinline__ void chunk_pipeline_gdn(const Args& a, int l, int vcu, int h, LAS unsigned char* L, int tid) {
    const int lane = tid & 63, wave = __builtin_amdgcn_readfirstlane(tid >> 6);
    const int c0 = vcu >> 3;
#define PU_(i_) (((size_t)(NB + (((c0) + 32 * (i_)) >> 6)) * 4 + h) * 64 + (((c0) + 32 * (i_)) & 63))
    if (wave < 2) {
        SOLVE_DECL();
        CL_BAR(); CL_BAR();
        chunk_back<0>(L, true, PU_(0), a.ws, tid);
#pragma unroll 1
        for (int i = 0; i < 16; ++i) { const size_t pu = PU_(i);
            SOLVE_R_0_51
            if (i + 1 < 16) {
                CL_BAR();
                SOLVE_R_51_64 SOLVE_WRITEOUT(pu);
                CL_BAR();
                chunk_back<0>(L, true, PU_(i + 1), a.ws, tid);
            } else { SOLVE_R_51_64 SOLVE_WRITEOUT(pu); CL_BAR(); } }
    } else {
        GdnConst K; gdn_const_load(K, a, l, h, tid);
        GdnRaw R[2]; float gl[2][8], vv[2][8];
        FOR_VW(gdn_raw_load_vw(R[vs], a, UB_(0), UC_(0), h, vw, lane)); gdn_touch(a, UB_(1), UC_(1), h, L, wave, lane); FOR_VW(gd_Fa(K, R[vs], gl[vs], vv[vs], L, vw, lane));
        CL_BAR();
        FOR_VW(gd_Fb(gl[vs], vv[vs], L, vw, lane));
        CL_BAR();
        chunk_back<0>(L, true, PU_(0), a.ws, tid);
#pragma unroll 1
        for (int i = 0; i < 16; ++i) { const size_t pu = PU_(i);
            gdn_touch(a, UB_((i + 2) & 15), UC_((i + 2) & 15), h, L, wave, lane);
            if (i + 1 < 16) { FOR_VW(gdn_raw_load_vw(R[vs], a, UB_(i + 1), UC_(i + 1), h, vw, lane)); }
            chunk_jobs(L, true, pu, a.ws, wave, lane);
            if (i + 1 < 16) {
                FOR_VW(gd_Fa(K, R[vs], gl[vs], vv[vs], L, vw, lane));
                CL_BAR();
                FOR_VW(gd_Fb(gl[vs], vv[vs], L, vw, lane));
                CL_BAR();
                chunk_back<0>(L, true, PU_(i + 1), a.ws, tid);
            } else { CL_BAR(); } }
    }
#undef PU_
#undef UB_
#undef UC_
}
#undef FOR_VW

constexpr int CS_BUF = 7 * 8192 + 256;
static_assert(2 * CS_BUF + 2 * 16384 <= PH_SCRATCH, "chunk-scan LDS");
#define CS_BAR() asm volatile("s_waitcnt lgkmcnt(0)\n\ts_barrier" ::: "memory")
__device__ __forceinline__ void chunk_scan_unit(const Args& a, int l, int u, LAS unsigned char* L, int tid) {
    const int wave = __builtin_amdgcn_readfirstlane(tid >> 6), lane = tid & 63;
    const int mixer = u >> 5, bh = u & 31, b = bh >> 2, h = bh & 3;
    const size_t pu0 = ((size_t)(mixer * NB + b) * 4 + h) * 64;
    if (wave >= 2) {
        const GAS unsigned char* pkg = (const GAS unsigned char*)(a.ws + WS_PK) + pu0 * 8192;
        const GAS unsigned char* wcg = (const GAS unsigned char*)(a.ws + WS_PKWC) + pu0 * 256;
        const int ll = (wave - 2) * 64 + lane;
        v4u RA[10], RB[10];
#define CS_LD(set_, c_) do { _Pragma("unroll") for (int k_ = 0; k_ < 9; ++k_) { const int p_ = ll + 384 * k_; \
            set_[k_] = *(const GAS v4u*)(pkg + (size_t)(c_) * 8192 + (size_t)(p_ >> 9) * PK_STRIDE + (p_ & 511) * 16); } \
          { const int p_ = ll + 384 * 9; const int pw_ = (p_ < 3600 ? p_ : 3599) - 3584;     \
            const GAS v4u* src_ = (p_ < 3584) ? (const GAS v4u*)(pkg + (size_t)(c_) * 8192 + (size_t)6 * PK_STRIDE + (p_ & 511) * 16) : (const GAS v4u*)(wcg + (size_t)(c_) * 256 + pw_ * 16); \
            set_[9] = *src_; } } while (0)
#define CS_ST(set_, buf_) do { _Pragma("unroll") for (int k_ = 0; k_ < 9; ++k_) { const int p_ = ll + 384 * k_; *(LAS v4u*)(L + (buf_) * CS_BUF + p_ * 16) = set_[k_]; } \
          { const int p_ = ll + 384 * 9; if (p_ < 3600) *(LAS v4u*)(L + (buf_) * CS_BUF + p_ * 16) = set_[9]; } } while (0)
        typedef unsigned u32x2 __attribute__((ext_vector_type(2)));
        const int lw = wave - 2, rg = lane >> 4, j4 = 4 * (lane & 15), ch = h * 64 + j4;
        const GAS bf16* Pz = (const GAS bf16*)(a.ws + WS_PROJ) + (size_t)(b * TSEQ) * NPJ + (mixer ? C_CZ : C_AZ) + ch;
        const GAS float* RVp = (const GAS float*)(a.ws + WS_RARR + 5 * ARR_STRIDE) + (size_t)(b * TSEQ) * 256 + ch; const GAS float* BONp = (const GAS float*)(a.ws + WS_BONUS) + (size_t)(b * TSEQ) * 4 + h;
        GAS bf16* OCp = (GAS bf16*)(a.ws + WS_OC) + (size_t)(b * TSEQ) * 1024 + (mixer ? 768 : 0) + ch;
        const f32x4 gA = mixer ? *(const GAS f32x4*)((const GAS float*)a.in[26] + l * 64 + j4) : *(const GAS f32x4*)((const GAS float*)a.in[20] + l * 256 + ch);
        const f32x4 gB = mixer ? (f32x4){0.f, 0.f, 0.f, 0.f} : *(const GAS f32x4*)((const GAS float*)a.in[21] + l * 256 + ch);
        u32x2 pz[3]; f32x4 prv[3]; float pbon[3];
#pragma unroll
        for (int k_ = 0; k_ < 3; ++k_) { pz[k_] = (u32x2){0u, 0u}; prv[k_] = (f32x4){0.f, 0.f, 0.f, 0.f}; pbon[k_] = 0.f; }
  \
#define PO_LOAD(c_) do { _Pragma("unroll") for (int k_ = 0; k_ < 3; ++k_) { const int g0_ = lw + 6 * k_; const int g_ = g0_ < 16 ? g0_ : 15; const size_t t_ = (size_t)(c_) * 64 + 4 * g_ + rg; \
            pz[k_] = *(const GAS u32x2*)(Pz + t_ * NPJ); prv[k_] = *(const GAS f32x4*)(RVp + t_ * 256); pbon[k_] = BONp[t_ * 4]; } } while (0)
#define PO_RUN(c_) do { const LAS float* OB_ = (const LAS float*)(L + 2 * CS_BUF + ((c_) & 1) * 16384); \
        _Pragma("unroll") for (int k_ = 0; k_ < 3; ++k_) { const int g0_ = lw + 6 * k_; const int g_ = g0_ < 16 ? g0_ : 15; { const int tt_ = 4 * g_ + rg; const f32x4 o_ = *(const LAS f32x4*)(OB_ + tt_ * 64 + j4); f32x4 y_; \
            if (!mixer) { const float mean_ = row16_sum((o_.x + o_.y) + (o_.z + o_.w)) * (1.f / 64.f); const f32x4 d_ = o_ - mean_; \
                const float var_ = row16_sum((d_.x * d_.x + d_.y * d_.y) + (d_.z * d_.z + d_.w * d_.w)) * (1.f / 64.f); y_ = d_ * rsq_fast(var_ + GN_EPS) * gA + gB + pbon[k_] * prv[k_]; } \
            else { const float ms_ = row16_sum((o_.x * o_.x + o_.y * o_.y) + (o_.z * o_.z + o_.w * o_.w)) * (1.f / 64.f); y_ = o_ * rsq_fast(ms_ + GDN_EPS) * gA; } \
            y_.x *= silu_fast(__uint_as_float(pz[k_].x << 16)); y_.y *= silu_fast(__uint_as_float(pz[k_].x & 0xffff0000u)); y_.z *= silu_fast(__uint_as_float(pz[k_].y << 16)); y_.w *= silu_fast(__uint_as_float(pz[k_].y & 0xffff0000u)); \
            u32x2 w_; w_.x = pk2(y_.x, y_.y); w_.y = pk2(y_.z, y_.w); if ((c_) >= 0) *(GAS u32x2*)(OCp + ((size_t)(c_) * 64 + tt_) * 1024) = w_; } } } while (0)
        CS_LD(RA, 0); CS_ST(RA, 0); CS_LD(RB, 1); CS_LD(RA, 2);
        CS_BAR();
        for (int c = 0; c < 64; c += 2) {
            PO_RUN(c - 1);
            PO_LOAD(c);
            CS_ST(RB, 1); CS_LD(RB, (c + 3 < 64 ? c + 3 : 63));
            CS_BAR();
            PO_RUN(c); PO_LOAD(c + 1);
            CS_ST(RA, 0);
            CS_LD(RA, (c + 4 < 64 ? c + 4 : 63));
            CS_BAR();
        }
        PO_RUN(63);
#undef PO_LOAD
#undef PO_RUN
#undef CS_LD
#undef CS_ST
        return;
    }
    const int r = lane & 31, hh = lane >> 5, ib = wave;
    f32x16 S0, S1;
#pragma unroll
    for (int i = 0; i < 16; ++i) { S0[i] = 0.f; S1[i] = 0.f; }
    CS_BAR();
    __builtin_amdgcn_s_waitcnt(0x0F70);
    for (int c = 0; c < 64; ++c) {
        const LAS unsigned char* pk = L + (c & 1) * CS_BUF;
        const LAS v4u* fWA = (const LAS v4u*)(pk) + lane; const LAS v4u* fRT = (const LAS v4u*)(pk + 8192) + lane; const LAS v4u* fARB = (const LAS v4u*)(pk + 2 * 8192) + lane; const LAS v4u* fBHT = (const LAS v4u*)(pk + 3 * 8192) + lane;
        const LAS v4u* iUV = (const LAS v4u*)(pk + 4 * 8192) + (ib * 4) * 64 + lane; const LAS v4u* iOV = (const LAS v4u*)(pk + 5 * 8192) + (ib * 4) * 64 + lane; const LAS v4u* iKTV = (const LAS v4u*)(pk + 6 * 8192) + (ib * 4) * 64 + lane;
        const LAS float* wc = (const LAS float*)(pk + 7 * 8192) + 4 * hh;
        f32x16 U0, U1, O0, O1, N0, N1;
#define SB_() __builtin_amdgcn_sched_barrier(0)
#define FRV(p_, f_) ((p_)[(f_) * 64])
#define BF_(v_) __builtin_bit_cast(bf16x8, (v_))
        const v4u rU0 = iUV[0], rU1 = iUV[64], rU2 = iUV[128], rU3 = iUV[192], rO0 = iOV[0], rO1 = iOV[64], rO2 = iOV[128], rO3 = iOV[192];
        v4u fa0 = FRV(fWA, 0), fa1 = FRV(fWA, 4), fa2 = FRV(fRT, 0), fa3 = FRV(fRT, 4), fa4 = FRV(fWA, 1), fa5 = FRV(fWA, 5), fa6 = FRV(fRT, 1), fa7 = FRV(fRT, 5);
        SB_();
        unpack8(U0, 0, rU0); unpack8(U0, 1, rU1); unpack8(U1, 0, rU2); unpack8(U1, 1, rU3);
        unpack8(O0, 0, rO0); unpack8(O0, 1, rO1); unpack8(O1, 0, rO2); unpack8(O1, 1, rO3);
        const bf16x8 sb0 = PACK8(S0, 0), sb1 = PACK8(S0, 1), sb2 = PACK8(S1, 0), sb3 = PACK8(S1, 1);
        SB_();
        v4u fb0 = FRV(fWA, 2), fb1 = FRV(fWA, 6), fb2 = FRV(fRT, 2), fb3 = FRV(fRT, 6), fb4 = FRV(fWA, 3), fb5 = FRV(fWA, 7), fb6 = FRV(fRT, 3), fb7 = FRV(fRT, 7);
        const v4u rN0 = iKTV[0], rN1 = iKTV[64], rN2 = iKTV[128], rN3 = iKTV[192];
        f32x4 w0[4], w1[4];
#pragma unroll
        for (int q = 0; q < 4; ++q) { w0[q] = *(const LAS f32x4*)(wc + 8 * q); w1[q] = *(const LAS f32x4*)(wc + 32 + 8 * q); }
        SB_();
        U0 = MFMA32(BF_(fa0), sb0, U0); U1 = MFMA32(BF_(fa1), sb0, U1); O0 = MFMA32(BF_(fa2), sb0, O0); O1 = MFMA32(BF_(fa3), sb0, O1);
        U0 = MFMA32(BF_(fa4), sb1, U0); U1 = MFMA32(BF_(fa5), sb1, U1); O0 = MFMA32(BF_(fa6), sb1, O0); O1 = MFMA32(BF_(fa7), sb1, O1);
        SB_();
        unpack8(N0, 0, rN0); unpack8(N0, 1, rN1); unpack8(N1, 0, rN2); unpack8(N1, 1, rN3);
#pragma unroll
        for (int q = 0; q < 4; ++q) {
            N0[4 * q] += w0[q].x * S0[4 * q]; N0[4 * q + 1] += w0[q].y * S0[4 * q + 1]; N0[4 * q + 2] += w0[q].z * S0[4 * q + 2]; N0[4 * q + 3] += w0[q].w * S0[4 * q + 3];
            N1[4 * q] += w1[q].x * S1[4 * q]; N1[4 * q + 1] += w1[q].y * S1[4 * q + 1]; N1[4 * q + 2] += w1[q].z * S1[4 * q + 2]; N1[4 * q + 3] += w1[q].w * S1[4 * q + 3]; }
        SB_();
        fa0 = FRV(fARB, 0); fa1 = FRV(fARB, 4); fa2 = FRV(fBHT, 0); fa3 = FRV(fBHT, 4); fa4 = FRV(fARB, 1); fa5 = FRV(fARB, 5); fa6 = FRV(fBHT, 1); fa7 = FRV(fBHT, 5);
        SB_();
        U0 = MFMA32(BF_(fb0), sb2, U0); U1 = MFMA32(BF_(fb1), sb2, U1); O0 = MFMA32(BF_(fb2), sb2, O0); O1 = MFMA32(BF_(fb3), sb2, O1);
        U0 = MFMA32(BF_(fb4), sb3, U0); U1 = MFMA32(BF_(fb5), sb3, U1); O0 = MFMA32(BF_(fb6), sb3, O0); O1 = MFMA32(BF_(fb7), sb3, O1);
        SB_();
        fb0 = FRV(fARB, 6); fb1 = FRV(fBHT, 2); fb2 = FRV(fBHT, 6); fb3 = FRV(fARB, 7); fb4 = FRV(fBHT, 3); fb5 = FRV(fBHT, 7);
        const bf16x8 ub0 = PACK8(U0, 0), ub1 = PACK8(U0, 1), ub2 = PACK8(U1, 0), ub3 = PACK8(U1, 1);
        SB_();
        O0 = MFMA32(BF_(fa0), ub0, O0); O1 = MFMA32(BF_(fa1), ub0, O1); N0 = MFMA32(BF_(fa2), ub0, N0); N1 = MFMA32(BF_(fa3), ub0, N1);
        O0 = MFMA32(BF_(fa4), ub1, O0); O1 = MFMA32(BF_(fa5), ub1, O1); N0 = MFMA32(BF_(fa6), ub1, N0); N1 = MFMA32(BF_(fa7), ub1, N1);
        O1 = MFMA32(BF_(fb0), ub2, O1); N0 = MFMA32(BF_(fb1), ub2, N0); N1 = MFMA32(BF_(fb2), ub2, N1);
        O1 = MFMA32(BF_(fb3), ub3, O1); N0 = MFMA32(BF_(fb4), ub3, N0); N1 = MFMA32(BF_(fb5), ub3, N1);
        SB_();
#undef SB_
#undef FRV
#undef BF_
        LAS float* Oc = (LAS float*)(L + 2 * CS_BUF + (c & 1) * 16384) + 32 * ib + r;
#pragma unroll
        for (int i = 0; i < 16; ++i) { Oc[crow16(i, hh) * 64] = O0[i]; Oc[(32 + crow16(i, hh)) * 64] = O1[i]; }
        S0 = N0; S1 = N1;
        CS_BAR();
    }
    float* so = a.out + (mixer ? O_GDP : O_RWP) + ((size_t)(l * NB + b) * 4 + h) * 4096;
    const int i_ = 32 * ib + r;
#pragma unroll
    for (int q = 0; q < 16; ++q) { const int k0 = crow16(q, hh), k1 = 32 + k0;
        if (mixer) { so[k0 * 64 + i_] = S0[q]; so[k1 * 64 + i_] = S1[q]; } else { so[i_ * 64 + k0] = S0[q]; so[i_ * 64 + k1] = S1[q]; } }
}

__device__ __forceinline__ int win_src_col(int n) {
    if (n < 2688) return n;
    if (n < 3968) return n + 8;
    if (n < 4224) return n + 16;
    if (n < 4232) return 2688 + (n - 4224);
    if (n < 4236) return 3976 + (n - 4232);
    if (n < 4240) return 3980 + (n - 4236);
    return -1;
}
__device__ __forceinline__ void transpose_item(const float* W, int Nsrc, bf16* WT, LAS float* scr, int kb, int nb, int lane, bool is_win) {
    const int k0 = 64 * kb, n0 = 32 * nb;
    const int n = n0 + (lane & 31); const int sc = is_win ? win_src_col(n) : n;
    float wv_[32];
#pragma unroll
    for (int i = 0; i < 32; ++i) { const int kk = 2 * i + (lane >> 5); wv_[i] = (sc >= 0) ? W[(size_t)(k0 + kk) * Nsrc + sc] : 0.f; }
#pragma unroll
    for (int i = 0; i < 32; ++i) { const int kk = 2 * i + (lane >> 5); scr[kk * 33 + (lane & 31)] = wv_[i]; }
    LDS_WAIT(); asm volatile("" ::: "memory");
    const int c = lane & 7;
#pragma unroll
    for (int j = 0; j < 4; ++j) { const int nn = (lane >> 3) + 8 * j; const LAS float* s = scr + (8 * c) * 33 + nn;
        v4u o; o.x = pk2(s[0 * 33], s[1 * 33]); o.y = pk2(s[2 * 33], s[3 * 33]); o.z = pk2(s[4 * 33], s[5 * 33]); o.w = pk2(s[6 * 33], s[7 * 33]);
        *(v4u*)(WT + (size_t)(n0 + nn) * 1024 + k0 + 8 * c) = o; }
    LDS_WAIT(); asm volatile("" ::: "memory");
}
__device__ __forceinline__ void phase_prologue(const Args& a, LAS unsigned char* ldsb, int vcu, int G, int tid) {
    const int lane = tid & 63, wave = tid >> 6;
    LAS float* scr = (LAS float*)(ldsb + wave * 16384);
    const int gw = vcu * NWAVES + wave, NGW = G * NWAVES;
    bf16* WinT = (bf16*)(a.ws + WS_WIN); bf16* WoutT = (bf16*)(a.ws + WS_WOUT);
    constexpr int NB_IN = NPJ / 32, I_IN = 16 * NB_IN, I_OUT = 16 * 32, I_L = I_IN + I_OUT;
    for (int it = gw; it < NLAYER * I_L; it += NGW) {
        const int l = it / I_L; int r = it - l * I_L;
        if (r < I_IN) transpose_item(a.in[11] + (size_t)l * 1024 * NIN, NIN, WinT + (size_t)l * NPJ * 1024, scr, r / NB_IN, r % NB_IN, lane, true);
        else { r -= I_IN; transpose_item(a.in[27] + (size_t)l * 1024 * 1024, 1024, WoutT + (size_t)l * 1024 * 1024, scr, r / 32, r % 32, lane, false); }
    }
    { bf16* W2T = (bf16*)(a.ws + WS_W2T); bf16* A2T = (bf16*)(a.ws + WS_A2T);
      for (int idx = vcu * NTHREADS + tid; idx < NLAYER * 256 * 64; idx += G * NTHREADS) { const int l = idx >> 14, c = (idx >> 6) & 255, j = idx & 63;
          W2T[idx] = (bf16)f2bf(a.in[14][((size_t)l * 64 + j) * 256 + c]); A2T[idx] = (bf16)f2bf(a.in[16][((size_t)l * 64 + j) * 256 + c]); } }
    bf16* XB = (bf16*)(a.ws + WS_XB);
    { const GAS f32x4* g4 = (const GAS f32x4*)a.in[9] + lane; const GAS f32x4* b4 = (const GAS f32x4*)a.in[10] + lane; GAS float* XF = (GAS float*)a.out; GAS bf16* XBg = (GAS bf16*)XB;
      for (int m0 = gw * 2; m0 < MROWS; m0 += NGW * 2) {
        f32x4 v[2][4]; float sm[2];
#pragma unroll
        for (int rr = 0; rr < 2; ++rr) { const int m = m0 + rr; const GAS f32x4* xr = (const GAS f32x4*)((m < MP) ? a.in[0] + (size_t)m * 1024 : a.in[1] + (size_t)(m - MP) * 1024) + lane; sm[rr] = 0.f;
#pragma unroll
            for (int q = 0; q < 4; ++q) { v[rr][q] = xr[64 * q]; sm[rr] += (v[rr][q].x + v[rr][q].y) + (v[rr][q].z + v[rr][q].w); } }
        float mean[2], rstd[2];
#pragma unroll
        for (int rr = 0; rr < 2; ++rr) mean[rr] = wave_sum_dpp(sm[rr]) * (1.f / 1024.f);
#pragma unroll
        for (int rr = 0; rr < 2; ++rr) { float s2 = 0.f;
#pragma unroll
            for (int q = 0; q < 4; ++q) { v[rr][q] = v[rr][q] - mean[rr]; s2 += (v[rr][q].x * v[rr][q].x + v[rr][q].y * v[rr][q].y) + (v[rr][q].z * v[rr][q].z + v[rr][q].w * v[rr][q].w); }
            rstd[rr] = 1.f / sqrtf(wave_sum_dpp(s2) * (1.f / 1024.f) + LN_EPS); }
#pragma unroll
        for (int q = 0; q < 4; ++q) { const f32x4 gg = g4[64 * q], bb = b4[64 * q];
#pragma unroll
            for (int rr = 0; rr < 2; ++rr) { const f32x4 o = v[rr][q] * rstd[rr] * gg + bb;
                ((GAS unsigned long long*)(XBg + (size_t)(m0 + rr) * 1024))[lane + 64 * q] = (unsigned long long)pk2(o.x, o.y) | ((unsigned long long)pk2(o.z, o.w) << 32); } }
      } }
}

struct Arr6 { float* p[6]; };
__device__ __forceinline__ Arr6 arr6(unsigned char* ws, size_t base) { Arr6 r;
#pragma unroll
    for (int i = 0; i < 6; ++i) r.p[i] = (float*)(ws + base + (size_t)i * ARR_STRIDE); return r; }

__device__ __forceinline__ void rwkv_prep_tile(const Args& a, int l, int tile, LAS float* XS, int tid) {
    const GAS bf16* P = (const GAS bf16*)(a.ws + WS_PROJ);
    const int m0 = tile * 8; const bool samp = m0 >= MP;
    const int t0 = samp ? ((m0 - MP) & 15) : (m0 & 4095); const int bidx = samp ? ((m0 - MP) >> 4) : (m0 >> 12);
    const GAS float* mu = (const GAS float*)a.in[12] + l * NSHIFT; const GAS float* shst = (const GAS float*)a.in[5] + ((size_t)l * SBATCH + (samp ? bidx : 0)) * NSHIFT;
    for (int idx = tid; idx < 8 * NSHIFT; idx += NTHREADS) {
        const int tok = idx / NSHIFT, c = idx - tok * NSHIFT;
        const float p = bf2f(P[(size_t)(m0 + tok) * NPJ + c]);
        const bool hasp = (t0 + tok > 0); const float pv = bf2f(P[(size_t)(m0 + tok - (hasp ? 1 : 0)) * NPJ + c]); const float sv = shst[c];
        const float prev = hasp ? pv : (samp ? sv : 0.f);
        float xs = p + (prev - p) * mu[c];
        if (c >= 768 && c < 832) xs = tanhf(xs);
        XS[tok * NSHIFT + c] = xs;
    }
    __syncthreads();
    const int g = tid >> 8, c = tid & 255, lane = tid & 63, h = c >> 6;
    float accw[4], acca[4];
    { const float w0v = ((const GAS float*)a.in[13])[l * 256 + c], a0v = ((const GAS float*)a.in[15])[l * 256 + c];
#pragma unroll
      for (int k = 0; k < 4; ++k) { accw[k] = w0v; acca[k] = a0v; } }
    const GAS float* w2 = (const GAS float*)a.in[14] + (size_t)l * 64 * 256 + c; const GAS float* a2 = (const GAS float*)a.in[16] + (size_t)l * 64 * 256 + c;
    const LAS float* xg = XS + (g * 4) * NSHIFT;
#pragma unroll 4
    for (int j = 0; j < 64; ++j) { const float wv = w2[j * 256], av = a2[j * 256];
#pragma unroll
        for (int k = 0; k < 4; ++k) { accw[k] += xg[k * NSHIFT + 768 + j] * wv; acca[k] += xg[k * NSHIFT + 832 + j] * av; } }
    const float kkc = ((const GAS float*)a.in[17])[l * 256 + c], kac = ((const GAS float*)a.in[18])[l * 256 + c], rkc = ((const GAS float*)a.in[19])[l * 256 + c];
    Arr6 R = arr6(a.ws, WS_RARR); float* BON = (float*)(a.ws + WS_BONUS);
#pragma unroll
    for (int k = 0; k < 4; ++k) { const int m = m0 + g * 4 + k; const size_t o = (size_t)m * 256 + c;
        const float r = xg[k * NSHIFT + c], kx = xg[k * NSHIFT + 256 + c], v = xg[k * NSHIFT + 512 + c];
        const float dec = __expf(-0.6065306597126334f * sigmoid_f(accw[k]));
        const float aa = sigmoid_f(acca[k]);
        const float kkr = kx * kkc; const float ss = wave_sum(kkr * kkr); const float kkn = kkr * __builtin_amdgcn_rcpf(fmaxf(__builtin_amdgcn_sqrtf(ss), 1e-12f));
        const float kmod = kx * (1.f + (aa - 1.f) * kac);
        const float bon = wave_sum(r * kmod * rkc);
        R.p[0][o] = dec; R.p[1][o] = kkn; R.p[2][o] = -kkn * aa; R.p[3][o] = kmod; R.p[4][o] = r; R.p[5][o] = v;
        if (lane == 0) BON[m * 4 + h] = bon; }
    __syncthreads();
}
__device__ __forceinline__ void gdn_prep_tile(const Args& a, int l, int tile, int tid) {
    const GAS bf16* P = (const GAS bf16*)(a.ws + WS_PROJ); const GAS float* SM = (const GAS float*)(a.ws + WS_SMALL);
    const int m0 = tile * 8; const bool samp = m0 >= MP;
    const int t0 = samp ? ((m0 - MP) & 15) : (m0 & 4095); const int bidx = samp ? ((m0 - MP) >> 4) : (m0 >> 12);
    const int g = tid >> 8, c = tid & 255, lane = tid & 63, h = c >> 6;
    const GAS float* cw = (const GAS float*)a.in[23] + (size_t)l * 4 * NCONV; const GAS float* cst = (const GAS float*)a.in[7] + ((size_t)l * SBATCH + (samp ? bidx : 0)) * 3 * NCONV;
    float xr[7][3], cwv[4][3];
#pragma unroll
    for (int i = 0; i < 7; ++i) { const int tt = t0 + g * 4 - 3 + i;
#pragma unroll
        for (int x = 0; x < 3; ++x) { const int col = x * 256 + c;
            const float pv = bf2f(P[(size_t)(m0 - t0 + (tt < 0 ? 0 : tt)) * NPJ + C_CQKV + col]); const float cv = cst[(tt < 0 ? 3 + tt : 0) * NCONV + col];
            xr[i][x] = tt >= 0 ? pv : (samp ? cv : 0.f); } }
#pragma unroll
    for (int i = 0; i < 4; ++i)
#pragma unroll
        for (int x = 0; x < 3; ++x) cwv[i][x] = cw[i * NCONV + x * 256 + c];
    const float alog = ((const GAS float*)a.in[24])[l * 4 + h], dtb = ((const GAS float*)a.in[25])[l * 4 + h];
    Arr6 Gm = arr6(a.ws, WS_GARR);
#pragma unroll
    for (int k = 0; k < 4; ++k) { const int m = m0 + g * 4 + k; const size_t o = (size_t)m * 256 + c;
        float y[3];
#pragma unroll
        for (int x = 0; x < 3; ++x) { float s = 0.f;
#pragma unroll
            for (int i = 0; i < 4; ++i) s += cwv[i][x] * xr[k + i][x];
            y[x] = silu_f(s); }
        const float qs = wave_sum(y[0] * y[0]), ks = wave_sum(y[1] * y[1]);
        const float qn = y[0] * __builtin_amdgcn_rsqf(qs + L2_EPS) * 0.125f, kn = y[1] * __builtin_amdgcn_rsqf(ks + L2_EPS);
        const float beta = sigmoid_f(SM[(size_t)m * 16 + 8 + h]);
        const float gg = -__expf(alog) * softplus_f(SM[(size_t)m * 16 + 12 + h] + dtb); const float eg = __expf(gg);
        Gm.p[0][o] = eg; Gm.p[1][o] = kn; Gm.p[2][o] = -eg * beta * kn; Gm.p[3][o] = beta * kn; Gm.p[4][o] = qn; Gm.p[5][o] = y[2]; }
}
__device__ __forceinline__ void fox_cum_prompt(const Args& a, int l, int b, LAS float* SEG, int tid) {
    const GAS float* SM = (const GAS float*)(a.ws + WS_SMALL); const int h = tid & 7, seg = tid >> 3; const float bfv = a.in[22][l * 8 + h];
    GAS float* lfo = (GAS float*)a.out + O_FLP + ((size_t)(l * NB + b) * TSEQ) * 8;
    float sum = 0.f;
#pragma unroll 1
    for (int g = 0; g < 4; ++g) { float lf[16];
#pragma unroll
        for (int i = 0; i < 16; ++i) lf[i] = SM[((size_t)b * TSEQ + seg * 64 + g * 16 + i) * 16 + h];
#pragma unroll
        for (int i = 0; i < 16; ++i) { const float v = logsigmoid_f(lf[i] + bfv); lfo[(seg * 64 + g * 16 + i) * 8 + h] = v; sum += v; } }
    SEG[seg * 8 + h] = sum; __syncthreads();
    float c = 0.f; for (int s = 0; s < seg; ++s) c += SEG[s * 8 + h];
    GAS float* CB = (GAS float*)(a.ws + WS_CB) + (size_t)(b * 8 + h) * TSEQ;
#pragma unroll 1
    for (int g = 0; g < 4; ++g) { float lf[16];
#pragma unroll
        for (int i = 0; i < 16; ++i) lf[i] = SM[((size_t)b * TSEQ + seg * 64 + g * 16 + i) * 16 + h];
#pragma unroll
        for (int i = 0; i < 16; ++i) { c += logsigmoid_f(lf[i] + bfv); CB[seg * 64 + g * 16 + i] = c * LOG2E; } }
    __syncthreads();
}
__device__ __forceinline__ void fox_cum_sample(const Args& a, int l, int b, LAS float* SEG, int tid) {
    const GAS float* SM = (const GAS float*)(a.ws + WS_SMALL); const int h = tid & 7, seg = tid >> 3; const float bfv = a.in[22][l * 8 + h];
    const GAS float* clf = (const GAS float*)a.in[4] + ((size_t)(l * SBATCH + b) * PAST) * 8;
    float lf[32]; float sum = 0.f;
#pragma unroll
    for (int i = 0; i < 32; ++i) { lf[i] = clf[(seg * 32 + i) * 8 + h]; }
#pragma unroll
    for (int i = 0; i < 32; ++i) sum += lf[i];
    SEG[seg * 8 + h] = sum; __syncthreads();
    float post = 0.f; for (int s = seg + 1; s < 64; ++s) post += SEG[s * 8 + h];
    GAS float* CBS = (GAS float*)(a.ws + WS_CBS) + (size_t)(b * 8 + h) * 2064;
#pragma unroll
    for (int i = 31; i >= 0; --i) { CBS[seg * 32 + i] = post * LOG2E; post += lf[i]; }
    if (seg == 0) { float run = 0.f; GAS float* lfo = (GAS float*)a.out + O_FLS + ((size_t)(l * SBATCH + b) * STOK) * 8; float ln[STOK];
#pragma unroll
        for (int i = 0; i < STOK; ++i) ln[i] = SM[((size_t)MP + b * STOK + i) * 16 + h];
#pragma unroll
        for (int i = 0; i < STOK; ++i) { const float v = logsigmoid_f(ln[i] + bfv); lfo[i * 8 + h] = v; run += v; CBS[PAST + i] = -run * LOG2E; } }
    __syncthreads();
}
__device__ __forceinline__ void phase_prep(const Args& a, int l, LAS unsigned char* ldsb, int vcu, int G, int tid) {
    LAS float* XS = (LAS float*)ldsb; const int wvp = __builtin_amdgcn_readfirstlane(tid >> 6);
    { const int sub = vcu & 7, mixer = sub >> 2, h = sub & 3;
      if (mixer == 0) chunk_pipeline_rwkv(a, l, vcu, h, ldsb, tid); else chunk_pipeline_gdn(a, l, vcu, h, ldsb, tid); }
    { int wv_ = wvp; unsigned zz_ = 0u; asm volatile("" : "+s"(wv_), "+s"(zz_)); tid = (wv_ << 6) | (int)__builtin_amdgcn_mbcnt_hi(~0u, __builtin_amdgcn_mbcnt_lo(~0u, zz_)); asm volatile("" : "+v"(tid)); }
    for (int ht = vcu; ht < 2 * (MS / 8); ht += G) { const int tile = MP / 8 + (ht >> 1); if (ht & 1) gdn_prep_tile(a, l, tile, tid); else rwkv_prep_tile(a, l, tile, XS, tid); }
    LAS float* SEG = (LAS float*)(ldsb + 32768);
    for (int u = vcu - 128; u >= 0 && u < NB + SBATCH; u += G) { if (u < NB) fox_cum_prompt(a, l, u, SEG, tid); else fox_cum_sample(a, l, u - NB, SEG, tid); }
    const bf16* P = (const bf16*)(a.ws + WS_PROJ);
    for (int idx = vcu * NTHREADS + tid; idx < (NB + SBATCH) * 3200; idx += G * NTHREADS) {
        const int seq = idx / 3200, r = idx - seq * 3200; const bool pr = seq < NB; const int b = pr ? seq : seq - NB;
        const size_t last = pr ? (size_t)b * TSEQ + (TSEQ - 1) : (size_t)MP + b * STOK + (STOK - 1);
        if (r < NSHIFT) { const float v = bf2f(P[last * NPJ + r]); a.out[(pr ? O_SHP + (size_t)(l * NB + b) * NSHIFT : O_SHS + (size_t)(l * SBATCH + b) * NSHIFT) + r] = v; }
        else { const int r2 = r - NSHIFT, i = r2 / NCONV, c = r2 - i * NCONV; const float v = bf2f(P[(last - 2 + i) * NPJ + C_CQKV + c]);
            a.out[(pr ? O_CVP + (size_t)(l * NB + b) * 3 * NCONV : O_CVS + (size_t)(l * SBATCH + b) * 3 * NCONV) + i * NCONV + c] = v; }
    }
}
constexpr int SC_TS = 32, SC_BUF = SC_TS * 5 * 64 * 4, SC_VS_OFF = 2 * SC_BUF, SC_VS = SC_TS * 32 * 4, SC_OS_OFF = SC_VS_OFF + 2 * SC_VS, SC_END = SC_OS_OFF + 2 * SC_VS;
static_assert(SC_END <= PH_SCRATCH, "scan LDS");
__device__ __forceinline__ void scan_unit(LAS unsigned char* ldsb, const Arr6& X, float* O, int rowbase, int nsteps, int h, int half,
                                          const float* s_init, float* s_out, bool transposed, int tid) {
    const int lane = tid & 63, wave = tid >> 6, j = lane & 15, rg = lane >> 4, row = 32 * half + 4 * wave + rg;
    f32x4 s = (f32x4){0.f, 0.f, 0.f, 0.f};
    if (s_init) { if (!transposed) s = *(const f32x4*)(s_init + row * 64 + 4 * j);
                  else { s.x = s_init[(4 * j + 0) * 64 + row]; s.y = s_init[(4 * j + 1) * 64 + row]; s.z = s_init[(4 * j + 2) * 64 + row]; s.w = s_init[(4 * j + 3) * 64 + row]; } }
    const int lt = tid >> 4, lq = tid & 15;
    const int colw = h * 64 + lq * 4, colv = h * 64 + 32 * half + lq * 2;
    const int nchunks = (nsteps + SC_TS - 1) / SC_TS;
    f32x4 ld[5]; f32x2 lv;
#define SC_GLOAD(c_) do { const int t_ = (c_) * SC_TS + lt; if (t_ < nsteps) { const size_t ro_ = (size_t)(rowbase + t_) * 256; \
        _Pragma("unroll") for (int q_ = 0; q_ < 5; ++q_) ld[q_] = *(const f32x4*)(X.p[q_] + ro_ + colw); lv = *(const f32x2*)(X.p[5] + ro_ + colv); } \
        else { _Pragma("unroll") for (int q_ = 0; q_ < 5; ++q_) ld[q_] = (f32x4){0.f, 0.f, 0.f, 0.f}; lv = (f32x2){0.f, 0.f}; } } while (0)
#define SC_LSTORE(b_) do { LAS float* B_ = (LAS float*)(ldsb + (b_) * SC_BUF); \
        _Pragma("unroll") for (int q_ = 0; q_ < 5; ++q_) *(LAS f32x4*)(B_ + (lt * 5 + q_) * 64 + lq * 4) = ld[q_]; \
        *(LAS f32x2*)((LAS float*)(ldsb + SC_VS_OFF + (b_) * SC_VS) + lt * 32 + lq * 2) = lv; } while (0)
    SC_GLOAD(0); SC_LSTORE(0); __syncthreads();
    for (int c = 0; c < nchunks; ++c) {
        const int b = c & 1;
        if (c + 1 < nchunks) SC_GLOAD(c + 1);
        const int steps = (nsteps - c * SC_TS) < SC_TS ? (nsteps - c * SC_TS) : SC_TS;
        const LAS float* Bf = (const LAS float*)(ldsb + b * SC_BUF) + 4 * j;
        const LAS float* VSb = (const LAS float*)(ldsb + SC_VS_OFF + b * SC_VS) + 4 * wave + rg;
        LAS float* OSb = (LAS float*)(ldsb + SC_OS_OFF + b * SC_VS);
#pragma unroll 4
        for (int tt = 0; tt < steps; ++tt) {
            const f32x4 W4 = *(const LAS f32x4*)(Bf + (tt * 5 + 0) * 64), A4 = *(const LAS f32x4*)(Bf + (tt * 5 + 1) * 64), B4 = *(const LAS f32x4*)(Bf + (tt * 5 + 2) * 64),
                        K4 = *(const LAS f32x4*)(Bf + (tt * 5 + 3) * 64), R4 = *(const LAS f32x4*)(Bf + (tt * 5 + 4) * 64);
            const float v = VSb[tt * 32];
            float d = (s.x * A4.x + s.y * A4.y) + (s.z * A4.z + s.w * A4.w); d = row16_sum(d);
            s = s * W4 + d * B4 + v * K4;
            float o = (s.x * R4.x + s.y * R4.y) + (s.z * R4.z + s.w * R4.w); o = row16_sum(o);
            if (j == 0) OSb[tt * 32 + 4 * wave + rg] = o;
        }
        if (c + 1 < nchunks) SC_LSTORE(b ^ 1);
        __syncthreads();
        { const int t_ = c * SC_TS + lt; if (t_ < nsteps) *(f32x2*)(O + (size_t)(rowbase + t_) * 256 + colv) = *(const LAS f32x2*)(OSb + lt * 32 + lq * 2); }
    }
#undef SC_GLOAD
#undef SC_LSTORE
    if (!transposed) *(f32x4*)(s_out + row * 64 + 4 * j) = s;
    else { s_out[(4 * j + 0) * 64 + row] = s.x; s_out[(4 * j + 1) * 64 + row] = s.y; s_out[(4 * j + 2) * 64 + row] = s.z; s_out[(4 * j + 3) * 64 + row] = s.w; }
    __syncthreads();
}
__device__ __forceinline__ void scan_sample_unit(const Args& a, int l, int u, LAS unsigned char* ldsb, int tid) {
    const int mixer = u >> 8, bh = (u & 255) >> 1, half = u & 1, b = bh >> 2, h = bh & 3;
    const Arr6 X = arr6(a.ws, mixer ? WS_GARR : WS_RARR); float* O = (float*)(a.ws + (mixer ? WS_OG : WS_OA));
    const size_t so_ = ((size_t)(l * SBATCH + b) * 4 + h) * 4096;
    scan_unit(ldsb, X, O, MP + b * STOK, STOK, h, half, a.in[mixer ? 8 : 6] + so_, a.out + (mixer ? O_GDS : O_RWS) + so_, mixer != 0, tid);
}

__device__ __forceinline__ void fox_sample_unit(const Args& a, int l, int bh, LAS unsigned char* ldsb, int tid) {
    const int b = bh >> 3, h = bh & 7, lane = tid & 63, wave = __builtin_amdgcn_readfirstlane(tid >> 6), r = lane & 31, hh = lane >> 5;
    const GAS bf16* P = (const GAS bf16*)(a.ws + WS_PROJ); const int m0 = MP + b * STOK;
    LAS float* PM = (LAS float*)ldsb; LAS float* PL = PM + 128; LAS float* PO = PM + 256;
    LAS float* BL = (LAS float*)(ldsb + 36864); LAS float* WSF = (LAS float*)(ldsb + 49152) + wave * 64;
    { const GAS float* cbs = (const GAS float*)(a.ws + WS_CBS) + (size_t)bh * 2064;
      for (int i = tid; i < 2080; i += NTHREADS) BL[i] = (i < 2064) ? cbs[i] : 0.f; }
    bf16x8 qf[4];
#pragma unroll
    for (int s_ = 0; s_ < 4; ++s_) { qf[s_] = (bf16x8){0, 0, 0, 0, 0, 0, 0, 0}; if (r < 16) qf[s_] = *(const GAS bf16x8*)(P + (size_t)(m0 + r) * NPJ + C_Q + h * 64 + 16 * s_ + 8 * hh); }
    __syncthreads();
    const GAS float* Kc = (const GAS float*)a.in[2] + ((size_t)(l * SBATCH + b) * PAST * 8 + h) * 64; const GAS float* Vc = (const GAS float*)a.in[3] + ((size_t)(l * SBATCH + b) * PAST * 8 + h) * 64;
    const GAS float* Kn = (const GAS float*)a.out + O_FKS + ((size_t)(l * SBATCH + b) * STOK * 8 + h) * 64; const GAS float* Vn = (const GAS float*)a.out + O_FVS + ((size_t)(l * SBATCH + b) * STOK * 8 + h) * 64;
    f32x4 kr[8]; float vr[32];
#define FS_LOADT(t_) do { const bool nw_ = (t_) == 64; const GAS float* kb_ = nw_ ? Kn : Kc + (size_t)(t_) * 32 * 512; const GAS float* vb_ = nw_ ? Vn : Vc + (size_t)(t_) * 32 * 512; const int lim_ = nw_ ? 15 : 31; \
        const GAS float* kp_ = kb_ + (size_t)(r < lim_ ? r : lim_) * 512 + 8 * hh; \
        _Pragma("unroll") for (int s_ = 0; s_ < 4; ++s_) { kr[2 * s_] = *(const GAS f32x4*)(kp_ + 16 * s_); kr[2 * s_ + 1] = *(const GAS f32x4*)(kp_ + 16 * s_ + 4); } \
        _Pragma("unroll") for (int f_ = 0; f_ < 4; ++f_) _Pragma("unroll") for (int e_ = 0; e_ < 8; ++e_) { int ke_ = 16 * (f_ & 1) + 8 * (e_ >> 2) + 4 * hh + (e_ & 3); ke_ = ke_ < lim_ ? ke_ : lim_; \
            vr[f_ * 8 + e_] = vb_[(size_t)ke_ * 512 + 32 * (f_ >> 1) + r]; } } while (0)
    const int tstart = (wave == 0) ? 64 : 56 + wave;
    FS_LOADT(tstart);
    float mref = -1e30f, lsum = 0.f; f32x16 O0, O1;
#pragma unroll
    for (int i = 0; i < 16; ++i) { O0[i] = 0.f; O1[i] = 0.f; }
    for (int t = tstart; t >= 0; t -= 8) {
        bf16x8 kf[4], vf[4];
#pragma unroll
        for (int s_ = 0; s_ < 4; ++s_) kf[s_] = pack8v(kr[2 * s_].x, kr[2 * s_].y, kr[2 * s_].z, kr[2 * s_].w, kr[2 * s_ + 1].x, kr[2 * s_ + 1].y, kr[2 * s_ + 1].z, kr[2 * s_ + 1].w);
#pragma unroll
        for (int f_ = 0; f_ < 4; ++f_) vf[f_] = pack8v(vr[8 * f_], vr[8 * f_ + 1], vr[8 * f_ + 2], vr[8 * f_ + 3], vr[8 * f_ + 4], vr[8 * f_ + 5], vr[8 * f_ + 6], vr[8 * f_ + 7]);
        if (t >= 8) FS_LOADT(t - 8);
        f32x16 S;
#pragma unroll
        for (int i = 0; i < 16; ++i) S[i] = 0.f;
#pragma unroll
        for (int s_ = 0; s_ < 4; ++s_) S = MFMA32(kf[s_], qf[s_], S);
#pragma unroll
        for (int g = 0; g < 4; ++g) { const f32x4 b4 = *(const LAS f32x4*)(BL + 32 * t + 8 * g + 4 * hh); S[4 * g] += b4.x; S[4 * g + 1] += b4.y; S[4 * g + 2] += b4.z; S[4 * g + 3] += b4.w; }
        if (t == 64) {
#pragma unroll
            for (int i = 0; i < 16; ++i) { const int kn = crow16(i, hh); if (kn > r || kn >= STOK) S[i] = -INFINITY; } }
        float mt = S[0];
#pragma unroll
        for (int i = 1; i < 16; ++i) mt = fmaxf(mt, S[i]);
        { auto rr = __builtin_amdgcn_permlane32_swap(__float_as_uint(mt), __float_as_uint(mt), false, false); mt = fmaxf(__uint_as_float(rr[0]), __uint_as_float(rr[1])); }
        if (__any(mt > mref + 8.f)) {
            const float nref = fmaxf(mref, mt); const float f = __builtin_amdgcn_exp2f(mref - nref); mref = nref; lsum *= f;
            if (hh == 0) WSF[r] = f;
            asm volatile("s_waitcnt lgkmcnt(0)" ::: "memory");
#pragma unroll
            for (int i = 0; i < 16; ++i) { const float fr = WSF[crow16(i, hh)]; O0[i] *= fr; O1[i] *= fr; }
            asm volatile("s_waitcnt lgkmcnt(0)" ::: "memory");
        }
#pragma unroll
        for (int i = 0; i < 16; ++i) { S[i] = __builtin_amdgcn_exp2f(S[i] - mref); lsum += S[i]; }
        const bf16x8 pf0 = PACK8(S, 0), pf1 = PACK8(S, 1);
        O0 = MFMA32(pf0, vf[0], O0); O0 = MFMA32(pf1, vf[1], O0); O1 = MFMA32(pf0, vf[2], O1); O1 = MFMA32(pf1, vf[3], O1);
    }
#undef FS_LOADT
    { auto rr = __builtin_amdgcn_permlane32_swap(__float_as_uint(lsum), __float_as_uint(lsum), false, false); lsum = __uint_as_float(rr[0]) + __uint_as_float(rr[1]); }
    if (lane < 16) { PM[wave * 16 + lane] = mref; PL[wave * 16 + lane] = lsum; }
#pragma unroll
    for (int i = 0; i < 8; ++i) { const int q = crow16(i, hh); PO[(wave * 16 + q) * 64 + r] = O0[i]; PO[(wave * 16 + q) * 64 + 32 + r] = O1[i]; }
    __syncthreads();
    { const int q = tid >> 5, d = (tid & 31) * 2;
      float M_ = PM[q];
#pragma unroll
      for (int w = 1; w < 8; ++w) M_ = fmaxf(M_, PM[w * 16 + q]);
      float L_ = 0.f, o0 = 0.f, o1 = 0.f;
#pragma unroll
      for (int w = 0; w < 8; ++w) { const float e = __builtin_amdgcn_exp2f(PM[w * 16 + q] - M_); L_ += PL[w * 16 + q] * e; o0 += PO[(w * 16 + q) * 64 + d] * e; o1 += PO[(w * 16 + q) * 64 + d + 1] * e; }
      const unsigned zz = *(const unsigned*)(P + (size_t)(m0 + q) * NPJ + C_BZ + h * 64 + d);
      const float z0 = __uint_as_float(zz << 16), z1 = __uint_as_float(zz & 0xffff0000u);
      const float r = 1.f / L_;
      bf16* OC = (bf16*)(a.ws + WS_OC);
      *(unsigned*)(OC + (size_t)(m0 + q) * 1024 + 256 + h * 64 + d) = pk2(o0 * r * silu_f(z0), o1 * r * silu_f(z1)); }
    __syncthreads();
}

__device__ __forceinline__ void phase2_queue(const Args& a, int l, const attn_body::AttnTensors& T, LAS unsigned char* ldsb, unsigned* ctr, volatile LAS unsigned* qw) {
    const int tid = threadIdx.x; unsigned nxt = 0u;
    if (tid == 0) nxt = __hip_atomic_fetch_add(ctr, 1u, __ATOMIC_RELAXED, __HIP_MEMORY_SCOPE_AGENT);
    for (;;) {
        if (tid == 0) *qw = nxt;
        asm volatile("s_waitcnt lgkmcnt(0)\n\ts_barrier" ::: "memory");
        const unsigned n = (unsigned)__builtin_amdgcn_readfirstlane((int)*qw);
        asm volatile("s_waitcnt lgkmcnt(0)\n\ts_barrier" ::: "memory");
        if (n >= (unsigned)(8 * 8 * 16 + SBATCH * 8)) break;
        if (tid == 0) nxt = __hip_atomic_fetch_add(ctr, 1u, __ATOMIC_RELAXED, __HIP_MEMORY_SCOPE_AGENT);
        if (n < 512u && (n & 1u)) { int t2 = tid; asm volatile("" : "+v"(t2)); fox_sample_unit(a, l, (int)(n >> 1), ldsb, t2); }
        else { const unsigned an = n < 512u ? (n >> 1) : n - 256u; const int bh = (int)(an & 63u), qb = 15 - (int)(an >> 6);
            attn_body::attn_unit<8>(bh / 8, bh % 8, qb, T.Q, T.K, T.V, T.Z, T.CB + (long)bh * TSEQ, T.O, (char*)ldsb); }
    }
}

__device__ __forceinline__ void phase_ln(const Args& a, int l, int vcu, int G, int tid) {
    const int lane = tid & 63, wave = tid >> 6; const int gw = vcu * NWAVES + wave, NGW = G * NWAVES;
    const GAS bf16* H = (const GAS bf16*)(a.ws + WS_H); GAS bf16* XB = (GAS bf16*)(a.ws + WS_XB); GAS float* XF = (GAS float*)a.out;
    const GAS f32x4* g4 = (const GAS f32x4*)((const GAS float*)a.in[28] + l * 1024) + lane; const GAS f32x4* b4 = (const GAS f32x4*)((const GAS float*)a.in[29] + l * 1024) + lane;
    typedef unsigned long long u64_t;
    u64_t hwA[2][4], xwA[2][4], hwB[2][4], xwB[2][4];
#define LN_LOAD(hw_, xw_, m_) do { const int mm_ = (m_) < MROWS ? (m_) : MROWS - 2; _Pragma("unroll") for (int rr = 0; rr < 2; ++rr) { \
        const GAS u64_t* xr = (const GAS u64_t*)(XB + (size_t)(mm_ + rr) * 1024) + lane; const GAS u64_t* hr = (const GAS u64_t*)(H + (size_t)(mm_ + rr) * 1024) + lane; \
        _Pragma("unroll") for (int q = 0; q < 4; ++q) { hw_[rr][q] = hr[64 * q]; xw_[rr][q] = xr[64 * q]; } } } while (0)
#define LN_BODY(hw_, xw_, m_) do { f32x4 v[2][4]; float s[2]; \
        _Pragma("unroll") for (int rr = 0; rr < 2; ++rr) { s[rr] = 0.f; \
            _Pragma("unroll") for (int q = 0; q < 4; ++q) { const unsigned h0 = (unsigned)hw_[rr][q], h1 = (unsigned)(hw_[rr][q] >> 32); \
                const f32x4 hv = (f32x4){__uint_as_float(h0 << 16), __uint_as_float(h0 & 0xffff0000u), __uint_as_float(h1 << 16), __uint_as_float(h1 & 0xffff0000u)}; \
                const unsigned x0 = (unsigned)xw_[rr][q], x1 = (unsigned)(xw_[rr][q] >> 32); \
                const f32x4 xv = (f32x4){__uint_as_float(x0 << 16), __uint_as_float(x0 & 0xffff0000u), __uint_as_float(x1 << 16), __uint_as_float(x1 & 0xffff0000u)}; \
                v[rr][q] = xv * ALPHA + hv; s[rr] += (v[rr][q].x + v[rr][q].y) + (v[rr][q].z + v[rr][q].w); } } \
        float mean[2], rstd[2]; \
        _Pragma("unroll") for (int rr = 0; rr < 2; ++rr) mean[rr] = wave_sum_dpp(s[rr]) * (1.f / 1024.f); \
        _Pragma("unroll") for (int rr = 0; rr < 2; ++rr) { float s2 = 0.f; \
            _Pragma("unroll") for (int q = 0; q < 4; ++q) { v[rr][q] = v[rr][q] - mean[rr]; s2 += (v[rr][q].x * v[rr][q].x + v[rr][q].y * v[rr][q].y) + (v[rr][q].z * v[rr][q].z + v[rr][q].w * v[rr][q].w); } \
            rstd[rr] = rsq_fast(wave_sum_dpp(s2) * (1.f / 1024.f) + LN_EPS); } \
        if ((m_) < MROWS) { \
        _Pragma("unroll") for (int q = 0; q < 4; ++q) { \
            _Pragma("unroll") for (int rr = 0; rr < 2; ++rr) { const f32x4 o = v[rr][q] * rstd[rr] * ggv[q] + bbv[q]; \
                if (l == NLAYER - 1) ((GAS f32x4*)(XF + (size_t)((m_) + rr) * 1024))[lane + 64 * q] = o;        \
                else ((GAS u64_t*)(XB + (size_t)((m_) + rr) * 1024))[lane + 64 * q] = (u64_t)pk2(o.x, o.y) | ((u64_t)pk2(o.z, o.w) << 32); } } } } while (0)
    const int step = NGW * 2;
    f32x4 ggv[4], bbv[4];
#pragma unroll
    for (int q = 0; q < 4; ++q) { ggv[q] = g4[64 * q]; bbv[q] = b4[64 * q]; }
    LN_LOAD(hwA, xwA, gw * 2);
#pragma unroll 1
    for (int m0 = gw * 2; m0 < MROWS; m0 += 2 * step) {
        LN_LOAD(hwB, xwB, m0 + step);
        LN_BODY(hwA, xwA, m0);
        LN_LOAD(hwA, xwA, m0 + 2 * step);
        LN_BODY(hwB, xwB, m0 + step);
    }
#undef LN_LOAD
#undef LN_BODY
}
__device__ __forceinline__ void sample_mixer_unit(const Args& a, int l, int mixer, int b, LAS unsigned char* ldsb, int tid) {
    for (int u8 = 0; u8 < 8; ++u8) scan_sample_unit(a, l, mixer * 256 + (b * 4 + (u8 >> 1)) * 2 + (u8 & 1), ldsb, tid);
    typedef unsigned u32x2 __attribute__((ext_vector_type(2)));
    const int lane = tid & 63, wave = tid >> 6, rg = lane >> 4, j = lane & 15, ch = rg * 64 + 4 * j;
    const GAS bf16* P = (const GAS bf16*)(a.ws + WS_PROJ); GAS bf16* OC = (GAS bf16*)(a.ws + WS_OC);
    const GAS float* Om = (const GAS float*)(a.ws + (mixer ? WS_OG : WS_OA)); const GAS float* BON = (const GAS float*)(a.ws + WS_BONUS); const GAS float* RV = (const GAS float*)(a.ws + WS_RARR + 5 * ARR_STRIDE);
    const f32x4 gA = mixer ? *(const GAS f32x4*)((const GAS float*)a.in[26] + l * 64 + 4 * j) : *(const GAS f32x4*)((const GAS float*)a.in[20] + l * 256 + ch);
    const f32x4 gB = mixer ? (f32x4){0.f, 0.f, 0.f, 0.f} : *(const GAS f32x4*)((const GAS float*)a.in[21] + l * 256 + ch);
#pragma unroll
    for (int rr = 0; rr < 2; ++rr) { const size_t m = (size_t)MP + b * STOK + 2 * wave + rr;
        const f32x4 o = *(const GAS f32x4*)(Om + m * 256 + ch); const u32x2 z = *(const GAS u32x2*)(P + m * NPJ + (mixer ? C_CZ : C_AZ) + ch); f32x4 y;
        if (!mixer) { const f32x4 rv = *(const GAS f32x4*)(RV + m * 256 + ch); const float bon = BON[m * 4 + rg];
            const float mean = row16_sum((o.x + o.y) + (o.z + o.w)) * (1.f / 64.f); const f32x4 d = o - mean;
            const float var = row16_sum((d.x * d.x + d.y * d.y) + (d.z * d.z + d.w * d.w)) * (1.f / 64.f); y = d * rsq_fast(var + GN_EPS) * gA + gB + bon * rv; }
        else { const float ms = row16_sum((o.x * o.x + o.y * o.y) + (o.z * o.z + o.w * o.w)) * (1.f / 64.f); y = o * rsq_fast(ms + GDN_EPS) * gA; }
        y.x *= silu_fast(__uint_as_float(z.x << 16)); y.y *= silu_fast(__uint_as_float(z.x & 0xffff0000u)); y.z *= silu_fast(__uint_as_float(z.y << 16)); y.w *= silu_fast(__uint_as_float(z.y & 0xffff0000u));
        u32x2 w; w.x = pk2(y.x, y.y); w.y = pk2(y.z, y.w); *(GAS u32x2*)(OC + m * 1024 + (mixer ? 768 : 0) + ch) = w; }
}
__device__ __forceinline__ void sample_outproj(const Args& a, int l, int w, LAS unsigned char* ldsb, int tid) {
    const int lane = tid & 63, wave = __builtin_amdgcn_readfirstlane(tid >> 6), r = lane & 31, hh = lane >> 5, rb = w >> 4, cb = w & 15;
    const GAS bf16* A = (const GAS bf16*)(a.ws + WS_OC) + (size_t)(MP + 32 * rb + r) * 1024 + 128 * wave + 8 * hh;
    const GAS bf16* B0 = (const GAS bf16*)(a.ws + WS_WOUT) + (size_t)l * 1024 * 1024 + (size_t)(64 * cb + r) * 1024 + 128 * wave + 8 * hh; const GAS bf16* B1 = B0 + (size_t)32 * 1024;
    bf16x8 af[8], b0[8], b1[8];
#pragma unroll
    for (int s_ = 0; s_ < 8; ++s_) { af[s_] = *(const GAS bf16x8*)(A + 16 * s_); b0[s_] = *(const GAS bf16x8*)(B0 + 16 * s_); b1[s_] = *(const GAS bf16x8*)(B1 + 16 * s_); }
    f32x16 c0, c1;
#pragma unroll
    for (int i = 0; i < 16; ++i) { c0[i] = 0.f; c1[i] = 0.f; }
#pragma unroll
    for (int s_ = 0; s_ < 8; ++s_) { c0 = MFMA32(af[s_], b0[s_], c0); c1 = MFMA32(af[s_], b1[s_], c1); }
    LAS float* PS = (LAS float*)ldsb;
#pragma unroll
    for (int i = 0; i < 16; ++i) { PS[((wave * 2 + 0) * 16 + i) * 64 + lane] = c0[i]; PS[((wave * 2 + 1) * 16 + i) * 64 + lane] = c1[i]; }
    __syncthreads();
    GAS bf16* H = (GAS bf16*)(a.ws + WS_H);
#pragma unroll
    for (int q = 0; q < 4; ++q) { const int e = tid + 512 * q, t = e >> 10, i = (e >> 6) & 15, ln = e & 63; float sum = 0.f;
#pragma unroll
        for (int wv = 0; wv < 8; ++wv) sum += PS[((wv * 2 + t) * 16 + i) * 64 + ln];
        const int row = crow16(i, ln >> 5), col = 32 * t + (ln & 31);
        H[(size_t)(MP + 32 * rb + row) * 1024 + 64 * cb + col] = (bf16)f2bf(sum); }
    __syncthreads();
}

#ifndef MK_FUSED
#define MK_FUSED 1
#endif
constexpr int CW_Q = 8192;
constexpr int CW_BAR = 4096;
constexpr int NPHASE = 6;

__global__ void __launch_bounds__(NTHREADS, 2) trunk_fwd(Args a) {
    extern __shared__ __attribute__((aligned(16))) unsigned char lds[];
    LAS unsigned char* ldsb = (LAS unsigned char*)lds;
    const int tid = threadIdx.x; const int wv0 = __builtin_amdgcn_readfirstlane(tid >> 6);
    constexpr int G = 256; const int bx = blockIdx.x; const int vcu = (bx % 8) * (G / 8) + bx / 8;
    volatile LAS unsigned* MISC = (volatile LAS unsigned*)(ldsb + MISC_OFF);
    for (int u = tid; u < 128; u += NTHREADS) ((LAS unsigned*)(ldsb + MISC_OFF))[u] = 0u;
    __syncthreads();
    unsigned* ctl = (unsigned*)(a.ws + WS_CTL);
    XcdBarrier bar; bar.bar = ctl + CW_BAR; bar.x = 0; bar.st = nullptr;
    if (a.fused) bar = xcd_barrier_post(ctl + CW_BAR, MISC + 8);
#define SEAM() do { if (fused) xcd_barrier(bar); } while (0)
#define IN(k) (ph_lo <= (k) && (k) < ph_hi)

    if (a.do_pro) { const int fused = a.fused; phase_prologue(a, ldsb, vcu, G, tid); SEAM(); }

    for (int l = a.l_lo; l < a.l_hi; ++l) {
        int ph_lo = a.ph_lo, ph_hi = a.ph_hi, fused = a.fused; asm volatile("" : "+s"(ph_lo), "+s"(ph_hi), "+s"(fused));
#if defined(__HIP_DEVICE_COMPILE__)
#define LAUNDER_ARGS() const __attribute__((address_space(4))) Args* ap_ = (const __attribute__((address_space(4))) Args*)__builtin_amdgcn_kernarg_segment_ptr(); asm volatile("" : "+s"(ap_)); Args al = *ap_
#else
#define LAUNDER_ARGS() Args al = a
#endif
#define LAUNDER() int wv_ = wv0; unsigned zz_ = 0u; asm volatile("" : "+s"(wv_), "+s"(zz_)); int tid = (wv_ << 6) | (int)__builtin_amdgcn_mbcnt_hi(~0u, __builtin_amdgcn_mbcnt_lo(~0u, zz_)); asm volatile("" : "+v"(tid));     LAUNDER_ARGS(); int bxl = bx; asm volatile("" : "+s"(al.ws), "+s"(al.out), "+s"(bxl)); const int vcul = (bxl % 8) * (G / 8) + bxl / 8; (void)vcul
        if (IN(0)) { LAUNDER(); (void)tid;
            pg8::Gemm g{(const bf16*)(al.ws + WS_XB), (const bf16*)(al.ws + WS_WIN) + (size_t)l * NPJ * 1024, MROWS, NPJ, DMODEL}; pg8::StaticOrder S; S.init(MROWS, NPJ, G, bxl);
            pg8::EpiProj E{(bf16*)(al.ws + WS_PROJ), (bf16*)(al.ws + WS_KV), (float*)(al.ws + WS_SMALL), al.out + O_FKP + (size_t)l * MP * 512, al.out + O_FVP + (size_t)l * MP * 512, al.out + O_FKS + (size_t)l * MS * 512, al.out + O_FVS + (size_t)l * MS * 512};
            pg8::gemm_phase<pg8::EpiProj, pg8::StaticOrder, false, true>(ldsb, g, S, E);
            SEAM();
        }
        if (IN(1)) { LAUNDER(); phase_prep(al, l, ldsb, vcul, G, tid); SEAM(); }
        if (IN(2)) {
            if (bx < 64) { LAUNDER(); chunk_scan_unit(al, l, bxl, ldsb, tid); __syncthreads(); }
            else if (bx < 128) { LAUNDER(); const int k_ = bxl - 64; sample_mixer_unit(al, l, k_ >> 5, k_ & 31, ldsb, tid); }
            { LAUNDER(); (void)tid; const bf16* PJ = (const bf16*)(al.ws + WS_PROJ);
              const bf16* KVb = (const bf16*)(al.ws + WS_KV);
              const attn_body::AttnTensors AT{(const attn_body::bf16*)(PJ + C_Q), (const attn_body::bf16*)(KVb), (const attn_body::bf16*)(KVb + 512), (const attn_body::bf16*)(PJ + C_BZ),
                                             (const float*)(al.ws + WS_CB), (attn_body::bf16*)((bf16*)(al.ws + WS_OC) + 256)};
              phase2_queue(al, l, AT, ldsb, ctl + CW_Q + 64 * l, MISC + 16); }
            SEAM();
        }
        if (IN(4)) { LAUNDER(); (void)tid;
            pg8::Gemm g{(const bf16*)(al.ws + WS_OC), (const bf16*)(al.ws + WS_WOUT) + (size_t)l * 1024 * 1024, MP, DMODEL, DMODEL}; pg8::StaticOrder S; S.init(MP, DMODEL, G, bxl);
            pg8::EpiH E{(bf16*)(al.ws + WS_H), DMODEL};
            pg8::gemm_phase<pg8::EpiH, pg8::StaticOrder, true, true>(ldsb, g, S, E);
            sample_outproj(al, l, bxl, ldsb, tid);
            SEAM();
        }
        if (IN(5)) { LAUNDER(); phase_ln(al, l, vcul, G, tid); if (l + 1 < a.l_hi || !IN(5)) SEAM(); }
    }
#undef SEAM
#undef IN
}

extern "C" void kernel_launch(void* const* d_in, const int* in_sizes, int n_in, void* d_out, int out_size, void* d_ws, size_t ws_size, hipStream_t stream) {
    static int grid = 0;
    if (grid == 0) {
        if (n_in != 30 || (size_t)out_size != O_END || ws_size < WS_END2) { fprintf(stderr, "kernel_launch: unexpected sizes: n_in %d out %d ws %zu (need %zu); nothing launched\n", n_in, out_size, ws_size, (size_t)WS_END2); grid = -1; return; }
        int dev = 0, cus = 0, per_cu = 0;
        if (hipGetDevice(&dev) != hipSuccess || hipDeviceGetAttribute(&cus, hipDeviceAttributeMultiprocessorCount, dev) != hipSuccess) { fprintf(stderr, "kernel_launch: device query failed\n"); grid = -1; return; }
        if (hipFuncSetAttribute((const void*)trunk_fwd, hipFuncAttributeMaxDynamicSharedMemorySize, LDS_BYTES) != hipSuccess) { fprintf(stderr, "kernel_launch: hipFuncSetAttribute failed\n"); grid = -1; return; }
        if (hipOccupancyMaxActiveBlocksPerMultiprocessor(&per_cu, (const void*)trunk_fwd, NTHREADS, LDS_BYTES) != hipSuccess || per_cu < 1) fprintf(stderr, "kernel_launch: note: occupancy query reports %d workgroups per CU\n", per_cu);
        (void)hipGetLastError();
        if (cus < 256) { fprintf(stderr, "kernel_launch: %d CUs; this kernel needs 256 resident workgroups\n", cus); grid = -1; return; }
        grid = 256;
    }
    if (grid < 0) return;
    (void)in_sizes;
    if (hipMemsetAsync((char*)d_ws + WS_CTL, 0, CTL_ZERO_BYTES, stream) != hipSuccess) { fprintf(stderr, "kernel_launch: memset failed\n"); return; }
    Args a{};
    for (int i = 0; i < 30; ++i) a.in[i] = (const float*)d_in[i];
    a.out = (float*)d_out; a.ws = (unsigned char*)d_ws;
#if MK_FUSED
    a.do_pro = 1; a.fused = 1; a.l_lo = 0; a.l_hi = NLAYER; a.ph_lo = 0; a.ph_hi = NPHASE;
    hipLaunchKernelGGL(trunk_fwd, dim3(grid), dim3(NTHREADS), LDS_BYTES, stream, a);
#else
    a.fused = 0; a.do_pro = 1; a.l_lo = 0; a.l_hi = 0; a.ph_lo = 0; a.ph_hi = 0;
    hipLaunchKernelGGL(trunk_fwd, dim3(grid), dim3(NTHREADS), LDS_BYTES, stream, a);
    a.do_pro = 0;
    for (int l = 0; l < NLAYER; ++l) for (int ph = 0; ph < NPHASE; ++ph) { a.l_lo = l; a.l_hi = l + 1; a.ph_lo = ph; a.ph_hi = ph + 1;
        hipLaunchKernelGGL(trunk_fwd, dim3(grid), dim3(NTHREADS), LDS_BYTES, stream, a); }
#endif
    const hipError_t le = hipPeekAtLastError();
    if (le != hipSuccess) fprintf(stderr, "kernel_launch: launch failed: %s\n", hipGetErrorName(le));
}
```
